# Optimizing an MI355X kernel written in HIP

```python
import math
import jax, jax.numpy as jnp
from jax import lax
import numpy as np

D_MODEL = 4096
BATCH = 1
SEQ = 16384
DEPTH = 1

N_HEADS = 16
HEAD_DIM = 64
ATTN_QK = N_HEADS * 2 * HEAD_DIM
ATTN_V = N_HEADS * 2 * HEAD_DIM
Q_BLOCK = 128
D_RNN = D_MODEL // 2
N_RNN_BLOCKS = 16
RNN_BLOCK = D_RNN // N_RNN_BLOCKS
CONV_RNN = 4
RG_C = 8.0
D_FF = 11008
CONV_FFN = 3
EPS = 1e-6
D_IN = 2 * ATTN_QK + ATTN_V + 2 * D_RNN + 2 * D_MODEL
IN_SPLITS = (ATTN_QK, 2 * ATTN_QK, 2 * ATTN_QK + ATTN_V,
             2 * ATTN_QK + ATTN_V + D_RNN, 2 * ATTN_QK + ATTN_V + 2 * D_RNN,
             2 * ATTN_QK + ATTN_V + 2 * D_RNN + D_MODEL)

kernel_name = "hybrid_diffattn_rglru_convffn_adaln"


def rmsnorm(x, w):
    xf = x.astype(jnp.float32)
    y = xf * lax.rsqrt(jnp.mean(xf * xf, axis=-1, keepdims=True) + EPS)
    return (y * w.astype(jnp.float32)).astype(x.dtype)


def modulate(h, shift, scale):
    return h * (1.0 + scale[:, None, :]) + shift[:, None, :]


def causal_dwconv(x, w, b):
    K = w.shape[0]
    S = x.shape[1]
    xp = jnp.pad(x, ((0, 0), (K - 1, 0), (0, 0)))
    y = b
    for j in range(K):
        y = y + xp[:, j:j + S] * w[j]
    return y


def lambda_init_fn(layer_idx):
    return 0.8 - 0.6 * math.exp(-0.3 * layer_idx)


def diff_attention(q, k, v, lq1, lk1, lq2, lk2, subln_w, lambda_init):
    B, S = q.shape[0], q.shape[1]
    q = q.reshape(B, S, N_HEADS, 2, HEAD_DIM)
    k = k.reshape(B, S, N_HEADS, 2, HEAD_DIM)
    v = v.reshape(B, S, N_HEADS, 2 * HEAD_DIM)
    f32 = jnp.float32
    lam = (jnp.exp(jnp.sum(lq1.astype(f32) * lk1.astype(f32)))
           - jnp.exp(jnp.sum(lq2.astype(f32) * lk2.astype(f32))) + lambda_init)
    slopes = 2.0 ** (-8.0 * jnp.arange(1, N_HEADS + 1, dtype=f32) / N_HEADS)
    kpos = jnp.arange(S, dtype=f32)
    n_blk = S // Q_BLOCK
    qb = q.reshape(B, n_blk, Q_BLOCK, N_HEADS, 2, HEAD_DIM).transpose(1, 0, 2, 3, 4, 5)
    starts = jnp.arange(n_blk, dtype=jnp.int32) * Q_BLOCK
    scale = HEAD_DIM ** -0.5

    def block(args):
        q_blk, start = args
        s = jnp.einsum('bqhcd,bkhcd->bhcqk', q_blk, k).astype(f32) * scale
        qpos = start.astype(f32) + jnp.arange(Q_BLOCK, dtype=f32)
        dist = qpos[:, None] - kpos[None, :]
        bias = jnp.where(dist >= 0, -slopes[:, None, None] * dist, -jnp.inf)
        p = jax.nn.softmax(s + bias[None, :, None], axis=-1)
        w = p[:, :, 0] - lam * p[:, :, 1]
        return jnp.einsum('bhqk,bkhe->bqhe', w.astype(v.dtype), v)

    o = lax.map(block, (qb, starts))
    o = o.transpose(1, 0, 2, 3, 4).reshape(B, S, N_HEADS, 2 * HEAD_DIM)
    o = rmsnorm(o, subln_w) * (1.0 - lambda_init)
    return o.reshape(B, S, N_HEADS * 2 * HEAD_DIM)


def rg_lru(x, w_a, b_a, w_x, b_x, lru_lambda):
    B, S = x.shape[0], x.shape[1]
    xb = x.reshape(B, S, N_RNN_BLOCKS, RNN_BLOCK)
    r = jax.nn.sigmoid(jnp.einsum('bsnd,nde->bsne', xb, w_a).reshape(B, S, D_RNN) + b_a)
    i = jax.nn.sigmoid(jnp.einsum('bsnd,nde->bsne', xb, w_x).reshape(B, S, D_RNN) + b_x)
    f32 = jnp.float32
    log_a = -RG_C * r.astype(f32) * jax.nn.softplus(-lru_lambda.astype(f32))
    a = jnp.exp(log_a)
    bx = jnp.sqrt(-jnp.expm1(2.0 * log_a)) * (i * x).astype(f32)

    def combine(left, right):
        a_l, b_l = left
        a_r, b_r = right
        return a_l * a_r, a_r * b_l + b_r

    _, h = lax.associative_scan(combine, (a, bx), axis=1)
    return h.astype(x.dtype)


def setup_inputs(seed: int = 0) -> dict:
    key = jax.random.key(seed)
    ks = jax.random.split(key, 32)
    f32 = jnp.float32
    D, L = D_MODEL, DEPTH

    def nrm(k, shape, scale):
        return jax.random.normal(k, shape, f32) * scale

    u = jax.random.uniform(ks[17], (L, D_RNN), f32, 0.9, 0.999)
    a0 = u ** (1.0 / RG_C)
    lru_lambda = jnp.log(a0) - jnp.log1p(-a0)
    return {
        "x": nrm(ks[0], (BATCH, SEQ, D), 1.0),
        "c": nrm(ks[1], (BATCH, D), 1.0),
        "w_ada": nrm(ks[2], (L, D, 6 * D), D ** -0.5),
        "b_ada": nrm(ks[3], (L, 6 * D), 0.01),
        "norm1_w": 1.0 + nrm(ks[4], (L, D), 0.01),
        "w_in": nrm(ks[5], (L, D, D_IN), D ** -0.5),
        "lambda_q1": nrm(ks[6], (L, HEAD_DIM), 0.1),
        "lambda_k1": nrm(ks[7], (L, HEAD_DIM), 0.1),
        "lambda_q2": nrm(ks[8], (L, HEAD_DIM), 0.1),
        "lambda_k2": nrm(ks[9], (L, HEAD_DIM), 0.1),
        "subln_w": 1.0 + nrm(ks[10], (L, 2 * HEAD_DIM), 0.01),
        "conv_w": nrm(ks[11], (L, CONV_RNN, D_RNN), CONV_RNN ** -0.5),
        "conv_b": nrm(ks[12], (L, D_RNN), 0.01),
        "w_rg_a": nrm(ks[13], (L, N_RNN_BLOCKS, RNN_BLOCK, RNN_BLOCK), RNN_BLOCK ** -0.5),
        "b_rg_a": nrm(ks[14], (L, D_RNN), 0.01),
        "w_rg_x": nrm(ks[15], (L, N_RNN_BLOCKS, RNN_BLOCK, RNN_BLOCK), RNN_BLOCK ** -0.5),
        "b_rg_x": nrm(ks[16], (L, D_RNN), 0.01),
        "lru_lambda": lru_lambda,
        "w_proj_attn": nrm(ks[18], (L, ATTN_V, D), ATTN_V ** -0.5),
        "w_proj_rec": nrm(ks[19], (L, D_RNN, D), D_RNN ** -0.5),
        "w_out": nrm(ks[20], (L, D, D), D ** -0.5),
        "norm2_w": 1.0 + nrm(ks[21], (L, D), 0.01),
        "w_ffn_up": nrm(ks[22], (L, D, 2 * D_FF), D ** -0.5),
        "ffn_conv_w": nrm(ks[23], (L, CONV_FFN, D_FF), CONV_FFN ** -0.5),
        "ffn_conv_b": nrm(ks[24], (L, D_FF), 0.01),
        "w_ffn_down": nrm(ks[25], (L, D_FF, D), D_FF ** -0.5),
        "norm_f_w": 1.0 + nrm(ks[26], (D,), 0.01),
    }


def reference(x, c, w_ada, b_ada, norm1_w, w_in, lambda_q1, lambda_k1, lambda_q2, lambda_k2,
              subln_w, conv_w, conv_b, w_rg_a, b_rg_a, w_rg_x, b_rg_x, lru_lambda,
              w_proj_attn, w_proj_rec, w_out, norm2_w, w_ffn_up, ffn_conv_w, ffn_conv_b,
              w_ffn_down, norm_f_w):
    for l in range(DEPTH):
        mod = jax.nn.silu(c) @ w_ada[l] + b_ada[l]
        sh1, sc1, g1, sh2, sc2, g2 = jnp.split(mod, 6, axis=-1)

        h = modulate(rmsnorm(x, norm1_w[l]), sh1, sc1)
        proj = h @ w_in[l]
        q, k, v, rx, rg, ga, gb = jnp.split(proj, IN_SPLITS, axis=-1)

        y_att = diff_attention(q, k, v, lambda_q1[l], lambda_k1[l], lambda_q2[l], lambda_k2[l],
                               subln_w[l], lambda_init_fn(l))
        xr = causal_dwconv(rx, conv_w[l], conv_b[l])
        y_rec = rg_lru(xr, w_rg_a[l], b_rg_a[l], w_rg_x[l], b_rg_x[l], lru_lambda[l]) * jax.nn.gelu(rg)

        mixed = (jax.nn.sigmoid(ga) * (y_att @ w_proj_attn[l])
                 + jax.nn.sigmoid(gb) * (y_rec @ w_proj_rec[l]))
        x = x + g1[:, None, :] * (mixed @ w_out[l])

        h = modulate(rmsnorm(x, norm2_w[l]), sh2, sc2)
        gate, up = jnp.split(h @ w_ffn_up[l], 2, axis=-1)
        gate = causal_dwconv(gate, ffn_conv_w[l], ffn_conv_b[l])
        x = x + g2[:, None, :] * ((jax.nn.gelu(gate) * up) @ w_ffn_down[l])

    return rmsnorm(x, norm_f_w)
```

```cpp
#include <hip/hip_runtime.h>
#include <cstdio>
#include <cstdint>
#ifndef MK_N_LAUNCHES
#define MK_N_LAUNCHES 13
#endif
__device__ __forceinline__ int ftid() { int t = (int)threadIdx.x; asm volatile("" : "+v"(t)); return t; }
namespace pg8 {
#define PG8_LAS __attribute__((address_space(3)))
typedef unsigned short bf16_t;
typedef short bf16x8 __attribute__((ext_vector_type(8)));
typedef float f32x4 __attribute__((ext_vector_type(4)));
typedef unsigned u32x4 __attribute__((ext_vector_type(4)));
constexpr int BM = 256, BK = 64, HALF = 128, HTB = HALF * BK * 2  , STAGE_BYTES = 8 * HTB, NXCD = 8, WGM = 8;

__host__ __device__ __forceinline__ int lds_byte(int r, int c) { const int st = (r >> 4) * 2 + (c >> 5), rr = r & 15, cc = c & 31, ob = rr * 64 + cc * 2; return st * 1024 + (ob ^ (((ob >> 9) & 1) << 5)); }
__host__ __device__ __forceinline__ void stage_rc(int b, int& R, int& C) { const int st = b / 1024, sb = b % 1024, swz = sb ^ (((sb >> 9) & 1) << 5); R = (st >> 1) * 16 + swz / 64; C = (st & 1) * 32 + (swz % 64) / 2; }
__host__ __device__ __forceinline__ int perm32(int rho) { const int n = rho >> 4, i = rho & 15; return 8 * (i >> 2) + 4 * n + (i & 3); }

struct Unit { int pm, pn; };
struct Gemm { const bf16_t* A; const bf16_t* Bt; int M, N, K; };

struct StaticOrder {
    int nM, nN, nwg, G, c;
    __host__ __device__ void init(int M, int N, int G_, int c_) { nM = M / BM; nN = N / BM; nwg = nM * nN; G = G_; c = c_; }
    __host__ __device__ bool next(int i, Unit& u) const {
        const long L = (long)i * G + c; if (L >= nwg) return false;
        int wgid = (int)L; { const int q = nwg / NXCD, r = nwg % NXCD, xcd = wgid % NXCD, off = wgid / NXCD; wgid = (xcd < r ? xcd * (q + 1) : r * (q + 1) + (xcd - r) * q) + off; }
        const int nig = WGM * nN, gid = wgid / nig, fm = gid * WGM, gsz = (nM - fm) < WGM ? (nM - fm) : WGM;
        u.pm = fm + ((wgid % nig) % gsz); u.pn = (wgid % nig) / gsz; return true;
    }
    __device__ __forceinline__ void a_ready(const Unit&) const {}
    __device__ __forceinline__ void done(const Unit&) const {}
};

__device__ __forceinline__ unsigned cvt_pk_bf16(float lo, float hi) { unsigned r; asm volatile("v_cvt_pk_bf16_f32 %0, %1, %2" : "=v"(r) : "v"(lo), "v"(hi)); return r; }
typedef float f32x2 __attribute__((ext_vector_type(2)));
__device__ __forceinline__ float sigmoid_f(float v) { return __builtin_amdgcn_rcpf(1.0f + __builtin_amdgcn_exp2f(-1.4426950408889634f * v)); }
__device__ __forceinline__ float gelu_tanh_f(float v) { const float u = v * (0.7978845608028654f + 0.035677408136300125f * v * v);
    return v * __builtin_amdgcn_rcpf(1.0f + __builtin_amdgcn_exp2f(-2.8853900817779268f * u)); }
__device__ __forceinline__ float bf_lo(unsigned w) { return __uint_as_float(w << 16); }
__device__ __forceinline__ float bf_hi(unsigned w) { return __uint_as_float(w & 0xffff0000u); }

template <int ACT> __device__ __forceinline__ void store_tile_bf16(const f32x4 (&acc)[2][2][4][2], bf16_t* base, int ldc, int row0, int col0, float sc) {
#pragma unroll
    for (int ai = 0; ai < 2; ++ai)
#pragma unroll
        for (int m = 0; m < 4; ++m) { bf16_t* rowp = base + (size_t)(row0 + ai * HALF + m * 16) * ldc + col0;
#pragma unroll
            for (int bj = 0; bj < 2; ++bj) { f32x4 v0 = acc[ai][bj][m][0], v1 = acc[ai][bj][m][1];
                if (ACT == 0) { v0 = v0 * sc; v1 = v1 * sc; }
                if (ACT == 2) {
#pragma unroll
                    for (int j = 0; j < 4; ++j) { v0[j] = gelu_tanh_f(v0[j]); v1[j] = gelu_tanh_f(v1[j]); } }
                if (ACT == 3) {
#pragma unroll
                    for (int j = 0; j < 4; ++j) { v0[j] = sigmoid_f(v0[j]); v1[j] = sigmoid_f(v1[j]); } }
                u32x4 w; w.x = cvt_pk_bf16(v0[0], v0[1]); w.y = cvt_pk_bf16(v0[2], v0[3]); w.z = cvt_pk_bf16(v1[0], v1[1]); w.w = cvt_pk_bf16(v1[2], v1[3]);
                *(u32x4*)(rowp + bj * HALF) = w;
                if (ACT != 0) __builtin_amdgcn_sched_barrier(0); } }
}
struct EpiProj {
    static constexpr bool PERM = true, AFTER_DRAIN = false;
    bf16_t *Q, *K, *V, *RX, *RG, *GA, *GB; float qscale;
    __device__ __forceinline__ void operator()(const f32x4 (&acc)[2][2][4][2], const Unit& u, int wr, int wc, int fr, int fq) const {
        const int pn = u.pn; const int row0 = u.pm * BM + wr * 64 + fr, cw = wc * 32 + 8 * fq;
        bf16_t* base; int ldc = 2048, colt, kind = 0; float sc = 1.0f;
        if (pn < 8)       { base = Q;  colt = pn * 256; sc = qscale; }
        else if (pn < 16) { base = K;  colt = (pn - 8) * 256; }
        else if (pn < 24) { base = V;  colt = (pn - 16) * 256; }
        else if (pn < 32) { base = RX; colt = (pn - 24) * 256; }
        else if (pn < 40) { base = RG; colt = (pn - 32) * 256; kind = 2; }
        else if (pn < 56) { base = GA; colt = (pn - 40) * 256; kind = 3; ldc = 4096; }
        else              { base = GB; colt = (pn - 56) * 256; kind = 3; ldc = 4096; }
        if (kind == 0)      store_tile_bf16<0>(acc, base, ldc, row0, colt + cw, sc);
        else if (kind == 2) store_tile_bf16<2>(acc, base, ldc, row0, colt + cw, sc);
        else                store_tile_bf16<3>(acc, base, ldc, row0, colt + cw, sc);
    }
};
struct EpiPlain {
    static constexpr bool PERM = true, AFTER_DRAIN = false;
    bf16_t* O; int ldc;
    __device__ __forceinline__ void operator()(const f32x4 (&acc)[2][2][4][2], const Unit& u, int wr, int wc, int fr, int fq) const {
        store_tile_bf16<0>(acc, O, ldc, u.pm * BM + wr * 64 + fr, u.pn * BM + wc * 32 + 8 * fq, 1.0f);
    }
};
template <bool HAS_ADD> struct EpiGate {
    static constexpr bool PERM = true, AFTER_DRAIN = false;
    const bf16_t* G; const bf16_t* ADD; bf16_t* O;
    __device__ __forceinline__ void operator()(const f32x4 (&acc)[2][2][4][2], const Unit& u, int wr, int wc, int fr, int fq) const {
        const int row0 = u.pm * BM + wr * 64 + fr, col0 = u.pn * BM + wc * 32 + 8 * fq;
#pragma unroll
        for (int ai = 0; ai < 2; ++ai)
#pragma unroll
            for (int m = 0; m < 4; ++m) { const size_t off = (size_t)(row0 + ai * HALF + m * 16) * 4096 + col0;
#pragma unroll
                for (int bj = 0; bj < 2; ++bj) { const u32x4 g = *(const u32x4*)(G + off + bj * HALF);
                    f32x4 v0 = acc[ai][bj][m][0], v1 = acc[ai][bj][m][1];
                    v0[0] *= bf_lo(g.x); v0[1] *= bf_hi(g.x); v0[2] *= bf_lo(g.y); v0[3] *= bf_hi(g.y); v1[0] *= bf_lo(g.z); v1[1] *= bf_hi(g.z); v1[2] *= bf_lo(g.w); v1[3] *= bf_hi(g.w);
                    if (HAS_ADD) { const u32x4 a = *(const u32x4*)(ADD + off + bj * HALF);
                        v0[0] += bf_lo(a.x); v0[1] += bf_hi(a.x); v0[2] += bf_lo(a.y); v0[3] += bf_hi(a.y); v1[0] += bf_lo(a.z); v1[1] += bf_hi(a.z); v1[2] += bf_lo(a.w); v1[3] += bf_hi(a.w); }
                    u32x4 w; w.x = cvt_pk_bf16(v0[0], v0[1]); w.y = cvt_pk_bf16(v0[2], v0[3]); w.z = cvt_pk_bf16(v1[0], v1[1]); w.w = cvt_pk_bf16(v1[2], v1[3]);
                    *(u32x4*)(O + off + bj * HALF) = w; }
                asm volatile("" ::: "memory"); }
    }
};
struct EpiRes {
    static constexpr bool PERM = false, AFTER_DRAIN = false;
    const float* base; float* out; const float* gvec;
    __device__ __forceinline__ void operator()(const f32x4 (&acc)[2][2][4][2], const Unit& u, int wr, int wc, int fr, int fq) const {
        const int row0 = u.pm * BM + wr * 64 + fr, col0 = u.pn * BM + wc * 32 + 4 * fq;
        f32x4 gv[2][2];
#pragma unroll
        for (int bj = 0; bj < 2; ++bj)
#pragma unroll
            for (int n = 0; n < 2; ++n) gv[bj][n] = *(const f32x4*)(gvec + col0 + bj * HALF + n * 16);
#pragma unroll
        for (int ai = 0; ai < 2; ++ai)
#pragma unroll
            for (int m = 0; m < 4; ++m) { const size_t off = (size_t)(row0 + ai * HALF + m * 16) * 4096 + col0;
#pragma unroll
                for (int bj = 0; bj < 2; ++bj)
#pragma unroll
                    for (int n = 0; n < 2; ++n) { const f32x4 bs = *(const f32x4*)(base + off + bj * HALF + n * 16);
                        *(f32x4*)(out + off + bj * HALF + n * 16) = bs + gv[bj][n] * acc[ai][bj][m][n]; }
                asm volatile("" ::: "memory"); }
    }
};

template <class Epi, class Sched, bool ALIGN_EPI = false, bool SP2 = false>
__device__ __forceinline__ void gemm_phase(PG8_LAS unsigned char* lds, const Gemm g, const Sched& S, const Epi& E) {
    const int tid = ftid(), wid = __builtin_amdgcn_readfirstlane(tid >> 6), lane = tid & 63, wr = wid >> 2, wc = wid & 3, fr = lane & 15, fq = lane >> 4;
    const int K = g.K, nt = K / BK;
    unsigned voffA[2], voffB[2];
#pragma unroll
    for (int i = 0; i < 2; ++i) { int R, C; stage_rc(tid * 16 + i * 8192, R, C); const int Rb = Epi::PERM ? ((R & ~31) + perm32(R & 31)) : R;
        voffA[i] = (unsigned)(R * K + C) * 2u; voffB[i] = (unsigned)(Rb * K + C) * 2u; }
    const size_t kstep = (size_t)(BK * 2);
    const size_t hstep = (size_t)HALF * K * 2;
    const size_t tstep = 2 * hstep;
    const unsigned ldsw = (unsigned)wid * 1024u;
    const int aoff = lds_byte(wr * 64 + fr, fq * 8), boff = lds_byte(wc * 32 + fr, fq * 8);
#define PG8_SA(b, h) (((b) * 2 + (h)) * HTB)
#define PG8_SB(b, h) ((4 + (b) * 2 + (h)) * HTB)
#define PG8_STAGE(bufoff, gbase, voff) do { _Pragma("unroll") for (int _i = 0; _i < 2; ++_i) \
        __builtin_amdgcn_global_load_lds((const unsigned*)((const char*)(gbase) + (voff)[_i]), (PG8_LAS unsigned*)(lds + (bufoff) + ldsw + _i * 8192), 16, 0, 0); } while (0)
#define PG8_LDA(dst, b, h) do { _Pragma("unroll") for (int m = 0; m < 4; ++m) _Pragma("unroll") for (int k = 0; k < 2; ++k) dst[m][k] = *(const PG8_LAS bf16x8*)(lds + PG8_SA(b, h) + aoff + m * 2048 + k * 1024); } while (0)
#define PG8_LDB(dst, b, h) do { _Pragma("unroll") for (int n = 0; n < 2; ++n) _Pragma("unroll") for (int k = 0; k < 2; ++k) dst[n][k] = *(const PG8_LAS bf16x8*)(lds + PG8_SB(b, h) + boff + n * 2048 + k * 1024); } while (0)
#define PG8_MMA(ai, bj, At, Bt) do { __builtin_amdgcn_s_setprio(1); _Pragma("unroll") for (int m = 0; m < 4; ++m) _Pragma("unroll") for (int n = 0; n < 2; ++n) _Pragma("unroll") for (int k = 0; k < 2; ++k) \
        acc[ai][bj][m][n] = __builtin_amdgcn_mfma_f32_16x16x32_bf16(Bt[n][k], At[m][k], acc[ai][bj][m][n], 0, 0, 0); __builtin_amdgcn_s_setprio(0); } while (0)
#define PG8_WAIT_V(n) asm volatile("s_waitcnt vmcnt(" #n ")" ::: "memory")
#define PG8_WAIT_L(n) asm volatile("s_waitcnt lgkmcnt(" #n ")" ::: "memory")
#define PG8_BAR __builtin_amdgcn_s_barrier()
#define PG8_SCHED __builtin_amdgcn_sched_barrier(0)
    Unit cur, nxt; int ui = 0;
    if (!S.next(0, cur)) return;
    f32x4 acc[2][2][4][2];
#pragma unroll
    for (int a = 0; a < 2; ++a)
#pragma unroll
        for (int b = 0; b < 2; ++b)
#pragma unroll
            for (int m = 0; m < 4; ++m)
#pragma unroll
                for (int n = 0; n < 2; ++n) acc[a][b][m][n] = (f32x4){0.f, 0.f, 0.f, 0.f};
    bf16x8 At[4][2], B0[2][2], B1[2][2];
    const char* cA = (const char*)g.A + (size_t)cur.pm * tstep; const char* cB = (const char*)g.Bt + (size_t)cur.pn * tstep;
    S.a_ready(cur);
    if constexpr (SP2) {
        PG8_STAGE(PG8_SB(0, 0), cB, voffB); PG8_STAGE(PG8_SB(0, 1), cB + hstep, voffB); PG8_STAGE(PG8_SA(0, 0), cA, voffA); PG8_STAGE(PG8_SA(0, 1), cA + hstep, voffA);
        if (wr == 1) PG8_BAR;
        PG8_WAIT_V(2); PG8_BAR;
        PG8_STAGE(PG8_SB(1, 0), cB + kstep, voffB); PG8_STAGE(PG8_SA(1, 0), cA + kstep, voffA); PG8_STAGE(PG8_SB(1, 1), cB + hstep + kstep, voffB);
        PG8_WAIT_V(6); PG8_BAR;
    } else {
        PG8_STAGE(PG8_SB(0, 0), cB, voffB); PG8_STAGE(PG8_SA(0, 0), cA, voffA); PG8_STAGE(PG8_SB(0, 1), cB + hstep, voffB); PG8_STAGE(PG8_SA(0, 1), cA + hstep, voffA);
        if (wr == 1) PG8_BAR;
        PG8_WAIT_V(4); PG8_BAR;
        PG8_STAGE(PG8_SB(1, 0), cB + kstep, voffB); PG8_STAGE(PG8_SA(1, 0), cA + kstep, voffA); PG8_STAGE(PG8_SB(1, 1), cB + hstep + kstep, voffB);
        PG8_WAIT_V(6); PG8_BAR;
    }
    for (;;) {
        const bool has_next = S.next(ui + 1, nxt);
        const char* nA = has_next ? (const char*)g.A + (size_t)nxt.pm * tstep : cA; const char* nB = has_next ? (const char*)g.Bt + (size_t)nxt.pn * tstep : cB;
        for (int t = 0; t < nt; t += 2) {
            const bool last = (t == nt - 2);
            const char* a1 = cA + (size_t)(t + 1) * kstep;
            const char* a2 = last ? nA : cA + (size_t)(t + 2) * kstep; const char* b2 = last ? nB : cB + (size_t)(t + 2) * kstep;
            const char* a3 = a2 + kstep; const char* b3 = b2 + kstep;
            if (last && has_next) S.a_ready(nxt);
            if constexpr (SP2) {
            PG8_LDB(B0, 0, 0); PG8_LDB(B1, 0, 1); PG8_SCHED; PG8_LDA(At, 0, 0); PG8_STAGE(PG8_SA(1, 1), a1 + hstep, voffA);
            PG8_WAIT_V(8); PG8_WAIT_L(0); PG8_BAR; PG8_MMA(0, 0, At, B0); PG8_MMA(0, 1, At, B1); PG8_BAR; PG8_SCHED;
            PG8_LDA(At, 0, 1); PG8_STAGE(PG8_SB(0, 0), b2, voffB); PG8_STAGE(PG8_SB(0, 1), b2 + hstep, voffB); PG8_STAGE(PG8_SA(0, 0), a2, voffA);
            PG8_WAIT_V(8); PG8_WAIT_L(0); PG8_BAR; PG8_MMA(1, 0, At, B0); PG8_MMA(1, 1, At, B1); PG8_BAR; PG8_SCHED;
            PG8_LDB(B0, 1, 0); PG8_LDB(B1, 1, 1); PG8_SCHED; PG8_LDA(At, 1, 0); PG8_STAGE(PG8_SA(0, 1), a2 + hstep, voffA);
            PG8_WAIT_V(8); PG8_WAIT_L(0); PG8_BAR; PG8_MMA(0, 0, At, B0); PG8_MMA(0, 1, At, B1); PG8_BAR; PG8_SCHED;
            PG8_LDA(At, 1, 1); PG8_STAGE(PG8_SB(1, 0), b3, voffB); PG8_STAGE(PG8_SB(1, 1), b3 + hstep, voffB); PG8_STAGE(PG8_SA(1, 0), a3, voffA);
            PG8_WAIT_V(8); PG8_WAIT_L(0); PG8_BAR; PG8_MMA(1, 0, At, B0); PG8_MMA(1, 1, At, B1); PG8_BAR; PG8_SCHED;
            } else {
            PG8_LDB(B0, 0, 0); PG8_SCHED; PG8_LDA(At, 0, 0); PG8_STAGE(PG8_SA(1, 1), a1 + hstep, voffA);
            PG8_WAIT_L(8); PG8_BAR; PG8_WAIT_L(0); PG8_MMA(0, 0, At, B0); PG8_BAR; PG8_SCHED;
            PG8_LDB(B1, 0, 1); PG8_STAGE(PG8_SB(0, 0), b2, voffB);
            PG8_BAR; PG8_WAIT_L(0); PG8_MMA(0, 1, At, B1); PG8_BAR;
            PG8_LDA(At, 0, 1); PG8_STAGE(PG8_SA(0, 0), a2, voffA);
            PG8_BAR; PG8_WAIT_L(0); PG8_MMA(1, 0, At, B0); PG8_BAR; PG8_SCHED;
            PG8_STAGE(PG8_SB(0, 1), b2 + hstep, voffB);
            PG8_WAIT_V(6); PG8_BAR; PG8_MMA(1, 1, At, B1); PG8_BAR;
            PG8_LDB(B0, 1, 0); PG8_SCHED; PG8_LDA(At, 1, 0); PG8_STAGE(PG8_SA(0, 1), a2 + hstep, voffA);
            PG8_WAIT_L(8); PG8_BAR; PG8_WAIT_L(0); PG8_MMA(0, 0, At, B0); PG8_BAR; PG8_SCHED;
            PG8_LDB(B1, 1, 1); PG8_STAGE(PG8_SB(1, 0), b3, voffB);
            PG8_BAR; PG8_WAIT_L(0); PG8_MMA(0, 1, At, B1); PG8_BAR;
            PG8_LDA(At, 1, 1); PG8_STAGE(PG8_SA(1, 0), a3, voffA);
            PG8_BAR; PG8_WAIT_L(0); PG8_MMA(1, 0, At, B0); PG8_BAR; PG8_SCHED;
            PG8_STAGE(PG8_SB(1, 1), b3 + hstep, voffB);
            PG8_WAIT_V(6); PG8_BAR; PG8_MMA(1, 1, At, B1); PG8_BAR;
            }
        }
        if constexpr (ALIGN_EPI) { if (wr == 0) PG8_BAR; }
        if constexpr (!Epi::AFTER_DRAIN) { E(acc, cur, wr, wc, fr, fq); S.done(cur); }
        if (!has_next) break;
#pragma unroll
        for (int a = 0; a < 2; ++a)
#pragma unroll
            for (int b = 0; b < 2; ++b)
#pragma unroll
                for (int m = 0; m < 4; ++m)
#pragma unroll
                    for (int n = 0; n < 2; ++n) acc[a][b][m][n] = (f32x4){0.f, 0.f, 0.f, 0.f};
        cur = nxt; cA = nA; cB = nB; ++ui;
        if constexpr (ALIGN_EPI) { if (wr == 1) PG8_BAR; }
    }
    PG8_WAIT_V(0);
    if constexpr (!ALIGN_EPI) { if (wr == 0) PG8_BAR; }
    PG8_BAR;
    if constexpr (Epi::AFTER_DRAIN) { E.fused(acc, cur, wr, wc, fr, fq, lds, wid, lane); S.done(cur); }
#undef PG8_SA
#undef PG8_SB
#undef PG8_STAGE
#undef PG8_LDA
#undef PG8_LDB
#undef PG8_MMA
#undef PG8_WAIT_V
#undef PG8_WAIT_L
#undef PG8_BAR
#undef PG8_SCHED
}
}
namespace att {
typedef unsigned short bf16_t;
using bf16x8 = __attribute__((ext_vector_type(8))) short;
using s16x4 = __attribute__((ext_vector_type(4))) short;
using f32x16 = __attribute__((ext_vector_type(16))) float;
using u32x4 = __attribute__((ext_vector_type(4))) unsigned;
typedef __attribute__((address_space(3))) char* lds_ptr;
typedef __attribute__((address_space(3))) const char* lds_cptr;
constexpr int PITCH = 2048, KVBLK = 64, QB = 256, SEQ = 16384;
constexpr int KSLOT = 8192, VSLOT = 16384, NSLOT = 3;
constexpr int LDS_K = 0, LDS_V = NSLOT * KSLOT, LDS_WS = LDS_V + NSLOT * VSLOT, LDS_OST = LDS_WS + 8 * 256, LDS_END = LDS_OST + 8 * 8192;
constexpr float THR = 8.0f;
#define ATT_SBAR() __builtin_amdgcn_sched_barrier(0)
#define ATT_WAIT_BAR(N) asm volatile("s_waitcnt vmcnt(" #N ") lgkmcnt(0)\n\ts_barrier" ::: "memory")
__device__ __forceinline__ void glds16(const void* gsrc, unsigned lds_dst) { unsigned keep;
    asm volatile("s_mov_b32 %0, m0\n\ts_mov_b32 m0, %2\n\ts_nop 0\n\tglobal_load_lds_dwordx4 %1, off\n\ts_mov_b32 m0, %0" : "=&s"(keep) : "v"(gsrc), "s"(lds_dst) : "memory"); }
__device__ __forceinline__ unsigned cvtpk(float lo, float hi) { unsigned r; asm("v_cvt_pk_bf16_f32 %0, %1, %2" : "=v"(r) : "v"(lo), "v"(hi)); return r; }
__device__ __forceinline__ int crow(int r, int hi) { return (r & 3) + 8 * (r >> 2) + 4 * hi; }

__device__ __forceinline__ void attn_unit(int h, int c, int qb, const bf16_t* Q, const bf16_t* __restrict__ K, const bf16_t* __restrict__ V, bf16_t* O, lds_ptr shm, float sl2, int t_start) {
    const int tid = ftid(), lane = tid & 63, r32 = lane & 31, hi = lane >> 5; const int wid = __builtin_amdgcn_readfirstlane(tid >> 6);
    const int q0 = qb * QB;
    const bf16_t* Qw = Q + (size_t)(q0 + wid * 32) * PITCH + h * 128 + c * 64;
    const bf16_t* Kh = K + h * 128 + c * 64; const bf16_t* Vh = V + h * 128;
    const unsigned lds0 = (unsigned)(uintptr_t)shm;
    __attribute__((address_space(3))) float* wsf = (__attribute__((address_space(3))) float*)(shm + LDS_WS) + wid * 64;
    const bf16_t* ksrc = Kh + (size_t)lane * PITCH + wid * 8;
    const bf16_t* vsrc0 = Vh + (size_t)(16 * (wid & 3) + (lane >> 2)) * PITCH + (wid >> 2) * 32 + (lane & 3) * 8;
    const bf16_t* vsrc1 = vsrc0 + 64;
    const unsigned kdst = lds0 + LDS_K + wid * 1024, vdst0 = lds0 + LDS_V + wid * 1024, vdst1 = vdst0 + 8192;
#define ATT_DMA(t, sl) do { const size_t go_ = (size_t)(t) * KVBLK * PITCH; \
        glds16(ksrc + go_, (unsigned)__builtin_amdgcn_readfirstlane(kdst + (sl) * KSLOT)); \
        glds16(vsrc0 + go_, (unsigned)__builtin_amdgcn_readfirstlane(vdst0 + (sl) * VSLOT)); \
        glds16(vsrc1 + go_, (unsigned)__builtin_amdgcn_readfirstlane(vdst1 + (sl) * VSLOT)); } while (0)
    const int vb0 = (int)(lds0 + LDS_V) + ((lane >> 4) & 1) * 32 + (lane & 3) * 8 + (4 * hi + ((lane & 15) >> 2)) * 64;
    const lds_cptr kp0 = (lds_cptr)shm + LDS_K + hi * 1024 + r32 * 16;
    const int NT = (q0 + QB) / KVBLK, n = NT - t_start;
    bf16x8 qr[4];
#pragma unroll
    for (int d0 = 0; d0 < 4; ++d0) qr[d0] = *reinterpret_cast<const bf16x8*>(Qw + (size_t)r32 * PITCH + d0 * 16 + hi * 8);
    asm volatile("s_waitcnt vmcnt(0)" ::: "memory");
#pragma unroll
    for (int d0 = 0; d0 < 4; ++d0) asm volatile("" : "+v"(qr[d0]));
    ATT_DMA(t_start, 0); ATT_DMA(t_start + 1, 1);
    f32x16 kbv;
#pragma unroll
    for (int r = 0; r < 16; ++r) kbv[r] = sl2 * (float)((r & 3) + 8 * (r >> 2));
    const float sl32 = 32.0f * sl2;
    const int qpos = q0 + wid * 32 + r32;
    float mref = 0.f, l_reg = 0.f; f32x16 o[4];
#pragma unroll
    for (int d = 0; d < 4; ++d) o[d] = f32x16{};
    int slot = 0;
    for (int i = 0; i < n; ++i) {
        const int t = t_start + i;
        if (i + 1 < n) { ATT_WAIT_BAR(3); } else { ATT_WAIT_BAR(0); }
        if (i + 2 < n) { const int s2 = (slot == 0) ? 2 : slot - 1; ATT_DMA(t + 2, s2); }
        const int d0i = 64 * t + 4 * hi - qpos;
        const float base0 = sl2 * (float)d0i - mref;
        f32x16 p0, p1;
#pragma unroll
        for (int r = 0; r < 16; ++r) { p0[r] = kbv[r] + base0; p1[r] = kbv[r] + (base0 + sl32); }
        { const lds_cptr kb = kp0 + slot * KSLOT;
#pragma unroll
          for (int d0 = 0; d0 < 4; ++d0) {
              const bf16x8 b0 = *reinterpret_cast<const __attribute__((address_space(3))) bf16x8*>(kb + d0 * 2048);
              const bf16x8 b1 = *reinterpret_cast<const __attribute__((address_space(3))) bf16x8*>(kb + d0 * 2048 + 512);
              p0 = __builtin_amdgcn_mfma_f32_32x32x16_bf16(b0, qr[d0], p0, 0, 0, 0);
              p1 = __builtin_amdgcn_mfma_f32_32x32x16_bf16(b1, qr[d0], p1, 0, 0, 0); } }
        if (t >= NT - 4) {
#pragma unroll
            for (int r = 0; r < 16; ++r) { const int kv = d0i + (r & 3) + 8 * (r >> 2); if (kv > 0) p0[r] = -__builtin_inff(); if (kv + 32 > 0) p1[r] = -__builtin_inff(); }
        }
        float rm;
        { float a = __builtin_fmaxf(__builtin_fmaxf(p0[0], p0[1]), p1[0]), b = __builtin_fmaxf(__builtin_fmaxf(p0[2], p0[3]), p1[1]); a = __builtin_fmaxf(__builtin_fmaxf(a, p1[2]), p1[3]);
#pragma unroll
          for (int r = 4; r < 16; r += 4) { a = __builtin_fmaxf(__builtin_fmaxf(a, p0[r]), p0[r + 1]); b = __builtin_fmaxf(__builtin_fmaxf(b, p0[r + 2]), p0[r + 3]);
                                            a = __builtin_fmaxf(__builtin_fmaxf(a, p1[r]), p1[r + 1]); b = __builtin_fmaxf(__builtin_fmaxf(b, p1[r + 2]), p1[r + 3]); }
          rm = __builtin_fmaxf(a, b);
          auto rr = __builtin_amdgcn_permlane32_swap(__float_as_uint(rm), __float_as_uint(rm), false, false);
          rm = __builtin_fmaxf(__uint_as_float(rr[0]), __uint_as_float(rr[1])); }
        const bool first = (i == 0);
        if (first || __any(rm > THR)) {
            const float dl = first ? rm : __builtin_fmaxf(rm, 0.f);
            mref += dl;
#pragma unroll
            for (int r = 0; r < 16; ++r) { p0[r] -= dl; p1[r] -= dl; }
            if (!first) {
                const float f = __builtin_amdgcn_exp2f(-dl);
                l_reg *= f;
                if (hi == 0) wsf[r32] = f;
                float fr_[16];
#pragma unroll
                for (int r = 0; r < 16; ++r) fr_[r] = wsf[crow(r, hi)];
#pragma unroll
                for (int d = 0; d < 4; ++d)
#pragma unroll
                    for (int r = 0; r < 16; ++r) o[d][r] *= fr_[r];
            }
        }
        float sacc = 0.f;
#pragma unroll
        for (int r = 0; r < 16; ++r) { p0[r] = __builtin_amdgcn_exp2f(p0[r]); p1[r] = __builtin_amdgcn_exp2f(p1[r]); }
#pragma unroll
        for (int r = 0; r < 16; ++r) sacc += p0[r] + p1[r];
        l_reg += sacc;
        u32x4 pw0, pw1, pw2, pw3;
        pw0 = (u32x4){cvtpk(p0[0], p0[1]), cvtpk(p0[2], p0[3]), cvtpk(p0[4], p0[5]), cvtpk(p0[6], p0[7])};
        pw1 = (u32x4){cvtpk(p0[8], p0[9]), cvtpk(p0[10], p0[11]), cvtpk(p0[12], p0[13]), cvtpk(p0[14], p0[15])};
        pw2 = (u32x4){cvtpk(p1[0], p1[1]), cvtpk(p1[2], p1[3]), cvtpk(p1[4], p1[5]), cvtpk(p1[6], p1[7])};
        pw3 = (u32x4){cvtpk(p1[8], p1[9]), cvtpk(p1[10], p1[11]), cvtpk(p1[12], p1[13]), cvtpk(p1[14], p1[15])};
        { const int vb = vb0 + slot * VSLOT;
          const bf16x8 pa0 = __builtin_bit_cast(bf16x8, pw0), pa1 = __builtin_bit_cast(bf16x8, pw1), pa2 = __builtin_bit_cast(bf16x8, pw2), pa3 = __builtin_bit_cast(bf16x8, pw3);
#pragma unroll
          for (int d0 = 0; d0 < 4; ++d0) { s16x4 lo[4], hh[4];
#pragma unroll
              for (int ks = 0; ks < 4; ++ks) {
                  asm volatile("ds_read_b64_tr_b16 %0,%1 offset:%c2" : "=&v"(lo[ks]) : "v"(vb), "i"(d0 * 4096 + ks * 1024) : "memory");
                  asm volatile("ds_read_b64_tr_b16 %0,%1 offset:%c2" : "=&v"(hh[ks]) : "v"(vb), "i"(d0 * 4096 + ks * 1024 + 512) : "memory"); }
              asm volatile("s_waitcnt lgkmcnt(0)" ::: "memory"); ATT_SBAR();
#define ATT_PK(k) (bf16x8){lo[k][0], lo[k][1], lo[k][2], lo[k][3], hh[k][0], hh[k][1], hh[k][2], hh[k][3]}
              o[d0] = __builtin_amdgcn_mfma_f32_32x32x16_bf16(pa0, ATT_PK(0), o[d0], 0, 0, 0);
              o[d0] = __builtin_amdgcn_mfma_f32_32x32x16_bf16(pa1, ATT_PK(1), o[d0], 0, 0, 0);
              o[d0] = __builtin_amdgcn_mfma_f32_32x32x16_bf16(pa2, ATT_PK(2), o[d0], 0, 0, 0);
              o[d0] = __builtin_amdgcn_mfma_f32_32x32x16_bf16(pa3, ATT_PK(3), o[d0], 0, 0, 0);
#undef ATT_PK
          } }
        slot = (slot == 2) ? 0 : slot + 1;
    }
    { auto rr = __builtin_amdgcn_permlane32_swap(__float_as_uint(l_reg), __float_as_uint(l_reg), false, false); l_reg = __uint_as_float(rr[0]) + __uint_as_float(rr[1]); }
    if (hi == 0) wsf[32 + r32] = l_reg;
    float rli[16];
#pragma unroll
    for (int r = 0; r < 16; ++r) rli[r] = 1.0f / wsf[32 + crow(r, hi)];
    { __attribute__((address_space(3))) bf16_t* stg = (__attribute__((address_space(3))) bf16_t*)(shm + LDS_OST) + wid * 4096;
#pragma unroll
      for (int r = 0; r < 16; ++r) { const int orow = crow(r, hi);
#pragma unroll
          for (int d0 = 0; d0 < 4; ++d0) { const float v = o[d0][r] * rli[r]; stg[orow * 128 + d0 * 32 + r32] = (bf16_t)(cvtpk(v, v) & 0xffffu); } }
      asm volatile("s_waitcnt lgkmcnt(0)" ::: "memory");
      bf16_t* Ow = O + (size_t)(q0 + wid * 32) * PITCH + h * 128;
#pragma unroll
      for (int it = 0; it < 8; ++it) { const int row = it * 4 + (lane >> 4), ch = lane & 15;
          const u32x4 v = *(const __attribute__((address_space(3))) u32x4*)(stg + row * 128 + ch * 8);
          *(u32x4*)(Ow + (size_t)row * PITCH + ch * 8) = v; } }
    asm volatile("s_waitcnt vmcnt(0) lgkmcnt(0)\n\ts_barrier" ::: "memory");
#undef ATT_DMA
}
#undef ATT_SBAR
#undef ATT_WAIT_BAR
}

constexpr int NWAVES = 8;
constexpr int N_LAUNCHES = MK_N_LAUNCHES;
constexpr int N_PHASES = 13;
constexpr int SEQ = 16384, DM = 4096, DIN = 18432, DRNN = 2048, DFF = 11008, NUP = 2 * DFF  ;
constexpr float EPS = 1e-6f;
constexpr float QSCALE = 0.125f * 1.4426950408889634f;
constexpr float LOG2E = 1.4426950408889634f;
constexpr size_t MiB = 1u << 20;
constexpr size_t WS_CTL = 0, CTL_ZERO_BYTES = 1 * MiB;
constexpr size_t WS_MOD = 1 * MiB;
constexpr size_t WS_RGW = 2 * MiB;
constexpr size_t WS_CA = 4 * MiB, WS_CB = 6 * MiB, WS_HC = 8 * MiB;
constexpr size_t WS_WIN = 16 * MiB;
constexpr size_t WS_WPA = 160 * MiB, WS_WPR = 176 * MiB;
constexpr size_t WS_WOUT = 192 * MiB;
constexpr size_t WS_WUP = 224 * MiB;
constexpr size_t WS_WDN = 396 * MiB;
constexpr size_t WS_H = 482 * MiB;
constexpr size_t WS_Q = 610 * MiB, WS_K = 674 * MiB, WS_V = 738 * MiB;
constexpr size_t WS_RX = 802 * MiB, WS_RG = 866 * MiB;
constexpr size_t WS_GA = 930 * MiB, WS_GB = 1058 * MiB;
constexpr size_t WS_O1 = 1186 * MiB, WS_O2 = 1250 * MiB;
constexpr size_t WS_MIX = 1314 * MiB;
constexpr size_t WS_GU = 610 * MiB;
constexpr size_t WS_ACT = 16 * MiB;
constexpr size_t WS_END = 1442 * MiB;
static_assert(WS_GU + (size_t)SEQ * NUP * 2 <= WS_MIX + 128 * MiB && WS_ACT + (size_t)SEQ * DFF * 2 <= WS_WDN, "d_ws map");
constexpr int CW_BAR = 4096;
constexpr int CW_ATTQ = 8192;
constexpr int RING_OFF = 0;
constexpr int LDSCTL_OFF = 143360, MISC_OFF = LDSCTL_OFF + 320;
constexpr int LDS_BYTES = 147456;
static_assert(att::LDS_END <= LDSCTL_OFF && MISC_OFF + 128 <= LDS_BYTES, "LDS map");
#define GAS __attribute__((address_space(1)))
#define LAS __attribute__((address_space(3)))
typedef unsigned short bf16;
typedef unsigned v4u __attribute__((ext_vector_type(4)));
typedef float f32x4 __attribute__((ext_vector_type(4)));
typedef short bf16x8 __attribute__((ext_vector_type(8)));
typedef GAS unsigned gu32;
typedef GAS unsigned long long gu64;
#define RLX_AGENT __ATOMIC_RELAXED, __HIP_MEMORY_SCOPE_AGENT
#define LDS_WAIT() asm volatile("s_waitcnt lgkmcnt(0)" ::: "memory")
#define VM_WAIT() asm volatile("s_waitcnt vmcnt(0)" ::: "memory")
__device__ __forceinline__ unsigned long long rt() { return __builtin_amdgcn_s_memrealtime(); }
__device__ __forceinline__ unsigned f2bf(float f) { unsigned u = __builtin_bit_cast(unsigned, f); return (u + 0x7fffu + ((u >> 16) & 1u)) >> 16; }
__device__ __forceinline__ unsigned pk2(float lo, float hi) { return f2bf(lo) | (f2bf(hi) << 16); }

#define XB_TMO      128
#define XB_XCNT(j)  (256  + 64 * (j))
#define XB_XSUB(j)  (1280 + 64 * (j))
#define XB_XGEN(j)  (2304 + 64 * (j))
#define XB_TOP      3328
#define XB_TOPGEN   3392
#define XCD_BAR_WORDS 3456
#define XB_SPIN_CAP (1u << 18)

__device__ __forceinline__ unsigned xb_ld(unsigned* p)              { return __hip_atomic_load(p, __ATOMIC_RELAXED, __HIP_MEMORY_SCOPE_AGENT); }
__device__ __forceinline__ unsigned xb_add(unsigned* p, unsigned v) { return __hip_atomic_fetch_add(p, v, __ATOMIC_RELAXED, __HIP_MEMORY_SCOPE_AGENT); }
__device__ __forceinline__ unsigned xb_xcc_id() { return (unsigned)__builtin_amdgcn_s_getreg((3 << 11) | 20) & 0xFu; }
#define XB_SPIN(cond, bar) do { unsigned _sp = 0; while (cond) { __builtin_amdgcn_s_sleep(1); \
    if ((++_sp & 255u) == 0u) { if (xb_ld(&(bar)[XB_TMO])) break; if (_sp > XB_SPIN_CAP) { atomicAdd(&(bar)[XB_TMO], 1u); break; } } } } while (0)

struct XcdBarrier {
    unsigned* bar; unsigned x;
    volatile LAS unsigned* st;
};

__device__ __forceinline__ XcdBarrier xcd_barrier_post(unsigned* bar, volatile LAS unsigned* st) {
    XcdBarrier b; b.bar = bar; b.x = xb_xcc_id(); b.st = st;
    if (threadIdx.x == 0) (void)xb_add(&bar[XB_XCNT(b.x)], 1u);
    return b;
}
__device__ __forceinline__ void xcd_barrier_complete(unsigned* bar, unsigned x, unsigned& nloc, unsigned& nx) {
    const unsigned G = gridDim.x * gridDim.y * gridDim.z;
    unsigned sum, cnt, mine, sp = 0u;
    for (;;) {
        sum = 0u; cnt = 0u; mine = 0u;
#pragma unroll
        for (unsigned j = 0; j < 16; ++j) { const unsigned c = xb_ld(&bar[XB_XCNT(j)]); sum += c; cnt += (c > 0u) ? 1u : 0u; mine = (j == x) ? c : mine; }
        if (sum == G) break;
        __builtin_amdgcn_s_sleep(1);
        if ((++sp & 255u) == 0u) { if (xb_ld(&bar[XB_TMO])) break; if (sp > XB_SPIN_CAP) { atomicAdd(&bar[XB_TMO], 1u); break; } }
    }
    nloc = mine > 0u ? mine : 1u; nx = cnt > 0u ? cnt : 1u;
}

__device__ __forceinline__ void xcd_barrier(const XcdBarrier& b) {
    asm volatile("s_waitcnt vmcnt(0)" ::: "memory");
    __syncthreads();
    if (threadIdx.x == 0) {
        unsigned* bar = b.bar;
        __builtin_amdgcn_s_waitcnt(0);
        unsigned nloc = b.st[0], nx = b.st[1];
        if (nloc == 0u) { xcd_barrier_complete(bar, b.x, nloc, nx); b.st[0] = nloc; b.st[1] = nx; }
        const unsigned old = xb_add(&bar[XB_XSUB(b.x)], 1u);
        const unsigned gen = old / nloc;
        if (old + 1u == (gen + 1u) * nloc) {
            __builtin_amdgcn_fence(__ATOMIC_RELEASE, "agent");
            asm volatile("s_waitcnt vmcnt(0)" ::: "memory");
            const unsigned og = xb_add(&bar[XB_TOP], 1u);
            const unsigned tg = og / nx;
            if (og + 1u == (tg + 1u) * nx) xb_add(&bar[XB_TOPGEN], 1u);
            else XB_SPIN(xb_ld(&bar[XB_TOPGEN]) == tg, bar);
            __builtin_amdgcn_fence(__ATOMIC_ACQUIRE, "agent");
            xb_add(&bar[XB_XGEN(b.x)], 1u);
            asm volatile("s_waitcnt vmcnt(0)" ::: "memory");
        } else {
            XB_SPIN(xb_ld(&bar[XB_XGEN(b.x)]) == gen, bar);
            __builtin_amdgcn_fence(__ATOMIC_ACQUIRE, "agent");
            asm volatile("s_waitcnt vmcnt(0)" ::: "memory");
        }
    }
    __syncthreads();
}
struct Frame {
    LAS unsigned char* lds;
    volatile LAS unsigned* MISC;
    gu32* ctl;
    int tid, lane, wave;
    int vcu, G;
};
__device__ __forceinline__ float wave_sum(float v) {
#pragma unroll
    for (int o = 1; o < 64; o <<= 1) v += __shfl_xor(v, o);
    return v;
}
__device__ __forceinline__ unsigned pkbf(float lo, float hi) { unsigned r; asm("v_cvt_pk_bf16_f32 %0, %1, %2" : "=v"(r) : "v"(lo), "v"(hi)); return r; }
__device__ __forceinline__ float bflo(unsigned w) { return __uint_as_float(w << 16); }
__device__ __forceinline__ float bfhi(unsigned w) { return __uint_as_float(w & 0xffff0000u); }
__device__ __forceinline__ float sigmoidf_(float v) { return __builtin_amdgcn_rcpf(1.0f + __builtin_amdgcn_exp2f(-LOG2E * v)); }
__device__ __forceinline__ float gelu_tanhf_(float v) { const float u = v * (0.7978845608028654f + 0.035677408136300125f * v * v);
    return v * __builtin_amdgcn_rcpf(1.0f + __builtin_amdgcn_exp2f(-2.8853900817779268f * u)); }

__device__ __forceinline__ void transpose_item(const float* W, int K, int N, bf16* WT, int k0, int n0, int rowbase, LAS float* scr, int lane) {
#pragma unroll 8
    for (int i = 0; i < 32; ++i) { const int kk = 2 * i + (lane >> 5); scr[kk * 33 + (lane & 31)] = W[(size_t)(k0 + kk) * N + n0 + (lane & 31)]; }
    LDS_WAIT(); asm volatile("" ::: "memory");
    const int c = lane & 7;
#pragma unroll
    for (int j = 0; j < 4; ++j) { const int n = (lane >> 3) + 8 * j; const LAS float* s = scr + (8 * c) * 33 + n;
        v4u o; o.x = pkbf(s[0 * 33], s[1 * 33]); o.y = pkbf(s[2 * 33], s[3 * 33]); o.z = pkbf(s[4 * 33], s[5 * 33]); o.w = pkbf(s[6 * 33], s[7 * 33]);
        *(GAS v4u*)(WT + (size_t)(rowbase + n) * K + k0 + 8 * c) = o; }
    LDS_WAIT(); asm volatile("" ::: "memory");
}
__device__ __forceinline__ void transpose_matrix_item(const float* W, int K, int N, bf16* WT, int item, int mode, LAS float* scr, int lane) {
    const int nblk = N / 32, kb = item / nblk, nb = item % nblk, n0 = 32 * nb;
    int rowbase = n0;
    if (mode == 1) { rowbase = (n0 < DFF) ? (n0 / 128) * 256 + (n0 % 128) : ((n0 - DFF) / 128) * 256 + 128 + ((n0 - DFF) % 128); }
    transpose_item(W, K, N, WT, 64 * kb, n0, rowbase, scr, lane);
}

__device__ __forceinline__ void norm_row_to_bf16(const float* xrow, bf16* orow, const LAS float* avec, const LAS float* bvec, int lane) {
    asm volatile("" ::: "memory");
    const GAS f32x4* xr = (const GAS f32x4*)xrow + lane;
    f32x4 v[16]; float s = 0.f;
#pragma unroll
    for (int j = 0; j < 16; ++j) { v[j] = xr[64 * j]; s += (v[j].x * v[j].x + v[j].y * v[j].y) + (v[j].z * v[j].z + v[j].w * v[j].w); }
    const float rstd = 1.0f / sqrtf(wave_sum(s) * (1.f / DM) + EPS);
    GAS unsigned long long* o8 = (GAS unsigned long long*)orow + lane;
#pragma unroll
    for (int j = 0; j < 16; ++j) { const f32x4 a = *(const LAS f32x4*)(avec + 256 * j + 4 * lane), b = *(const LAS f32x4*)(bvec + 256 * j + 4 * lane);
        const f32x4 y = v[j] * rstd * a + b;
        o8[64 * j] = (unsigned long long)pkbf(y.x, y.y) | ((unsigned long long)pkbf(y.z, y.w) << 32);
        if ((j & 3) == 3) __builtin_amdgcn_sched_barrier(0); }
}
namespace rgl {
constexpr int T = 64;
constexpr int L_XRF = 0, L_AF = 32768, L_BF = 65536, L_XRB = 98304, L_SA = 115712, L_SB = 117760, L_END = 119808;
typedef short bf16x8 __attribute__((ext_vector_type(8)));
struct Ptrs { const bf16* RX; const bf16* RGg; const float* conv_w; const float* conv_b; const bf16* Wt; const float* b_a; const float* b_x; const float* lam; float* CA; float* CB; const float* HC; bf16* YREC; };
template <int PASS> __device__ __forceinline__ void unit(const Ptrs& P, int n, int ch, LAS unsigned char* lds, int tid, const bf16x8 (&bw)[2][4], float bias_a, float bias_x, float sp) {
    const int lane = tid & 63, wid = tid >> 6, cbase = n * 128, t0 = ch * T;
    LAS float* XRF = (LAS float*)(lds + L_XRF); LAS float* AF = (LAS float*)(lds + L_AF); LAS float* BF = (LAS float*)(lds + L_BF);
    LAS float* SA = (LAS float*)(lds + L_SA); LAS float* SB = (LAS float*)(lds + L_SB);
#pragma unroll
    for (int jj = 0; jj < 2; ++jj) { const int it = tid + 512 * jj, r = it >> 4, g = it & 15, t = t0 + r, col = cbase + 8 * g;
        float xr[8];
        { const f32x4 b0 = *(const GAS f32x4*)(P.conv_b + col), b1 = *(const GAS f32x4*)(P.conv_b + col + 4);
          xr[0] = b0.x; xr[1] = b0.y; xr[2] = b0.z; xr[3] = b0.w; xr[4] = b1.x; xr[5] = b1.y; xr[6] = b1.z; xr[7] = b1.w; }
#pragma unroll
        for (int j = 0; j < 4; ++j) { const int ts = t - 3 + j;
            if (ts >= 0) { const v4u x = *(const GAS v4u*)(P.RX + (size_t)ts * DRNN + col);
                const f32x4 w0 = *(const GAS f32x4*)(P.conv_w + j * DRNN + col), w1 = *(const GAS f32x4*)(P.conv_w + j * DRNN + col + 4);
                xr[0] += w0.x * bflo(x.x); xr[1] += w0.y * bfhi(x.x); xr[2] += w0.z * bflo(x.y); xr[3] += w0.w * bfhi(x.y);
                xr[4] += w1.x * bflo(x.z); xr[5] += w1.y * bfhi(x.z); xr[6] += w1.z * bflo(x.w); xr[7] += w1.w * bfhi(x.w); } }
        *(LAS f32x4*)(XRF + r * 128 + 8 * g) = (f32x4){xr[0], xr[1], xr[2], xr[3]}; *(LAS f32x4*)(XRF + r * 128 + 8 * g + 4) = (f32x4){xr[4], xr[5], xr[6], xr[7]};
        v4u pk; pk.x = pkbf(xr[0], xr[1]); pk.y = pkbf(xr[2], xr[3]); pk.z = pkbf(xr[4], xr[5]); pk.w = pkbf(xr[6], xr[7]);
        *(LAS v4u*)(lds + L_XRB + r * 272 + 16 * g) = pk; }
    __syncthreads();
    { const int fi = lane & 15, kq = lane >> 4;
#pragma unroll
      for (int rt = 0; rt < 4; ++rt) { f32x4 da = (f32x4){0.f, 0.f, 0.f, 0.f}, dx = da;
#pragma unroll
          for (int s = 0; s < 4; ++s) { const bf16x8 af = *(const LAS bf16x8*)(lds + L_XRB + (16 * rt + fi) * 272 + (32 * s + 8 * kq) * 2);
              da = __builtin_amdgcn_mfma_f32_16x16x32_bf16(af, bw[0][s], da, 0, 0, 0);
              dx = __builtin_amdgcn_mfma_f32_16x16x32_bf16(af, bw[1][s], dx, 0, 0, 0); }
          const int e = 16 * wid + fi;
#pragma unroll
          for (int q = 0; q < 4; ++q) { const int t = 16 * rt + 4 * kq + q;
              const float r = sigmoidf_(da[q] + bias_a), ig = sigmoidf_(dx[q] + bias_x);
              const float la = -8.0f * r * sp, a = __expf(la);
              const float bxv = sqrtf(-expm1f(2.0f * la)) * ig * XRF[t * 128 + e];
              AF[t * 128 + e] = a; BF[t * 128 + e] = bxv; } } }
    __syncthreads();
    const int e = tid & 127, sub = tid >> 7;
    { float A = 1.f, B = 0.f;
#pragma unroll
      for (int q = 0; q < 16; ++q) { const int t = 16 * sub + q; const float a = AF[t * 128 + e], b = BF[t * 128 + e]; B = a * B + b; A = A * a; }
      SA[sub * 128 + e] = A; SB[sub * 128 + e] = B; }
    __syncthreads();
    if (PASS == 1) {
        if (tid < 128) { float A = 1.f, B = 0.f;
#pragma unroll
            for (int s = 0; s < 4; ++s) { const float a = SA[s * 128 + e], b = SB[s * 128 + e]; B = a * B + b; A = A * a; }
            P.CA[(size_t)ch * DRNN + cbase + e] = A; P.CB[(size_t)ch * DRNN + cbase + e] = B; }
    } else {
        float hst = P.HC[(size_t)ch * DRNN + cbase + e];
        for (int s = 0; s < sub; ++s) hst = SA[s * 128 + e] * hst + SB[s * 128 + e];
#pragma unroll
        for (int q = 0; q < 16; ++q) { const int t = 16 * sub + q; hst = AF[t * 128 + e] * hst + BF[t * 128 + e]; AF[t * 128 + e] = hst; }
        __syncthreads();
#pragma unroll
        for (int jj = 0; jj < 2; ++jj) { const int it = tid + 512 * jj, r = it >> 4, g = it & 15, t = t0 + r, col = cbase + 8 * g;
            const v4u gg = *(const GAS v4u*)(P.RGg + (size_t)t * DRNN + col);
            const f32x4 h0 = *(const LAS f32x4*)(AF + r * 128 + 8 * g), h1 = *(const LAS f32x4*)(AF + r * 128 + 8 * g + 4);
            v4u pk; pk.x = pkbf(h0.x * bflo(gg.x), h0.y * bfhi(gg.x)); pk.y = pkbf(h0.z * bflo(gg.y), h0.w * bfhi(gg.y));
            pk.z = pkbf(h1.x * bflo(gg.z), h1.y * bfhi(gg.z)); pk.w = pkbf(h1.z * bflo(gg.w), h1.w * bfhi(gg.w));
            *(GAS v4u*)(P.YREC + (size_t)t * DRNN + col) = pk; }
    }
    __syncthreads();
}
template <int PASS> __device__ __forceinline__ void phase(const Ptrs& P, LAS unsigned char* lds, int tid, int G) {
    const int lane = tid & 63, wid = tid >> 6, fi = lane & 15, kq = lane >> 4;
    int ncur = -1; bf16x8 bw[2][4]; float bias_a = 0.f, bias_x = 0.f, sp = 0.f;
#pragma unroll
    for (int g = 0; g < 2; ++g)
#pragma unroll
        for (int s = 0; s < 4; ++s) bw[g][s] = (bf16x8){0, 0, 0, 0, 0, 0, 0, 0};
    for (int u = blockIdx.x; u < 16 * (SEQ / T); u += G) {
        const int n = u & 15, ch = u >> 4;
        if (n != ncur) { ncur = n; const int e = 16 * wid + fi;
#pragma unroll
            for (int g = 0; g < 2; ++g)
#pragma unroll
                for (int s = 0; s < 4; ++s) bw[g][s] = *(const GAS bf16x8*)(P.Wt + ((size_t)(g * 16 + n) * 128 + e) * 128 + 32 * s + 8 * kq);
            bias_a = P.b_a[n * 128 + e]; bias_x = P.b_x[n * 128 + e]; sp = log1pf(__expf(-P.lam[n * 128 + e])); }
        unit<PASS>(P, n, ch, lds, tid, bw, bias_a, bias_x, sp);
    }
}
}

struct Args { const float* in[27]; float* out; unsigned char* ws; int ph_lo, ph_hi; };
__global__ void __launch_bounds__(NWAVES * 64, 2) mk_fwd(Args args) {
    extern __shared__ __attribute__((aligned(16))) unsigned char lds[];
    Frame F;
    F.lds = (LAS unsigned char*)lds;
    F.MISC = (volatile LAS unsigned*)(F.lds + MISC_OFF);
    F.tid = ftid(); F.lane = F.tid & 63; F.wave = __builtin_amdgcn_readfirstlane(F.tid >> 6);
    F.G = gridDim.x; { const int bx = blockIdx.x; F.vcu = (F.G % 8 == 0) ? (bx % 8) * (F.G / 8) + bx / 8 : bx; }
    unsigned char* ws = args.ws;
    F.ctl = (gu32*)(ws + WS_CTL);
    for (int u = F.tid; u < (LDS_BYTES - LDSCTL_OFF) / 4; u += NWAVES * 64) ((LAS unsigned*)(F.lds + LDSCTL_OFF))[u] = 0u;
    __syncthreads();
    XcdBarrier bar; bar.bar = (unsigned*)(F.ctl + CW_BAR); bar.x = 0; bar.st = nullptr;
    if (N_LAUNCHES == 1) bar = xcd_barrier_post((unsigned*)(F.ctl + CW_BAR), F.MISC + 8);
#define GRID_BAR() do { if (N_LAUNCHES == 1) xcd_barrier(bar); } while (0)
    const int lo = args.ph_lo, hi = args.ph_hi;
#define IN(k) (lo <= (k) && (k) < hi)
#define BOTH(k) (IN(k) && IN((k) + 1))
    const float* x = args.in[0]; const float* cvec = args.in[1]; const float* w_ada = args.in[2]; const float* b_ada = args.in[3]; const float* norm1_w = args.in[4];
    const float* w_in = args.in[5]; const float* lq1 = args.in[6]; const float* lk1 = args.in[7]; const float* lq2 = args.in[8]; const float* lk2 = args.in[9];
    const float* subln_w = args.in[10]; const float* conv_w = args.in[11]; const float* conv_b = args.in[12]; const float* w_rg_a = args.in[13]; const float* b_rg_a = args.in[14];
    const float* w_rg_x = args.in[15]; const float* b_rg_x = args.in[16]; const float* lru_lambda = args.in[17]; const float* w_pa = args.in[18]; const float* w_pr = args.in[19];
    const float* w_out = args.in[20]; const float* norm2_w = args.in[21]; const float* w_up = args.in[22]; const float* fconv_w = args.in[23]; const float* fconv_b = args.in[24];
    const float* w_dn = args.in[25]; const float* normf_w = args.in[26];
    float* out = args.out;
    float* MOD = (float*)(ws + WS_MOD);
    bf16* RGW = (bf16*)(ws + WS_RGW); float* CA = (float*)(ws + WS_CA); float* CB = (float*)(ws + WS_CB); float* HC = (float*)(ws + WS_HC);
    bf16* WIN = (bf16*)(ws + WS_WIN); bf16* WPA = (bf16*)(ws + WS_WPA); bf16* WPR = (bf16*)(ws + WS_WPR); bf16* WOUT = (bf16*)(ws + WS_WOUT); bf16* WUP = (bf16*)(ws + WS_WUP); bf16* WDN = (bf16*)(ws + WS_WDN);
    bf16* HB = (bf16*)(ws + WS_H); bf16* QB_ = (bf16*)(ws + WS_Q); bf16* KB = (bf16*)(ws + WS_K); bf16* VB = (bf16*)(ws + WS_V); bf16* RXB = (bf16*)(ws + WS_RX); bf16* RGB = (bf16*)(ws + WS_RG);
    bf16* GAB = (bf16*)(ws + WS_GA); bf16* GBB = (bf16*)(ws + WS_GB); bf16* O1 = (bf16*)(ws + WS_O1); bf16* O2 = (bf16*)(ws + WS_O2); bf16* MIX = (bf16*)(ws + WS_MIX);
    bf16* GU = (bf16*)(ws + WS_GU); bf16* ACT = (bf16*)(ws + WS_ACT);
    bf16* YATT = QB_; bf16* YREC = KB; bf16* M1 = HB;
    const int gw = F.vcu * NWAVES + F.wave, NGW = F.G * NWAVES;

#ifndef NO_P0
    if (IN(0)) { F.tid = ftid(); F.lane = F.tid & 63;
        { LAS float* sc_l = (LAS float*)(F.lds);
          LAS float* red = (LAS float*)(F.lds + 16384);
          for (int i = F.tid; i < DM; i += NWAVES * 64) { const float cv = cvec[i]; sc_l[i] = cv * sigmoidf_(cv); }
          __syncthreads();
          for (int cb = blockIdx.x; cb < (6 * DM) / 96; cb += F.G) {
              const int rgp = F.tid >> 5, cl = F.tid & 31;
              f32x4 a = (f32x4){0.f, 0.f, 0.f, 0.f};
              if (cl < 24) { const float* wp = w_ada + (size_t)rgp * (6 * DM) + 96 * cb + 4 * cl;
#pragma unroll 8
                  for (int k = 0; k < DM / 16; ++k) { const f32x4 w = *(const GAS f32x4*)(wp + (size_t)k * 16 * (6 * DM)); a += w * sc_l[rgp + 16 * k]; }
                  *(LAS f32x4*)(red + rgp * 96 + 4 * cl) = a; }
              __syncthreads();
              if (F.tid < 96) { float s = 0.f;
#pragma unroll
                  for (int g = 0; g < 16; ++g) s += red[g * 96 + F.tid];
                  MOD[96 * cb + F.tid] = s + b_ada[96 * cb + F.tid]; }
              __syncthreads(); } }
        { LAS float* scr = (LAS float*)(F.lds + RING_OFF + F.wave * 16384);
          constexpr int I_IN = (DM / 64) * (DIN / 32), I_PA = (2048 / 64) * (DM / 32), I_OUT = (DM / 64) * (DM / 32), I_UP = (DM / 64) * (NUP / 32), I_DN = (DFF / 64) * (DM / 32), I_RG = 16 * 2 * 4;
          constexpr int NITEMS = I_IN + 2 * I_PA + I_OUT + I_UP + I_DN + 2 * I_RG;
          for (int it = gw; it < NITEMS; it += NGW) {
              int r = it;
              if (r < I_IN) { transpose_matrix_item(w_in, DM, DIN, WIN, r, 0, scr, F.lane); continue; } r -= I_IN;
              if (r < I_PA) { transpose_matrix_item(w_pa, 2048, DM, WPA, r, 0, scr, F.lane); continue; } r -= I_PA;
              if (r < I_PA) { transpose_matrix_item(w_pr, 2048, DM, WPR, r, 0, scr, F.lane); continue; } r -= I_PA;
              if (r < I_OUT) { transpose_matrix_item(w_out, DM, DM, WOUT, r, 0, scr, F.lane); continue; } r -= I_OUT;
              if (r < I_UP) { transpose_matrix_item(w_up, DM, NUP, WUP, r, 1, scr, F.lane); continue; } r -= I_UP;
              if (r < I_DN) { transpose_matrix_item(w_dn, DFF, DM, WDN, r, 0, scr, F.lane); continue; } r -= I_DN;
              if (r < I_RG) { const int nb = r >> 3; transpose_matrix_item(w_rg_a + (size_t)nb * 16384, 128, 128, RGW + (size_t)nb * 16384, r & 7, 0, scr, F.lane); continue; } r -= I_RG;
              { const int nb = r >> 3; transpose_matrix_item(w_rg_x + (size_t)nb * 16384, 128, 128, RGW + (size_t)(16 + nb) * 16384, r & 7, 0, scr, F.lane); }
          } }
        if (BOTH(0)) GRID_BAR();
    }
#endif
#ifndef NO_P1
    if (IN(1)) { F.tid = ftid(); F.lane = F.tid & 63;
        LAS float* av = (LAS float*)(F.lds); LAS float* bv = (LAS float*)(F.lds + 16384);
        for (int i = F.tid; i < DM; i += NWAVES * 64) { av[i] = norm1_w[i] * (1.0f + MOD[DM + i]); bv[i] = MOD[i]; }
        __syncthreads();
#pragma unroll 1
        for (int m = gw; m < SEQ; m += NGW) norm_row_to_bf16(x + (size_t)m * DM, HB + (size_t)m * DM, av, bv, F.lane);
        if (BOTH(1)) GRID_BAR();
    }
#endif
#ifndef NO_P2
    if (IN(2)) { F.tid = ftid(); F.lane = F.tid & 63;
        pg8::Gemm g{HB, WIN, SEQ, DIN, DM}; pg8::StaticOrder S; S.init(SEQ, DIN, F.G, (int)blockIdx.x);
        pg8::EpiProj E{QB_, KB, VB, RXB, RGB, GAB, GBB, QSCALE};
        pg8::gemm_phase<pg8::EpiProj, pg8::StaticOrder, true, true>(F.lds + RING_OFF, g, S, E);
        if (BOTH(2)) GRID_BAR();
    }
#endif
    const rgl::Ptrs RP{RXB, RGB, conv_w, conv_b, RGW, b_rg_a, b_rg_x, lru_lambda, CA, CB, HC, YREC};
#ifndef NO_P3
    if (IN(3)) { F.tid = ftid(); F.lane = F.tid & 63;
        rgl::phase<1>(RP, F.lds, F.tid, F.G);
        if (BOTH(3)) GRID_BAR();
    }
#endif
#ifndef NO_P4
    if (IN(4)) { F.tid = ftid(); F.lane = F.tid & 63;
        if (blockIdx.x < 4) { const int e = blockIdx.x * 512 + F.tid; float hst = 0.f;
            for (int c0 = 0; c0 < SEQ / rgl::T; c0 += 8) { float a[8], b[8];
#pragma unroll
                for (int j = 0; j < 8; ++j) { a[j] = CA[(size_t)(c0 + j) * DRNN + e]; b[j] = CB[(size_t)(c0 + j) * DRNN + e]; }
#pragma unroll
                for (int j = 0; j < 8; ++j) { HC[(size_t)(c0 + j) * DRNN + e] = hst; hst = a[j] * hst + b[j]; } }
            VM_WAIT(); __syncthreads(); }
        for (;;) {
            if (F.tid == 0) F.MISC[16] = __hip_atomic_fetch_add(F.ctl + CW_ATTQ, 1u, RLX_AGENT);
            __syncthreads();
            const int idx = (int)F.MISC[16];
            __syncthreads();
            if (idx >= 2048) break;
            const int qb = 63 - (idx >> 5), hc = idx & 31, h = hc >> 1, c = hc & 1;
            const float sl2 = exp2f(-0.5f * (float)(h + 1)) * LOG2E;
            att::attn_unit(h, c, qb, QB_, KB, VB, c ? O2 : O1, (att::lds_ptr)(F.lds + RING_OFF), sl2, 0);
        }
        if (BOTH(4)) GRID_BAR();
    }
#endif
#ifndef NO_P5
    if (IN(5)) { F.tid = ftid(); F.lane = F.tid & 63;
        rgl::phase<2>(RP, F.lds, F.tid, F.G);
        float lam;
        { const float p1 = (F.lane < 64) ? lq1[F.lane] * lk1[F.lane] : 0.f, p2 = lq2[F.lane] * lk2[F.lane];
          lam = __expf(wave_sum(p1)) - __expf(wave_sum(p2)) + 0.2f; }
        float sw[8];
#pragma unroll
        for (int j = 0; j < 8; ++j) sw[j] = subln_w[8 * (F.lane & 15) + j] * 0.8f;
#pragma unroll 1
        for (int m = gw; m < SEQ; m += NGW) {
#pragma unroll
            for (int j = 0; j < 4; ++j) { const size_t off = (size_t)m * 2048 + 512 * j + 8 * F.lane;
                const v4u a = *(const GAS v4u*)(O1 + off), b = *(const GAS v4u*)(O2 + off);
                float d[8]; d[0] = bflo(a.x) - lam * bflo(b.x); d[1] = bfhi(a.x) - lam * bfhi(b.x); d[2] = bflo(a.y) - lam * bflo(b.y); d[3] = bfhi(a.y) - lam * bfhi(b.y);
                d[4] = bflo(a.z) - lam * bflo(b.z); d[5] = bfhi(a.z) - lam * bfhi(b.z); d[6] = bflo(a.w) - lam * bflo(b.w); d[7] = bfhi(a.w) - lam * bfhi(b.w);
                float ss = 0.f;
#pragma unroll
                for (int q = 0; q < 8; ++q) ss += d[q] * d[q];
                ss += __shfl_xor(ss, 1); ss += __shfl_xor(ss, 2); ss += __shfl_xor(ss, 4); ss += __shfl_xor(ss, 8);
                const float rstd = 1.0f / sqrtf(ss * (1.f / 128.f) + EPS);
                v4u o; o.x = pkbf(d[0] * rstd * sw[0], d[1] * rstd * sw[1]); o.y = pkbf(d[2] * rstd * sw[2], d[3] * rstd * sw[3]);
                o.z = pkbf(d[4] * rstd * sw[4], d[5] * rstd * sw[5]); o.w = pkbf(d[6] * rstd * sw[6], d[7] * rstd * sw[7]);
                *(GAS v4u*)(YATT + off) = o; } }
        if (BOTH(5)) GRID_BAR();
    }
#endif
#ifndef NO_P6
    if (IN(6)) { F.tid = ftid(); F.lane = F.tid & 63;
        { pg8::Gemm g{YATT, WPA, SEQ, DM, 2048}; pg8::StaticOrder S; S.init(SEQ, DM, F.G, (int)blockIdx.x);
          pg8::EpiGate<false> E{GAB, nullptr, M1};
          pg8::gemm_phase<pg8::EpiGate<false>, pg8::StaticOrder, true, true>(F.lds + RING_OFF, g, S, E); }
        VM_WAIT(); __syncthreads();
        { pg8::Gemm g{YREC, WPR, SEQ, DM, 2048}; pg8::StaticOrder S; S.init(SEQ, DM, F.G, (int)blockIdx.x);
          pg8::EpiGate<true> E{GBB, M1, MIX};
          pg8::gemm_phase<pg8::EpiGate<true>, pg8::StaticOrder, true, true>(F.lds + RING_OFF, g, S, E); }
        if (BOTH(6)) GRID_BAR();
    }
#endif
#ifndef NO_P7
    if (IN(7)) { F.tid = ftid(); F.lane = F.tid & 63;
        pg8::Gemm g{MIX, WOUT, SEQ, DM, DM}; pg8::StaticOrder S; S.init(SEQ, DM, F.G, (int)blockIdx.x);
        pg8::EpiRes E{x, out, MOD + 2 * DM};
        pg8::gemm_phase<pg8::EpiRes, pg8::StaticOrder, true, true>(F.lds + RING_OFF, g, S, E);
        if (BOTH(7)) GRID_BAR();
    }
#endif
#ifndef NO_P8
    if (IN(8)) { F.tid = ftid(); F.lane = F.tid & 63;
        LAS float* av = (LAS float*)(F.lds); LAS float* bv = (LAS float*)(F.lds + 16384);
        for (int i = F.tid; i < DM; i += NWAVES * 64) { av[i] = norm2_w[i] * (1.0f + MOD[4 * DM + i]); bv[i] = MOD[3 * DM + i]; }
        __syncthreads();
#pragma unroll 1
        for (int m = gw; m < SEQ; m += NGW) norm_row_to_bf16(out + (size_t)m * DM, HB + (size_t)m * DM, av, bv, F.lane);
        if (BOTH(8)) GRID_BAR();
    }
#endif
#ifndef NO_P9
    if (IN(9)) { F.tid = ftid(); F.lane = F.tid & 63;
        pg8::Gemm g{HB, WUP, SEQ, NUP, DM}; pg8::StaticOrder S; S.init(SEQ, NUP, F.G, (int)blockIdx.x);
        pg8::EpiPlain E{GU, NUP};
        pg8::gemm_phase<pg8::EpiPlain, pg8::StaticOrder, true, true>(F.lds + RING_OFF, g, S, E);
        if (BOTH(9)) GRID_BAR();
    }
#endif
#ifndef NO_P10
    if (IN(10)) { F.tid = ftid(); F.lane = F.tid & 63;
        constexpr int NG = DFF / 8, RCH = 32, NITEM = (SEQ / RCH) * NG;
        for (int it = blockIdx.x * (NWAVES * 64) + F.tid; it < NITEM; it += F.G * NWAVES * 64) {
            const int gidx = it % NG, rc = it / NG, tj = gidx >> 4, ti = gidx & 15, cgate = 256 * tj + 8 * ti, cact = 8 * gidx, r0 = rc * RCH;
            float w0[8], w1[8], w2[8], bb[8];
#pragma unroll
            for (int q = 0; q < 8; ++q) { w0[q] = fconv_w[cact + q]; w1[q] = fconv_w[DFF + cact + q]; w2[q] = fconv_w[2 * DFF + cact + q]; bb[q] = fconv_b[cact + q]; }
            float g1[8], g2[8];
            if (r0 >= 2) { const v4u a = *(const GAS v4u*)(GU + (size_t)(r0 - 2) * NUP + cgate), b = *(const GAS v4u*)(GU + (size_t)(r0 - 1) * NUP + cgate);
                g2[0] = bflo(a.x); g2[1] = bfhi(a.x); g2[2] = bflo(a.y); g2[3] = bfhi(a.y); g2[4] = bflo(a.z); g2[5] = bfhi(a.z); g2[6] = bflo(a.w); g2[7] = bfhi(a.w);
                g1[0] = bflo(b.x); g1[1] = bfhi(b.x); g1[2] = bflo(b.y); g1[3] = bfhi(b.y); g1[4] = bflo(b.z); g1[5] = bfhi(b.z); g1[6] = bflo(b.w); g1[7] = bfhi(b.w); }
            else {
#pragma unroll
                for (int q = 0; q < 8; ++q) { g1[q] = 0.f; g2[q] = 0.f; } }
#pragma unroll 4
            for (int r = 0; r < RCH; ++r) { const size_t ro = (size_t)(r0 + r) * NUP + cgate;
                const v4u a = *(const GAS v4u*)(GU + ro), u = *(const GAS v4u*)(GU + ro + 128);
                float g0[8], uu[8];
                g0[0] = bflo(a.x); g0[1] = bfhi(a.x); g0[2] = bflo(a.y); g0[3] = bfhi(a.y); g0[4] = bflo(a.z); g0[5] = bfhi(a.z); g0[6] = bflo(a.w); g0[7] = bfhi(a.w);
                uu[0] = bflo(u.x); uu[1] = bfhi(u.x); uu[2] = bflo(u.y); uu[3] = bfhi(u.y); uu[4] = bflo(u.z); uu[5] = bfhi(u.z); uu[6] = bflo(u.w); uu[7] = bfhi(u.w);
                float y[8];
#pragma unroll
                for (int q = 0; q < 8; ++q) { const float cv = bb[q] + w0[q] * g2[q] + w1[q] * g1[q] + w2[q] * g0[q]; y[q] = gelu_tanhf_(cv) * uu[q]; g2[q] = g1[q]; g1[q] = g0[q]; }
                v4u o; o.x = pkbf(y[0], y[1]); o.y = pkbf(y[2], y[3]); o.z = pkbf(y[4], y[5]); o.w = pkbf(y[6], y[7]);
                *(GAS v4u*)(ACT + (size_t)(r0 + r) * DFF + cact) = o; }
        }
        if (BOTH(10)) GRID_BAR();
    }
#endif
#ifndef NO_P11
    if (IN(11)) { F.tid = ftid(); F.lane = F.tid & 63;
        pg8::Gemm g{ACT, WDN, SEQ, DM, DFF}; pg8::StaticOrder S; S.init(SEQ, DM, F.G, (int)blockIdx.x);
        pg8::EpiRes E{out, out, MOD + 5 * DM};
        pg8::gemm_phase<pg8::EpiRes, pg8::StaticOrder, true, true>(F.lds + RING_OFF, g, S, E);
        if (BOTH(11)) GRID_BAR();
    }
#endif
#ifndef NO_P12
    if (IN(12)) { F.tid = ftid(); F.lane = F.tid & 63;
#pragma unroll 1
        for (int m = gw; m < SEQ; m += NGW) {
            GAS f32x4* xr = (GAS f32x4*)(out + (size_t)m * DM) + F.lane;
            f32x4 v[16]; float s = 0.f;
#pragma unroll
            for (int j = 0; j < 16; ++j) { v[j] = xr[64 * j]; s += (v[j].x * v[j].x + v[j].y * v[j].y) + (v[j].z * v[j].z + v[j].w * v[j].w); }
            const float rstd = 1.0f / sqrtf(wave_sum(s) * (1.f / DM) + EPS);
#pragma unroll
            for (int j = 0; j < 16; ++j) { const f32x4 w = *(const GAS f32x4*)(normf_w + 256 * j + 4 * F.lane); xr[64 * j] = v[j] * rstd * w; }
        }
    }
#endif
#undef IN
#undef BOTH
#undef GRID_BAR
}

extern "C" void kernel_launch(void* const* d_in, const int* in_sizes, int n_in, void* d_out, int out_size, void* d_ws, size_t ws_size, hipStream_t stream) {
    static int grid = 0;
    if (grid == 0) {
        if (n_in != 27 || out_size != SEQ * DM || ws_size < WS_END) { fprintf(stderr, "kernel_launch: unexpected problem (n_in %d, out %d, ws %zu); nothing launched\n", n_in, out_size, ws_size); grid = -1; return; }
        int dev = 0, cus = 0, per_cu = 0;
        if (hipGetDevice(&dev) != hipSuccess || hipDeviceGetAttribute(&cus, hipDeviceAttributeMultiprocessorCount, dev) != hipSuccess) { grid = -1; return; }
        if (hipFuncSetAttribute((const void*)mk_fwd, hipFuncAttributeMaxDynamicSharedMemorySize, LDS_BYTES) != hipSuccess) { fprintf(stderr, "kernel_launch: hipFuncSetAttribute failed\n"); grid = -1; return; }
        if (hipOccupancyMaxActiveBlocksPerMultiprocessor(&per_cu, (const void*)mk_fwd, NWAVES * 64, LDS_BYTES) != hipSuccess || per_cu < 1)
            fprintf(stderr, "kernel_launch: note: occupancy query reports %d workgroups per CU\n", per_cu);
        (void)hipGetLastError();
        grid = cus;
    }
    if (grid < 0) return;
    if (hipMemsetAsync((char*)d_ws + WS_CTL, 0, CTL_ZERO_BYTES, stream) != hipSuccess) return;
    Args a{};
    for (int i = 0; i < 27; ++i) a.in[i] = (const float*)d_in[i];
    a.out = (float*)d_out; a.ws = (unsigned char*)d_ws;
    for (int li = 0; li < N_LAUNCHES; ++li) {
        a.ph_lo = (N_LAUNCHES == 1) ? 0 : li; a.ph_hi = (N_LAUNCHES == 1) ? N_PHASES : li + 1;
        hipLaunchKernelGGL(mk_fwd, dim3(grid), dim3(NWAVES * 64), LDS_BYTES, stream, a);
        const hipError_t le = hipPeekAtLastError();
        if (le != hipSuccess) { fprintf(stderr, "kernel_launch: launch %d failed: %s\n", li, hipGetErrorName(le)); break; }
    }
}
```

```cpp
#include <hip/hip_runtime.h>
#include <cstdio>
#include <cstdint>
#ifndef MK_N_LAUNCHES
#define MK_N_LAUNCHES 1
#endif
__device__ __forceinline__ int ftid() { int t = (int)threadIdx.x; asm volatile("" : "+v"(t)); return t; }
namespace pg8 {
#define PG8_LAS __attribute__((address_space(3)))
typedef unsigned short bf16_t;
typedef short bf16x8 __attribute__((ext_vector_type(8)));
typedef float f32x4 __attribute__((ext_vector_type(4)));
typedef unsigned u32x4 __attribute__((ext_vector_type(4)));
constexpr int BM = 256, BK = 64, HALF = 128, HTB = HALF * BK * 2  , STAGE_BYTES = 8 * HTB, NXCD = 8, WGM = 8;

__host__ __device__ __forceinline__ int lds_byte(int r, int c) { const int st = (r >> 4) * 2 + (c >> 5), rr = r & 15, cc = c & 31, ob = rr * 64 + cc * 2; return st * 1024 + (ob ^ (((ob >> 9) & 1) << 5)); }
__host__ __device__ __forceinline__ void stage_rc(int b, int& R, int& C) { const int st = b / 1024, sb = b % 1024, swz = sb ^ (((sb >> 9) & 1) << 5); R = (st >> 1) * 16 + swz / 64; C = (st & 1) * 32 + (swz % 64) / 2; }
__host__ __device__ __forceinline__ int perm32(int rho) { const int n = rho >> 4, i = rho & 15; return 8 * (i >> 2) + 4 * n + (i & 3); }

struct Unit { int pm, pn; };
struct Gemm { const bf16_t* A; const bf16_t* Bt; int M, N, K, ld; };

struct StaticOrder {
    int nM, nN, nwg, G, c;
    __host__ __device__ void init(int M, int N, int G_, int c_) { nM = M / BM; nN = N / BM; nwg = nM * nN; G = G_; c = c_; }
    __host__ __device__ bool next(int i, Unit& u) const {
        const long L = (long)i * G + c; if (L >= nwg) return false;
        int wgid = (int)L; { const int q = nwg / NXCD, r = nwg % NXCD, xcd = wgid % NXCD, off = wgid / NXCD; wgid = (xcd < r ? xcd * (q + 1) : r * (q + 1) + (xcd - r) * q) + off; }
        const int nig = WGM * nN, gid = wgid / nig, fm = gid * WGM, gsz = (nM - fm) < WGM ? (nM - fm) : WGM;
        u.pm = fm + ((wgid % nig) % gsz); u.pn = (wgid % nig) / gsz; return true;
    }
    __device__ __forceinline__ void a_ready(const Unit&) const {}
    __device__ __forceinline__ void done(const Unit&) const {}
};

struct HalfXcdOrder : StaticOrder {
    __host__ __device__ bool next(int i, Unit& u) const {
        const int full = nwg / G;
        if (i < full) return StaticOrder::next(i, u);
        if (i > full || (nwg % G) * 2 != G || G != 256) return (nwg % G) * 2 != G || G != 256 ? StaticOrder::next(i, u) : false;
        const int xcd = c % NXCD, slot = c / NXCD, q = nwg / NXCD; if (xcd >= 4) return false;
        const int wgid = (slot < 16 ? xcd : xcd + 4) * q + full * (G / NXCD) + (slot & 15);
        const int nig = WGM * nN, gid = wgid / nig, fm = gid * WGM, gsz = (nM - fm) < WGM ? (nM - fm) : WGM;
        u.pm = fm + ((wgid % nig) % gsz); u.pn = (wgid % nig) / gsz; return true;
    }
};
struct ProjOrder16 : StaticOrder {
    __host__ __device__ bool next(int i, Unit& u) const { if (!StaticOrder::next(i, u)) return false; u.pn = u.pn < 8 ? u.pn : (u.pn < 24 ? u.pn + 16 : u.pn + 32); return true; }
};
struct StaticOrderFixed : StaticOrder {
    __host__ __device__ bool next(int i, Unit& u) const { const long L = (long)i * G + c; if (L >= nwg) return false; StaticOrder t = *this; return t.StaticOrder::next(0, u); }
};
__device__ __forceinline__ unsigned cvt_pk_bf16(float lo, float hi) { unsigned r; asm volatile("v_cvt_pk_bf16_f32 %0, %1, %2" : "=v"(r) : "v"(lo), "v"(hi)); return r; }
typedef float f32x2 __attribute__((ext_vector_type(2)));
__device__ __forceinline__ float sigmoid_f(float v) { return __builtin_amdgcn_rcpf(1.0f + __builtin_amdgcn_exp2f(-1.4426950408889634f * v)); }
__device__ __forceinline__ float gelu_tanh_f(float v) { const float u = v * (0.7978845608028654f + 0.035677408136300125f * v * v);
    return v * __builtin_amdgcn_rcpf(1.0f + __builtin_amdgcn_exp2f(-2.8853900817779268f * u)); }
__device__ __forceinline__ float bf_lo(unsigned w) { return __uint_as_float(w << 16); }
__device__ __forceinline__ float bf_hi(unsigned w) { return __uint_as_float(w & 0xffff0000u); }

template <int ACT, int LAYOUT = 0> __device__ __forceinline__ void store_tile_bf16(const f32x4 (&acc)[2][2][4][2], bf16_t* base, int ldc, int row0, int col0, float sc) {
#pragma unroll
    for (int ai = 0; ai < 2; ++ai)
#pragma unroll
        for (int m = 0; m < 4; ++m) { const int row = row0 + ai * HALF + m * 16; bf16_t* rowp = base + (size_t)row * ldc + col0;
            if (LAYOUT == 1) rowp = base + ((size_t)((col0 >> 6) * 256 + (row >> 6)) * 4096 + ((col0 & 63) >> 3) * 512 + (row & 63) * 8);
            if (LAYOUT == 2) rowp = base + ((size_t)((col0 >> 7) * 256 + (row >> 6)) * 8192 + (((col0 & 127) >> 5) * 4 + ((row & 63) >> 4)) * 512 + (row & 15) * 32 + (col0 & 31));
#pragma unroll
            for (int bj = 0; bj < 2; ++bj) { f32x4 v0 = acc[ai][bj][m][0], v1 = acc[ai][bj][m][1];
                if (ACT == 0) { v0 = v0 * sc; v1 = v1 * sc; }
                if (ACT == 2) {
#pragma unroll
                    for (int j = 0; j < 4; ++j) { v0[j] = gelu_tanh_f(v0[j]); v1[j] = gelu_tanh_f(v1[j]); } }
                if (ACT == 3) {
#pragma unroll
                    for (int j = 0; j < 4; ++j) { v0[j] = sigmoid_f(v0[j] * sc); v1[j] = sigmoid_f(v1[j] * sc); } }
                u32x4 w; w.x = cvt_pk_bf16(v0[0], v0[1]); w.y = cvt_pk_bf16(v0[2], v0[3]); w.z = cvt_pk_bf16(v1[0], v1[1]); w.w = cvt_pk_bf16(v1[2], v1[3]);
                *(u32x4*)(rowp + (LAYOUT == 1 ? bj * 2 * 256 * 4096 : LAYOUT == 2 ? bj * 256 * 8192 : bj * HALF)) = w;
                if (ACT != 0) __builtin_amdgcn_sched_barrier(0); } }
}
struct EpiProj {
    static constexpr bool PERM = true, AFTER_DRAIN = false;
    bf16_t *Q, *K, *V, *RX, *RG, *GA, *GB; float qscale, gscale;
    __device__ __forceinline__ void operator()(const f32x4 (&acc)[2][2][4][2], const Unit& u, int wr, int wc, int fr, int fq) const {
        const int pn = u.pn; const int row0 = u.pm * BM + wr * 64 + fr, cw = wc * 32 + 8 * fq;
        bf16_t* base; int ldc = 2048, colt, kind = 0; float sc = 1.0f;
        if (pn < 8)       { base = Q;  colt = pn * 256; sc = qscale; }
        else if (pn < 16) { base = K;  colt = (pn - 8) * 256; kind = 4; sc = gscale; }
        else if (pn < 24) { base = V;  colt = (pn - 16) * 256; kind = 5; sc = gscale; }
        else if (pn < 32) { base = RX; colt = (pn - 24) * 256; }
        else if (pn < 40) { base = RG; colt = (pn - 32) * 256; kind = 2; }
        else if (pn < 56) { base = GA; colt = (pn - 40) * 256; kind = 3; ldc = 4096; sc = gscale; }
        else              { base = GB; colt = (pn - 56) * 256; kind = 3; ldc = 4096; sc = gscale; }
        if (kind == 4)      store_tile_bf16<0, 1>(acc, base, ldc, row0, colt + cw, sc);
        else if (kind == 5) store_tile_bf16<0, 2>(acc, base, ldc, row0, colt + cw, sc);
        else if (kind == 0) store_tile_bf16<0>(acc, base, ldc, row0, colt + cw, sc);
        else if (kind == 2) store_tile_bf16<2>(acc, base, ldc, row0, colt + cw, sc);
        else                store_tile_bf16<3>(acc, base, ldc, row0, colt + cw, sc);
    }
};
struct EpiProjOff {
    static constexpr bool PERM = true, AFTER_DRAIN = false;
    EpiProj e; int off;
    __device__ __forceinline__ void operator()(const f32x4 (&acc)[2][2][4][2], const Unit& u, int wr, int wc, int fr, int fq) const { Unit u2 = u; u2.pn += off; e(acc, u2, wr, wc, fr, fq); }
};
struct EpiProjF8 {
    static constexpr bool PERM = true, AFTER_DRAIN = false;
    EpiProj e;
    __device__ __forceinline__ void operator()(const f32x4 (&acc)[2][2][4][2], const Unit& u, int wr, int wc, int fr, int fq) const { Unit u2 = u; u2.pn = u.pn < 16 ? u.pn + 8 : u.pn + 24; e(acc, u2, wr, wc, fr, fq); }
};
struct EpiPlain {
    static constexpr bool PERM = true, AFTER_DRAIN = false;
    bf16_t* O; int ldc;
    __device__ __forceinline__ void operator()(const f32x4 (&acc)[2][2][4][2], const Unit& u, int wr, int wc, int fr, int fq) const {
        store_tile_bf16<0>(acc, O, ldc, u.pm * BM + wr * 64 + fr, u.pn * BM + wc * 32 + 8 * fq, 1.0f);
    }
};
template <bool HAS_ADD> struct EpiGate {
    static constexpr bool PERM = true, AFTER_DRAIN = false;
    const bf16_t* G; const bf16_t* ADD; bf16_t* O; float sc;
    __device__ __forceinline__ void operator()(const f32x4 (&acc)[2][2][4][2], const Unit& u, int wr, int wc, int fr, int fq) const {
        const int row0 = u.pm * BM + wr * 64 + fr, col0 = u.pn * BM + wc * 32 + 8 * fq;
#pragma unroll
        for (int ai = 0; ai < 2; ++ai)
#pragma unroll
            for (int mh = 0; mh < 2; ++mh) {
                u32x4 g[2][2], ad[2][2];
#pragma unroll
                for (int mm = 0; mm < 2; ++mm) { const size_t off = (size_t)(row0 + ai * HALF + (2 * mh + mm) * 16) * 4096 + col0;
#pragma unroll
                    for (int bj = 0; bj < 2; ++bj) { g[mm][bj] = *(const u32x4*)(G + off + bj * HALF); if (HAS_ADD) ad[mm][bj] = *(const u32x4*)(ADD + off + bj * HALF); } }
#pragma unroll
                for (int mm = 0; mm < 2; ++mm) { const int m = 2 * mh + mm; const size_t off = (size_t)(row0 + ai * HALF + m * 16) * 4096 + col0;
#pragma unroll
                    for (int bj = 0; bj < 2; ++bj) { const u32x4 gg = g[mm][bj];
                        f32x4 v0 = acc[ai][bj][m][0] * sc, v1 = acc[ai][bj][m][1] * sc;
                        v0[0] *= bf_lo(gg.x); v0[1] *= bf_hi(gg.x); v0[2] *= bf_lo(gg.y); v0[3] *= bf_hi(gg.y); v1[0] *= bf_lo(gg.z); v1[1] *= bf_hi(gg.z); v1[2] *= bf_lo(gg.w); v1[3] *= bf_hi(gg.w);
                        if (HAS_ADD) { const u32x4 a = ad[mm][bj];
                            v0[0] += bf_lo(a.x); v0[1] += bf_hi(a.x); v0[2] += bf_lo(a.y); v0[3] += bf_hi(a.y); v1[0] += bf_lo(a.z); v1[1] += bf_hi(a.z); v1[2] += bf_lo(a.w); v1[3] += bf_hi(a.w); }
                        u32x4 w; w.x = cvt_pk_bf16(v0[0], v0[1]); w.y = cvt_pk_bf16(v0[2], v0[3]); w.z = cvt_pk_bf16(v1[0], v1[1]); w.w = cvt_pk_bf16(v1[2], v1[3]);
                        *(u32x4*)(O + off + bj * HALF) = w; } }
                asm volatile("" ::: "memory"); }
    }
};
struct EpiRes1 {
    static constexpr bool PERM = true, AFTER_DRAIN = false;
    const float* x; const float* gvec; bf16_t* X1B; float* PART;
    __device__ __forceinline__ void operator()(const f32x4 (&acc)[2][2][4][2], const Unit& u, int wr, int wc, int fr, int fq) const {
        const int row0 = u.pm * BM + wr * 64 + fr, col0 = u.pn * BM + wc * 32 + 8 * fq;
        f32x4 gv[2][2];
#pragma unroll
        for (int bj = 0; bj < 2; ++bj)
#pragma unroll
            for (int n = 0; n < 2; ++n) gv[bj][n] = *(const f32x4*)(gvec + col0 + bj * HALF + n * 4);
#pragma unroll
        for (int ai = 0; ai < 2; ++ai)
#pragma unroll
            for (int mh = 0; mh < 2; ++mh) {
                f32x4 bs[2][2][2];
#pragma unroll
                for (int mm = 0; mm < 2; ++mm) { const size_t off = (size_t)(row0 + ai * HALF + (2 * mh + mm) * 16) * 4096 + col0;
#pragma unroll
                    for (int bj = 0; bj < 2; ++bj)
#pragma unroll
                        for (int n = 0; n < 2; ++n) bs[mm][bj][n] = *(const f32x4*)(x + off + bj * HALF + n * 4); }
#pragma unroll
                for (int mm = 0; mm < 2; ++mm) { const int m = 2 * mh + mm, row = row0 + ai * HALF + m * 16; const size_t off = (size_t)row * 4096 + col0; float ss = 0.f;
#pragma unroll
                    for (int bj = 0; bj < 2; ++bj) { const f32x4 v0 = bs[mm][bj][0] + gv[bj][0] * acc[ai][bj][m][0], v1 = bs[mm][bj][1] + gv[bj][1] * acc[ai][bj][m][1];
                        ss += (v0[0] * v0[0] + v0[1] * v0[1]) + (v0[2] * v0[2] + v0[3] * v0[3]) + (v1[0] * v1[0] + v1[1] * v1[1]) + (v1[2] * v1[2] + v1[3] * v1[3]);
                        u32x4 w; w.x = cvt_pk_bf16(v0[0], v0[1]); w.y = cvt_pk_bf16(v0[2], v0[3]); w.z = cvt_pk_bf16(v1[0], v1[1]); w.w = cvt_pk_bf16(v1[2], v1[3]);
                        *(u32x4*)(X1B + off + bj * HALF) = w; }
                    ss += __shfl_xor(ss, 16); ss += __shfl_xor(ss, 32);
                    if (fq == 0) PART[(size_t)row * 64 + u.pn * 4 + wc] = ss; }
                asm volatile("" ::: "memory"); }
    }
};
struct EpiRes2 {
    static constexpr bool PERM = true, AFTER_DRAIN = false;
    bf16_t* XB; const float* gvec;
    __device__ __forceinline__ void operator()(const f32x4 (&acc)[2][2][4][2], const Unit& u, int wr, int wc, int fr, int fq) const {
        const int row0 = u.pm * BM + wr * 64 + fr, col0 = u.pn * BM + wc * 32 + 8 * fq;
        f32x4 gv[2][2];
#pragma unroll
        for (int bj = 0; bj < 2; ++bj)
#pragma unroll
            for (int n = 0; n < 2; ++n) gv[bj][n] = *(const f32x4*)(gvec + col0 + bj * HALF + n * 4);
#pragma unroll
        for (int ai = 0; ai < 2; ++ai) {
            u32x4 bs[4][2];
#pragma unroll
            for (int m = 0; m < 4; ++m)
#pragma unroll
                for (int bj = 0; bj < 2; ++bj) bs[m][bj] = *(const u32x4*)(XB + (size_t)(row0 + ai * HALF + m * 16) * 4096 + col0 + bj * HALF);
#pragma unroll
            for (int m = 0; m < 4; ++m)
#pragma unroll
                for (int bj = 0; bj < 2; ++bj) { const u32x4 b = bs[m][bj];
                    f32x4 v0 = gv[bj][0] * acc[ai][bj][m][0], v1 = gv[bj][1] * acc[ai][bj][m][1];
                    v0[0] += bf_lo(b.x); v0[1] += bf_hi(b.x); v0[2] += bf_lo(b.y); v0[3] += bf_hi(b.y); v1[0] += bf_lo(b.z); v1[1] += bf_hi(b.z); v1[2] += bf_lo(b.w); v1[3] += bf_hi(b.w);
                    u32x4 w; w.x = cvt_pk_bf16(v0[0], v0[1]); w.y = cvt_pk_bf16(v0[2], v0[3]); w.z = cvt_pk_bf16(v1[0], v1[1]); w.w = cvt_pk_bf16(v1[2], v1[3]);
                    *(u32x4*)(XB + (size_t)(row0 + ai * HALF + m * 16) * 4096 + col0 + bj * HALF) = w; }
            asm volatile("" ::: "memory"); }
    }
};
__device__ __forceinline__ float dpp_ror1(float v) { return __int_as_float(__builtin_amdgcn_mov_dpp(__float_as_int(v), 0x121, 0xf, 0xf, true)); }
__device__ __forceinline__ float dpp_ror2(float v) { return __int_as_float(__builtin_amdgcn_mov_dpp(__float_as_int(v), 0x122, 0xf, 0xf, true)); }
struct EpiFfn {
    static constexpr bool PERM = true, AFTER_DRAIN = false, HAS_PREF = true;
    bf16_t* ACT; const float* cw; const float* cb; float* GT; float* GH; float* UH; PG8_LAS float* bnd; int dff; const float* rstd; const float* bias2;
    PG8_LAS float* stg;
    __device__ __forceinline__ void prefetch(const Unit& u, int par, int wid, int lane) const {
        if (wid < 4) { const int hi = lane >> 5, l4 = 4 * (lane & 31), c0 = u.pn * 128 + l4; const float* src;
            if (wid == 0) src = rstd + u.pm * BM + 4 * lane;
            else if (wid == 1) src = bias2 + hi * dff + c0;
            else if (wid == 2) src = cw + hi * dff + c0;
            else src = hi ? (cb + c0) : (cw + 2 * dff + c0);
            __builtin_amdgcn_global_load_lds((const unsigned*)src, (PG8_LAS unsigned*)(stg + par * 1024 + wid * 256), 16, 0, 0); }
    }
    __device__ __forceinline__ void operator()(const f32x4 (&acc)[2][2][4][2], const Unit& u, int wr, int wc, int fr, int fq, int par) const {
        const int cl = wc * 32 + 8 * fq, cact = u.pn * 128 + cl, row0 = u.pm * BM + wr * 64 + fr;
        const PG8_LAS float* sg = stg + par * 1024;
        float rs[2][4], bg[8], bu[8];
#pragma unroll
        for (int ai = 0; ai < 2; ++ai)
#pragma unroll
            for (int m = 0; m < 4; ++m) rs[ai][m] = sg[wr * 64 + fr + ai * HALF + m * 16];
        { const f32x4 a0 = *(const PG8_LAS f32x4*)(sg + 256 + cl), a1 = *(const PG8_LAS f32x4*)(sg + 256 + cl + 4), b0 = *(const PG8_LAS f32x4*)(sg + 384 + cl), b1 = *(const PG8_LAS f32x4*)(sg + 384 + cl + 4);
#pragma unroll
          for (int q = 0; q < 4; ++q) { bg[q] = a0[q]; bg[4 + q] = a1[q]; bu[q] = b0[q]; bu[4 + q] = b1[q]; } }
#define FFN_G(ai, m, q) (rs[ai][m] * acc[ai][0][m][(q) >> 2][(q) & 3] + bg[q])
#define FFN_U(ai, m, q) (rs[ai][m] * acc[ai][1][m][(q) >> 2][(q) & 3] + bu[q])
        if (fr >= 14) {
#pragma unroll
            for (int ai = 0; ai < 2; ++ai) { PG8_LAS float* d = bnd + ((ai * 2 + wr) * 2 + (fr - 14)) * 128 + cl;
                *(PG8_LAS f32x4*)d = (f32x4){FFN_G(ai, 3, 0), FFN_G(ai, 3, 1), FFN_G(ai, 3, 2), FFN_G(ai, 3, 3)}; *(PG8_LAS f32x4*)(d + 4) = (f32x4){FFN_G(ai, 3, 4), FFN_G(ai, 3, 5), FFN_G(ai, 3, 6), FFN_G(ai, 3, 7)}; }
            if (wr == 1) { float* d = GT + ((size_t)u.pm * 2 + (fr - 14)) * dff + cact;
                *(f32x4*)d = (f32x4){FFN_G(1, 3, 0), FFN_G(1, 3, 1), FFN_G(1, 3, 2), FFN_G(1, 3, 3)}; *(f32x4*)(d + 4) = (f32x4){FFN_G(1, 3, 4), FFN_G(1, 3, 5), FFN_G(1, 3, 6), FFN_G(1, 3, 7)}; }
        }
        if (fr < 2 && wr == 0) { float* d = GH + ((size_t)u.pm * 2 + fr) * dff + cact;
            *(f32x4*)d = (f32x4){FFN_G(0, 0, 0), FFN_G(0, 0, 1), FFN_G(0, 0, 2), FFN_G(0, 0, 3)}; *(f32x4*)(d + 4) = (f32x4){FFN_G(0, 0, 4), FFN_G(0, 0, 5), FFN_G(0, 0, 6), FFN_G(0, 0, 7)};
            float* e2 = UH + ((size_t)u.pm * 2 + fr) * dff + cact;
            *(f32x4*)e2 = (f32x4){FFN_U(0, 0, 0), FFN_U(0, 0, 1), FFN_U(0, 0, 2), FFN_U(0, 0, 3)}; *(f32x4*)(e2 + 4) = (f32x4){FFN_U(0, 0, 4), FFN_U(0, 0, 5), FFN_U(0, 0, 6), FFN_U(0, 0, 7)}; }
        float w0[8], w1[8], w2[8], bb[8];
        { const f32x4 a0 = *(const PG8_LAS f32x4*)(sg + 512 + cl), a1 = *(const PG8_LAS f32x4*)(sg + 512 + cl + 4), b0 = *(const PG8_LAS f32x4*)(sg + 640 + cl), b1 = *(const PG8_LAS f32x4*)(sg + 640 + cl + 4);
          const f32x4 c0 = *(const PG8_LAS f32x4*)(sg + 768 + cl), c1 = *(const PG8_LAS f32x4*)(sg + 768 + cl + 4), d0 = *(const PG8_LAS f32x4*)(sg + 896 + cl), d1 = *(const PG8_LAS f32x4*)(sg + 896 + cl + 4);
#pragma unroll
          for (int q = 0; q < 4; ++q) { w0[q] = a0[q]; w0[4 + q] = a1[q]; w1[q] = b0[q]; w1[4 + q] = b1[q]; w2[q] = c0[q]; w2[4 + q] = c1[q]; bb[q] = d0[q]; bb[4 + q] = d1[q]; } }
        asm volatile("s_waitcnt lgkmcnt(0)" ::: "memory"); __builtin_amdgcn_s_barrier(); asm volatile("" ::: "memory");
#pragma unroll
        for (int ai = 0; ai < 2; ++ai) {
            float prv[8];
            { const bool have = (wr == 1) || (ai == 1);
              const int src = (wr == 1) ? (ai * 2 + 0) : (0 * 2 + 1);
              const PG8_LAS float* sp = bnd + (src * 2 + ((fr >= 14) ? (fr - 14) : 0)) * 128 + cl;
              const f32x4 x0 = *(const PG8_LAS f32x4*)sp, x1 = *(const PG8_LAS f32x4*)(sp + 4);
#pragma unroll
              for (int q = 0; q < 4; ++q) { prv[q] = have ? x0[q] : 0.f; prv[4 + q] = have ? x1[q] : 0.f; } }
#pragma unroll
            for (int m = 0; m < 4; ++m) {
                const f32x2 rs2 = {rs[ai][m], rs[ai][m]};
                unsigned wo[4];
#pragma unroll
                for (int p = 0; p < 4; ++p) {
                    const f32x4 ag = acc[ai][0][m][p >> 1], au = acc[ai][1][m][p >> 1];
                    const f32x2 a2 = (p & 1) ? __builtin_shufflevector(ag, ag, 2, 3) : __builtin_shufflevector(ag, ag, 0, 1);
                    const f32x2 u2 = (p & 1) ? __builtin_shufflevector(au, au, 2, 3) : __builtin_shufflevector(au, au, 0, 1);
                    const f32x2 cur = rs2 * a2 + (f32x2){bg[2 * p], bg[2 * p + 1]};
                    const f32x2 up = rs2 * u2 + (f32x2){bu[2 * p], bu[2 * p + 1]};
                    f32x2 cv = (f32x2){w2[2 * p], w2[2 * p + 1]} * cur + (f32x2){bb[2 * p], bb[2 * p + 1]};
#pragma unroll
                    for (int e = 0; e < 2; ++e) { const int q = 2 * p + e; const float c = cur[e], pv = prv[q];
                        const float t1 = (fr == 15) ? pv : c, t2 = (fr >= 14) ? pv : c;
                        cv[e] = __builtin_fmaf(dpp_ror1(t1), w1[q], cv[e]); cv[e] = __builtin_fmaf(dpp_ror2(t2), w0[q], cv[e]); prv[q] = c; }
                    const f32x2 t = cv * cv, pp = t * (f32x2){-0.10294324f, -0.10294324f} + (f32x2){-2.3022082f, -2.3022082f}, uu = cv * pp;
                    const f32x2 d = (f32x2){__builtin_amdgcn_exp2f(uu.x), __builtin_amdgcn_exp2f(uu.y)} + (f32x2){1.f, 1.f};
                    const f32x2 y = cv * (f32x2){__builtin_amdgcn_rcpf(d.x), __builtin_amdgcn_rcpf(d.y)} * up;
                    wo[p] = cvt_pk_bf16(y.x, y.y); }
                u32x4 w; w.x = wo[0]; w.y = wo[1]; w.z = wo[2]; w.w = wo[3];
                *(u32x4*)(ACT + (size_t)(row0 + ai * HALF + m * 16) * dff + cact) = w;
                __builtin_amdgcn_sched_barrier(0); }
        }
#undef FFN_G
#undef FFN_U
    }
};

struct EpiNone {
    static constexpr bool PERM = true, AFTER_DRAIN = false;
    __device__ __forceinline__ void operator()(const f32x4 (&acc)[2][2][4][2], const Unit& u, int wr, int wc, int fr, int fq) const {
#pragma unroll
        for (int ai = 0; ai < 2; ++ai)
#pragma unroll
            for (int bj = 0; bj < 2; ++bj)
#pragma unroll
                for (int m = 0; m < 4; ++m)
#pragma unroll
                    for (int n = 0; n < 2; ++n) asm volatile("" :: "v"(acc[ai][bj][m][n]));
    }
};

template <class T, class = void> struct epi_has_pref { static constexpr bool value = false; };
template <class T> struct epi_has_pref<T, decltype((void)T::HAS_PREF)> { static constexpr bool value = true; };
typedef int pg8_i32x4 __attribute__((ext_vector_type(4)));
typedef int pg8_i32x8 __attribute__((ext_vector_type(8)));
template <class Epi, class Sched, bool ALIGN_EPI = false, bool SP2 = false, bool F8 = false>
__device__ __forceinline__ void gemm_phase(PG8_LAS unsigned char* lds, const Gemm g, const Sched& S, const Epi& E) {
    const int tid = ftid(), wid = __builtin_amdgcn_readfirstlane(tid >> 6), lane = tid & 63, wr = wid >> 2, wc = wid & 3, fr = lane & 15, fq = lane >> 4;
    const int sc8 = __builtin_amdgcn_readfirstlane(0x7F7F7F7F);
    constexpr int ES = F8 ? 1 : 2, KSTR = F8 ? 16 : 1024;
    const int K = g.K, nt = K * ES / (BK * 2), LD = g.ld;
    unsigned voffA[2], voffB[2];
#pragma unroll
    for (int i = 0; i < 2; ++i) { int R, C; stage_rc(tid * 16 + i * 8192, R, C); const int Rb = Epi::PERM ? ((R & ~31) + perm32(R & 31)) : R;
        voffA[i] = (unsigned)(R * LD) * (unsigned)ES + (unsigned)C * 2u; voffB[i] = (unsigned)(Rb * LD) * (unsigned)ES + (unsigned)C * 2u; }
    const size_t kstep = (size_t)(BK * 2);
    const size_t hstep = (size_t)HALF * LD * ES;
    const size_t tstep = 2 * hstep;
    const unsigned ldsw = (unsigned)wid * 1024u;
    const int aoff = lds_byte(wr * 64 + fr, fq * (F8 ? 16 : 8)), boff = lds_byte(wc * 32 + fr, fq * (F8 ? 16 : 8));
#define PG8_SA(b, h) (((b) * 2 + (h)) * HTB)
#define PG8_SB(b, h) ((4 + (b) * 2 + (h)) * HTB)
#define PG8_STAGE(bufoff, gbase, voff) do { _Pragma("unroll") for (int _i = 0; _i < 2; ++_i) \
        __builtin_amdgcn_global_load_lds((const unsigned*)((const char*)(gbase) + (voff)[_i]), (PG8_LAS unsigned*)(lds + (bufoff) + ldsw + _i * 8192), 16, 0, 0); } while (0)
#define PG8_LDA(dst, b, h) do { _Pragma("unroll") for (int m = 0; m < 4; ++m) _Pragma("unroll") for (int k = 0; k < 2; ++k) dst[m][k] = *(const PG8_LAS bf16x8*)(lds + PG8_SA(b, h) + aoff + m * 2048 + k * KSTR); } while (0)
#define PG8_LDB(dst, b, h) do { _Pragma("unroll") for (int n = 0; n < 2; ++n) _Pragma("unroll") for (int k = 0; k < 2; ++k) dst[n][k] = *(const PG8_LAS bf16x8*)(lds + PG8_SB(b, h) + boff + n * 2048 + k * KSTR); } while (0)
#define PG8_CAT8(x0, x1) __builtin_shufflevector(__builtin_bit_cast(pg8_i32x4, x0), __builtin_bit_cast(pg8_i32x4, x1), 0, 1, 2, 3, 4, 5, 6, 7)
#define PG8_MMA(ai, bj, At, Bt) do { __builtin_amdgcn_s_setprio(1); \
        if constexpr (F8) { _Pragma("unroll") for (int m = 0; m < 4; ++m) _Pragma("unroll") for (int n = 0; n < 2; ++n) \
            asm volatile("v_mfma_scale_f32_16x16x128_f8f6f4 %0, %1, %2, %0, %3, %3 op_sel_hi:[0,0,0]" : "+v"(acc[ai][bj][m][n]) : "v"(PG8_CAT8(Bt[n][0], Bt[n][1])), "v"(PG8_CAT8(At[m][0], At[m][1])), "v"(sc8)); } \
        else { _Pragma("unroll") for (int m = 0; m < 4; ++m) _Pragma("unroll") for (int n = 0; n < 2; ++n) _Pragma("unroll") for (int k = 0; k < 2; ++k) \
            acc[ai][bj][m][n] = __builtin_amdgcn_mfma_f32_16x16x32_bf16(Bt[n][k], At[m][k], acc[ai][bj][m][n], 0, 0, 0); } \
        __builtin_amdgcn_s_setprio(0); } while (0)
#define PG8_WAIT_V(n) asm volatile("s_waitcnt vmcnt(" #n ")" ::: "memory")
#define PG8_WAIT_L(n) asm volatile("s_waitcnt lgkmcnt(" #n ")" ::: "memory")
#define PG8_BAR __builtin_amdgcn_s_barrier()
#define PG8_SCHED __builtin_amdgcn_sched_barrier(0)
    Unit cur, nxt; int ui = 0;
    if (!S.next(0, cur)) return;
    f32x4 acc[2][2][4][2];
#pragma unroll
    for (int a = 0; a < 2; ++a)
#pragma unroll
        for (int b = 0; b < 2; ++b)
#pragma unroll
            for (int m = 0; m < 4; ++m)
#pragma unroll
                for (int n = 0; n < 2; ++n) acc[a][b][m][n] = (f32x4){0.f, 0.f, 0.f, 0.f};
    bf16x8 At[4][2], B0[2][2], B1[2][2];
    const char* cA = (const char*)g.A + (size_t)cur.pm * tstep; const char* cB = (const char*)g.Bt + (size_t)cur.pn * tstep;
    S.a_ready(cur);
    if constexpr (epi_has_pref<Epi>::value) E.prefetch(cur, 0, wid, lane);
    if constexpr (SP2) {
        PG8_STAGE(PG8_SB(0, 0), cB, voffB); PG8_STAGE(PG8_SB(0, 1), cB + hstep, voffB); PG8_STAGE(PG8_SA(0, 0), cA, voffA); PG8_STAGE(PG8_SA(0, 1), cA + hstep, voffA);
        if (wr == 1) PG8_BAR;
        PG8_WAIT_V(2); PG8_BAR;
        PG8_STAGE(PG8_SB(1, 0), cB + kstep, voffB); PG8_STAGE(PG8_SA(1, 0), cA + kstep, voffA); PG8_STAGE(PG8_SB(1, 1), cB + hstep + kstep, voffB);
        PG8_WAIT_V(6); PG8_BAR;
    } else {
        PG8_STAGE(PG8_SB(0, 0), cB, voffB); PG8_STAGE(PG8_SA(0, 0), cA, voffA); PG8_STAGE(PG8_SB(0, 1), cB + hstep, voffB); PG8_STAGE(PG8_SA(0, 1), cA + hstep, voffA);
        if (wr == 1) PG8_BAR;
        PG8_WAIT_V(4); PG8_BAR;
        PG8_STAGE(PG8_SB(1, 0), cB + kstep, voffB); PG8_STAGE(PG8_SA(1, 0), cA + kstep, voffA); PG8_STAGE(PG8_SB(1, 1), cB + hstep + kstep, voffB);
        PG8_WAIT_V(6); PG8_BAR;
    }
    for (;;) {
        const bool has_next = S.next(ui + 1, nxt);
        const char* nA = has_next ? (const char*)g.A + (size_t)nxt.pm * tstep : cA; const char* nB = has_next ? (const char*)g.Bt + (size_t)nxt.pn * tstep : cB;
        for (int t = 0; t < nt; t += 2) {
            const bool last = (t == nt - 2);
            const char* a1 = cA + (size_t)(t + 1) * kstep;
            const char* a2 = last ? nA : cA + (size_t)(t + 2) * kstep; const char* b2 = last ? nB : cB + (size_t)(t + 2) * kstep;
            const char* a3 = a2 + kstep; const char* b3 = b2 + kstep;
            if (last && has_next) S.a_ready(nxt);
            if constexpr (SP2) {
            PG8_LDB(B0, 0, 0); PG8_LDB(B1, 0, 1); PG8_SCHED; PG8_LDA(At, 0, 0); PG8_STAGE(PG8_SA(1, 1), a1 + hstep, voffA);
            PG8_WAIT_V(8); PG8_WAIT_L(0); PG8_BAR; PG8_MMA(0, 0, At, B0); PG8_MMA(0, 1, At, B1); PG8_BAR; PG8_SCHED;
            PG8_LDA(At, 0, 1); PG8_STAGE(PG8_SB(0, 0), b2, voffB); PG8_STAGE(PG8_SB(0, 1), b2 + hstep, voffB); PG8_STAGE(PG8_SA(0, 0), a2, voffA);
            PG8_WAIT_V(8); PG8_WAIT_L(0); PG8_BAR; PG8_MMA(1, 0, At, B0); PG8_MMA(1, 1, At, B1); PG8_BAR; PG8_SCHED;
            PG8_LDB(B0, 1, 0); PG8_LDB(B1, 1, 1); PG8_SCHED; PG8_LDA(At, 1, 0); PG8_STAGE(PG8_SA(0, 1), a2 + hstep, voffA);
            PG8_WAIT_V(8); PG8_WAIT_L(0); PG8_BAR; PG8_MMA(0, 0, At, B0); PG8_MMA(0, 1, At, B1); PG8_BAR; PG8_SCHED;
            PG8_LDA(At, 1, 1); PG8_STAGE(PG8_SB(1, 0), b3, voffB); PG8_STAGE(PG8_SB(1, 1), b3 + hstep, voffB); PG8_STAGE(PG8_SA(1, 0), a3, voffA);
            PG8_WAIT_V(8); PG8_WAIT_L(0); PG8_BAR; PG8_MMA(1, 0, At, B0); PG8_MMA(1, 1, At, B1); PG8_BAR; PG8_SCHED;
            } else {
            PG8_LDB(B0, 0, 0); PG8_SCHED; PG8_LDA(At, 0, 0); PG8_STAGE(PG8_SA(1, 1), a1 + hstep, voffA);
            PG8_WAIT_L(8); PG8_BAR; PG8_WAIT_L(0); PG8_MMA(0, 0, At, B0); PG8_BAR; PG8_SCHED;
            PG8_LDB(B1, 0, 1); PG8_STAGE(PG8_SB(0, 0), b2, voffB);
            PG8_BAR; PG8_WAIT_L(0); PG8_MMA(0, 1, At, B1); PG8_BAR;
            PG8_LDA(At, 0, 1); PG8_STAGE(PG8_SA(0, 0), a2, voffA);
            PG8_BAR; PG8_WAIT_L(0); PG8_MMA(1, 0, At, B0); PG8_BAR; PG8_SCHED;
            PG8_STAGE(PG8_SB(0, 1), b2 + hstep, voffB);
            PG8_WAIT_V(6); PG8_BAR; PG8_MMA(1, 1, At, B1); PG8_BAR;
            PG8_LDB(B0, 1, 0); PG8_SCHED; PG8_LDA(At, 1, 0); PG8_STAGE(PG8_SA(0, 1), a2 + hstep, voffA);
            PG8_WAIT_L(8); PG8_BAR; PG8_WAIT_L(0); PG8_MMA(0, 0, At, B0); PG8_BAR; PG8_SCHED;
            PG8_LDB(B1, 1, 1); PG8_STAGE(PG8_SB(1, 0), b3, voffB);
            PG8_BAR; PG8_WAIT_L(0); PG8_MMA(0, 1, At, B1); PG8_BAR;
            PG8_LDA(At, 1, 1); PG8_STAGE(PG8_SA(1, 0), a3, voffA);
            PG8_BAR; PG8_WAIT_L(0); PG8_MMA(1, 0, At, B0); PG8_BAR; PG8_SCHED;
            PG8_STAGE(PG8_SB(1, 1), b3 + hstep, voffB);
            PG8_WAIT_V(6); PG8_BAR; PG8_MMA(1, 1, At, B1); PG8_BAR;
            }
        }
        if constexpr (ALIGN_EPI) { if (wr == 0) PG8_BAR; }
        if constexpr (F8) {
#define PG8_PIN8(ai, bj) "+v"(acc[ai][bj][0][0]), "+v"(acc[ai][bj][0][1]), "+v"(acc[ai][bj][1][0]), "+v"(acc[ai][bj][1][1]), "+v"(acc[ai][bj][2][0]), "+v"(acc[ai][bj][2][1]), "+v"(acc[ai][bj][3][0]), "+v"(acc[ai][bj][3][1])
            asm volatile("s_nop 15\n\ts_nop 15" : PG8_PIN8(0, 0)); asm volatile("" : PG8_PIN8(0, 1)); asm volatile("" : PG8_PIN8(1, 0)); asm volatile("" : PG8_PIN8(1, 1));
#undef PG8_PIN8
        }
        if constexpr (epi_has_pref<Epi>::value) { E(acc, cur, wr, wc, fr, fq, ui & 1); S.done(cur); if (has_next) E.prefetch(nxt, (ui + 1) & 1, wid, lane); }
        else if constexpr (F8) { const int t2 = ftid(); E(acc, cur, wr, wc, t2 & 15, (t2 >> 4) & 3); S.done(cur); }
        else if constexpr (!Epi::AFTER_DRAIN) { E(acc, cur, wr, wc, fr, fq); S.done(cur); }
        if (!has_next) break;
#pragma unroll
        for (int a = 0; a < 2; ++a)
#pragma unroll
            for (int b = 0; b < 2; ++b)
#pragma unroll
                for (int m = 0; m < 4; ++m)
#pragma unroll
                    for (int n = 0; n < 2; ++n) acc[a][b][m][n] = (f32x4){0.f, 0.f, 0.f, 0.f};
        cur = nxt; cA = nA; cB = nB; ++ui;
        if constexpr (F8) { const int t3 = ftid();
#pragma unroll
            for (int i = 0; i < 2; ++i) { int R, C; stage_rc(t3 * 16 + i * 8192, R, C); const int Rb = Epi::PERM ? ((R & ~31) + perm32(R & 31)) : R;
                voffA[i] = (unsigned)(R * LD) * (unsigned)ES + (unsigned)C * 2u; voffB[i] = (unsigned)(Rb * LD) * (unsigned)ES + (unsigned)C * 2u; } }
        if constexpr (ALIGN_EPI) { if (wr == 1) PG8_BAR; }
    }
    PG8_WAIT_V(0);
    if constexpr (!ALIGN_EPI) { if (wr == 0) PG8_BAR; }
    PG8_BAR;
    if constexpr (Epi::AFTER_DRAIN) { E.fused(acc, cur, wr, wc, fr, fq, lds, wid, lane); S.done(cur); }
#undef PG8_SA
#undef PG8_SB
#undef PG8_STAGE
#undef PG8_LDA
#undef PG8_LDB
#undef PG8_MMA
#undef PG8_CAT8
#undef PG8_WAIT_V
#undef PG8_WAIT_L
#undef PG8_BAR
#undef PG8_SCHED
}
}
namespace att {
typedef unsigned short bf16_t;
using bf16x8 = __attribute__((ext_vector_type(8))) short;
using s16x4 = __attribute__((ext_vector_type(4))) short;
using f32x16 = __attribute__((ext_vector_type(16))) float;
using u32x4 = __attribute__((ext_vector_type(4))) unsigned;
typedef __attribute__((address_space(3))) char* lds_ptr;
typedef __attribute__((address_space(3))) const char* lds_cptr;
constexpr int PITCH = 2048, KVBLK = 64, QB = 256, SEQ = 16384;
constexpr int KSLOT = 8192, VSLOT = 16384, NSLOT = 3;
constexpr int LDS_K = 0, LDS_V = NSLOT * KSLOT, LDS_WS = LDS_V + NSLOT * VSLOT, LDS_OST = LDS_WS + 8 * 256, LDS_STOP = LDS_OST + 8 * 8192, LDS_END = LDS_STOP + 64;
constexpr float THR = 8.0f;
#define ATT_SBAR() __builtin_amdgcn_sched_barrier(0)
#define ATT_WAIT_BAR(N) asm volatile("s_waitcnt vmcnt(" #N ") lgkmcnt(0)\n\ts_barrier" ::: "memory")
__device__ __forceinline__ void glds16(const void* gsrc, unsigned lds_dst) { unsigned keep;
    asm volatile("s_mov_b32 %0, m0\n\ts_mov_b32 m0, %2\n\ts_nop 0\n\tglobal_load_lds_dwordx4 %1, off\n\ts_mov_b32 m0, %0" : "=&s"(keep) : "v"(gsrc), "s"(lds_dst) : "memory"); }
__device__ __forceinline__ unsigned cvtpk(float lo, float hi) { unsigned r; asm("v_cvt_pk_bf16_f32 %0, %1, %2" : "=v"(r) : "v"(lo), "v"(hi)); return r; }
__device__ __forceinline__ float add1(float a, float b) { float r; asm("v_add_f32 %0, %1, %2" : "=v"(r) : "v"(a), "v"(b)); return r; }
__device__ __forceinline__ int crow(int r, int hi) { return (r & 3) + 8 * (r >> 2) + 4 * hi; }

__device__ __forceinline__ void attn_unit(int h, int c, int qb, const bf16_t* Q, const bf16_t* __restrict__ K, const bf16_t* __restrict__ V, bf16_t* O, lds_ptr shm, float sl2, int t_start, float kn) {
    const int tid = ftid(), lane = tid & 63, r32 = lane & 31, hi = lane >> 5; const int wid = __builtin_amdgcn_readfirstlane(tid >> 6);
    const int q0 = qb * QB;
    const bf16_t* Qw = Q + (size_t)(q0 + wid * 32) * PITCH + h * 128 + c * 64;
    const unsigned lds0 = (unsigned)(uintptr_t)shm;
    __attribute__((address_space(3))) float* wsf = (__attribute__((address_space(3))) float*)(shm + LDS_WS) + wid * 64;
    const bf16_t* ksrc = K + (size_t)(h * 2 + c) * 256 * 4096 + wid * 512 + lane * 8;
    const bf16_t* vsrc0 = V + (size_t)h * 256 * 8192 + wid * 512 + lane * 8;
    const bf16_t* vsrc1 = vsrc0 + 8 * 512;
    const unsigned kdst = lds0 + LDS_K + wid * 1024, vdst0 = lds0 + LDS_V + wid * 1024, vdst1 = vdst0 + 8192;
#define ATT_DMA(t, sl) do { \
        glds16(ksrc + (size_t)(t) * 4096, (unsigned)__builtin_amdgcn_readfirstlane(kdst + (sl) * KSLOT)); \
        glds16(vsrc0 + (size_t)(t) * 8192, (unsigned)__builtin_amdgcn_readfirstlane(vdst0 + (sl) * VSLOT)); \
        glds16(vsrc1 + (size_t)(t) * 8192, (unsigned)__builtin_amdgcn_readfirstlane(vdst1 + (sl) * VSLOT)); } while (0)
    const int vb0 = (int)(lds0 + LDS_V) + ((lane >> 4) & 1) * 32 + (lane & 3) * 8 + (4 * hi + ((lane & 15) >> 2)) * 64;
    const lds_cptr kp0 = (lds_cptr)shm + LDS_K + hi * 1024 + r32 * 16;
    const int NT = (q0 + QB) / KVBLK, n = NT - t_start;
    bf16x8 qr[4];
#pragma unroll
    for (int d0 = 0; d0 < 4; ++d0) qr[d0] = *reinterpret_cast<const bf16x8*>(Qw + (size_t)r32 * PITCH + d0 * 16 + hi * 8);
    asm volatile("s_waitcnt vmcnt(0)" ::: "memory");
#pragma unroll
    for (int d0 = 0; d0 < 4; ++d0) asm volatile("" : "+v"(qr[d0]));
#define ATT_SEQ(i) (((i) < 4) ? (NT - 4 + (i)) : (NT - 1 - (i)))
    float brow;
    { float qn2 = 0.f;
#pragma unroll
      for (int d0 = 0; d0 < 4; ++d0)
#pragma unroll
          for (int e = 0; e < 8; ++e) { const float v = __uint_as_float(((unsigned)(unsigned short)qr[d0][e]) << 16); qn2 += v * v; }
      auto rr = __builtin_amdgcn_permlane32_swap(__float_as_uint(qn2), __float_as_uint(qn2), false, false);
      qn2 = __uint_as_float(rr[0]) + __uint_as_float(rr[1]);
      brow = sqrtf(qn2) * kn * 1.001f + 0.01f; }
    __attribute__((address_space(3))) float* stopv = (__attribute__((address_space(3))) float*)(shm + LDS_STOP);
    ATT_DMA(ATT_SEQ(0), 0); ATT_DMA(ATT_SEQ(1), 1);
    f32x16 kbv;
#pragma unroll
    for (int r = 0; r < 16; ++r) kbv[r] = sl2 * (float)((r & 3) + 8 * (r >> 2));
    const float sl32 = 32.0f * sl2;
    const int qpos = q0 + wid * 32 + r32;
    float mref = 0.f, l_reg = 0.f; f32x16 o[4];
#pragma unroll
    for (int d = 0; d < 4; ++d) o[d] = f32x16{};
    int slot = 0;
    for (int i = 0; i < n; ++i) {
        const int t = ATT_SEQ(i);
        if (i + 1 < n) { ATT_WAIT_BAR(3); } else { ATT_WAIT_BAR(0); }
        if (i >= 4) { const int pb = ((i - 1) & 1) * 8;
            float mv = stopv[pb];
#pragma unroll
            for (int w = 1; w < 8; ++w) mv = __builtin_fmaxf(mv, stopv[pb + w]);
            if (mv < -44.0f) break; }
        if (i + 2 < n) { const int s2 = (slot == 0) ? 2 : slot - 1; ATT_DMA(ATT_SEQ(i + 2), s2); }
        const int d0i = 64 * t + 4 * hi - qpos;
        const float base0 = sl2 * (float)d0i - mref, base1 = base0 + sl32;
        f32x16 p0, p1;
#pragma unroll
        for (int r = 0; r < 16; ++r) { p0[r] = add1(kbv[r], base0); p1[r] = add1(kbv[r], base1); }
        { const lds_cptr kb = kp0 + slot * KSLOT;
#pragma unroll
          for (int d0 = 0; d0 < 4; ++d0) {
              const bf16x8 b0 = *reinterpret_cast<const __attribute__((address_space(3))) bf16x8*>(kb + d0 * 2048);
              const bf16x8 b1 = *reinterpret_cast<const __attribute__((address_space(3))) bf16x8*>(kb + d0 * 2048 + 512);
              p0 = __builtin_amdgcn_mfma_f32_32x32x16_bf16(b0, qr[d0], p0, 0, 0, 0);
              p1 = __builtin_amdgcn_mfma_f32_32x32x16_bf16(b1, qr[d0], p1, 0, 0, 0); } }
        if (t >= NT - 4) {
#pragma unroll
            for (int r = 0; r < 16; ++r) { const int kv = d0i + (r & 3) + 8 * (r >> 2); if (kv > 0) p0[r] = -__builtin_inff(); if (kv + 32 > 0) p1[r] = -__builtin_inff(); }
        }
        float rm;
        { float a = __builtin_fmaxf(__builtin_fmaxf(p0[0], p0[1]), p1[0]), b = __builtin_fmaxf(__builtin_fmaxf(p0[2], p0[3]), p1[1]); a = __builtin_fmaxf(__builtin_fmaxf(a, p1[2]), p1[3]);
#pragma unroll
          for (int r = 4; r < 16; r += 4) { a = __builtin_fmaxf(__builtin_fmaxf(a, p0[r]), p0[r + 1]); b = __builtin_fmaxf(__builtin_fmaxf(b, p0[r + 2]), p0[r + 3]);
                                            a = __builtin_fmaxf(__builtin_fmaxf(a, p1[r]), p1[r + 1]); b = __builtin_fmaxf(__builtin_fmaxf(b, p1[r + 2]), p1[r + 3]); }
          rm = __builtin_fmaxf(a, b);
          auto rr = __builtin_amdgcn_permlane32_swap(__float_as_uint(rm), __float_as_uint(rm), false, false);
          rm = __builtin_fmaxf(__uint_as_float(rr[0]), __uint_as_float(rr[1])); }
        const bool first = (i == 0);
        if (first || __any(rm > THR)) {
            const float dl = first ? rm : __builtin_fmaxf(rm, 0.f);
            mref += dl;
#pragma unroll
            for (int r = 0; r < 16; ++r) { p0[r] -= dl; p1[r] -= dl; }
            if (!first) {
                const float f = __builtin_amdgcn_exp2f(-dl);
                l_reg *= f;
                if (hi == 0) wsf[r32] = f;
                float fr_[16];
#pragma unroll
                for (int r = 0; r < 16; ++r) fr_[r] = wsf[crow(r, hi)];
#pragma unroll
                for (int d = 0; d < 4; ++d)
#pragma unroll
                    for (int r = 0; r < 16; ++r) o[d][r] *= fr_[r];
            }
        }
        float sacc = 0.f;
#pragma unroll
        for (int r = 0; r < 16; ++r) { p0[r] = __builtin_amdgcn_exp2f(p0[r]); p1[r] = __builtin_amdgcn_exp2f(p1[r]); }
#pragma unroll
        for (int r = 0; r < 16; ++r) sacc += p0[r] + p1[r];
        l_reg += sacc;
        u32x4 pw0, pw1, pw2, pw3;
        pw0 = (u32x4){cvtpk(p0[0], p0[1]), cvtpk(p0[2], p0[3]), cvtpk(p0[4], p0[5]), cvtpk(p0[6], p0[7])};
        pw1 = (u32x4){cvtpk(p0[8], p0[9]), cvtpk(p0[10], p0[11]), cvtpk(p0[12], p0[13]), cvtpk(p0[14], p0[15])};
        pw2 = (u32x4){cvtpk(p1[0], p1[1]), cvtpk(p1[2], p1[3]), cvtpk(p1[4], p1[5]), cvtpk(p1[6], p1[7])};
        pw3 = (u32x4){cvtpk(p1[8], p1[9]), cvtpk(p1[10], p1[11]), cvtpk(p1[12], p1[13]), cvtpk(p1[14], p1[15])};
        { const int vb = vb0 + slot * VSLOT;
          const bf16x8 pa0 = __builtin_bit_cast(bf16x8, pw0), pa1 = __builtin_bit_cast(bf16x8, pw1), pa2 = __builtin_bit_cast(bf16x8, pw2), pa3 = __builtin_bit_cast(bf16x8, pw3);
#pragma unroll
          for (int d0 = 0; d0 < 4; ++d0) { s16x4 lo[4], hh[4];
#pragma unroll
              for (int ks = 0; ks < 4; ++ks) {
                  asm volatile("ds_read_b64_tr_b16 %0,%1 offset:%c2" : "=&v"(lo[ks]) : "v"(vb), "i"(d0 * 4096 + ks * 1024) : "memory");
                  asm volatile("ds_read_b64_tr_b16 %0,%1 offset:%c2" : "=&v"(hh[ks]) : "v"(vb), "i"(d0 * 4096 + ks * 1024 + 512) : "memory"); }
              asm volatile("s_waitcnt lgkmcnt(0)" ::: "memory"); ATT_SBAR();
#define ATT_PK(k) (bf16x8){lo[k][0], lo[k][1], lo[k][2], lo[k][3], hh[k][0], hh[k][1], hh[k][2], hh[k][3]}
              o[d0] = __builtin_amdgcn_mfma_f32_32x32x16_bf16(pa0, ATT_PK(0), o[d0], 0, 0, 0);
              o[d0] = __builtin_amdgcn_mfma_f32_32x32x16_bf16(pa1, ATT_PK(1), o[d0], 0, 0, 0);
              o[d0] = __builtin_amdgcn_mfma_f32_32x32x16_bf16(pa2, ATT_PK(2), o[d0], 0, 0, 0);
              o[d0] = __builtin_amdgcn_mfma_f32_32x32x16_bf16(pa3, ATT_PK(3), o[d0], 0, 0, 0);
#undef ATT_PK
          } }
        if (i >= 3 && i + 1 < n) {
            float v = brow + sl2 * (float)(64 * ATT_SEQ(i + 1) + 63 - qpos) - mref;
            v = __builtin_fmaxf(v, __shfl_xor(v, 1)); v = __builtin_fmaxf(v, __shfl_xor(v, 2)); v = __builtin_fmaxf(v, __shfl_xor(v, 4)); v = __builtin_fmaxf(v, __shfl_xor(v, 8)); v = __builtin_fmaxf(v, __shfl_xor(v, 16));
            if (lane == 0) stopv[(i & 1) * 8 + wid] = v; }
        slot = (slot == 2) ? 0 : slot + 1;
    }
#undef ATT_SEQ
    { auto rr = __builtin_amdgcn_permlane32_swap(__float_as_uint(l_reg), __float_as_uint(l_reg), false, false); l_reg = __uint_as_float(rr[0]) + __uint_as_float(rr[1]); }
    if (hi == 0) wsf[32 + r32] = l_reg;
    float rli[16];
#pragma unroll
    for (int r = 0; r < 16; ++r) rli[r] = 1.0f / wsf[32 + crow(r, hi)];
    { __attribute__((address_space(3))) bf16_t* stg = (__attribute__((address_space(3))) bf16_t*)(shm + LDS_OST) + wid * 4096;
#pragma unroll
      for (int r = 0; r < 16; ++r) { const int orow = crow(r, hi);
#pragma unroll
          for (int d0 = 0; d0 < 4; ++d0) { const float v = o[d0][r] * rli[r]; stg[orow * 128 + d0 * 32 + r32] = (bf16_t)(cvtpk(v, v) & 0xffffu); } }
      asm volatile("s_waitcnt lgkmcnt(0)" ::: "memory");
      bf16_t* Ow = O + (size_t)(q0 + wid * 32) * PITCH + h * 128;
#pragma unroll
      for (int it = 0; it < 8; ++it) { const int row = it * 4 + (lane >> 4), ch = lane & 15;
          const u32x4 v = *(const __attribute__((address_space(3))) u32x4*)(stg + row * 128 + ch * 8);
          *(u32x4*)(Ow + (size_t)row * PITCH + ch * 8) = v; } }
    asm volatile("s_waitcnt vmcnt(0) lgkmcnt(0)\n\ts_barrier" ::: "memory");
#undef ATT_DMA
}
#undef ATT_SBAR
#undef ATT_WAIT_BAR
}

constexpr int NWAVES = 8;
constexpr int N_LAUNCHES = MK_N_LAUNCHES;
constexpr int N_PHASES = 13;
constexpr int SEQ = 16384, DM = 4096, DIN = 18432, DRNN = 2048, DFF = 11008, NUP = 2 * DFF  ;
constexpr float EPS = 1e-6f;
constexpr float QSCALE = 0.125f * 1.4426950408889634f;
constexpr float LOG2E = 1.4426950408889634f;
constexpr size_t MiB = 1u << 20;
constexpr size_t WS_CTL = 0, CTL_ZERO_BYTES = 64 * 1024;
constexpr size_t WS_MOD = 1 * MiB;
constexpr size_t WS_RGW = 2 * MiB;
constexpr size_t WS_CA = 4 * MiB, WS_CB = 6 * MiB, WS_HC = 8 * MiB;
constexpr size_t WS_PART = 10 * MiB;
constexpr size_t WS_RSTD = 14 * MiB, WS_BIAS2 = 14 * MiB + 512 * 1024;
constexpr size_t WS_WIN = 16 * MiB;
constexpr size_t WS_WPA = 160 * MiB, WS_WPR = 176 * MiB;
constexpr size_t WS_WOUT = 192 * MiB;
constexpr size_t WS_WUP = 224 * MiB;
constexpr size_t WS_WDN = 396 * MiB;
constexpr size_t WS_H = 482 * MiB;
constexpr size_t WS_Q = 610 * MiB, WS_K = 674 * MiB, WS_V = 738 * MiB;
constexpr size_t WS_RX = 802 * MiB, WS_RG = 866 * MiB;
constexpr size_t WS_GA = 930 * MiB, WS_GB = 1058 * MiB;
constexpr size_t WS_O1 = 1186 * MiB, WS_O2 = 1250 * MiB;
constexpr size_t WS_H8 = 1186 * MiB, WS_W8 = 1250 * MiB;
constexpr int NPROJ8 = 8192;
constexpr float W8SCALE = 128.0f, WPA8SCALE = 64.0f;
constexpr size_t WS_MIX = 1314 * MiB;
constexpr size_t WS_GT = 1314 * MiB, WS_GH = 1320 * MiB, WS_UH = 1326 * MiB;
constexpr size_t WS_ACT = 610 * MiB;
constexpr size_t WS_BPART = 1442 * MiB;
constexpr size_t WS_END = 1448 * MiB;
static_assert(WS_UH + (size_t)64 * 2 * DFF * 4 <= WS_BPART && WS_BPART + (size_t)64 * NUP * 4 <= WS_END && WS_ACT + (size_t)SEQ * DFF * 2 <= WS_GT, "d_ws map");
constexpr int CW_BAR = 4096;
constexpr int CW_ATTQ = 8192;
constexpr int CW_QKMAX = 8320;
constexpr int RING_OFF = 0, BND_OFF = 131072;
constexpr int LDSCTL_OFF = 143360, MISC_OFF = LDSCTL_OFF + 320;
constexpr int LDS_BYTES = 147456;
static_assert(att::LDS_END <= LDSCTL_OFF && MISC_OFF + 128 <= LDS_BYTES, "LDS map");
#define GAS __attribute__((address_space(1)))
#define LAS __attribute__((address_space(3)))
typedef unsigned short bf16;
typedef unsigned v4u __attribute__((ext_vector_type(4)));
typedef float f32x4 __attribute__((ext_vector_type(4)));
typedef short bf16x8 __attribute__((ext_vector_type(8)));
typedef GAS unsigned gu32;
typedef GAS unsigned long long gu64;
#define RLX_AGENT __ATOMIC_RELAXED, __HIP_MEMORY_SCOPE_AGENT
#define LDS_WAIT() asm volatile("s_waitcnt lgkmcnt(0)" ::: "memory")
#define VM_WAIT() asm volatile("s_waitcnt vmcnt(0)" ::: "memory")
__device__ __forceinline__ unsigned long long rt() { return __builtin_amdgcn_s_memrealtime(); }
__device__ __forceinline__ unsigned f2bf(float f) { unsigned u = __builtin_bit_cast(unsigned, f); return (u + 0x7fffu + ((u >> 16) & 1u)) >> 16; }
__device__ __forceinline__ unsigned pk2(float lo, float hi) { return f2bf(lo) | (f2bf(hi) << 16); }

#define XB_TMO      128
#define XB_XCNT(j)  (256  + 64 * (j))
#define XB_XSUB(j)  (1280 + 64 * (j))
#define XB_XGEN(j)  (2304 + 64 * (j))
#define XB_TOP      3328
#define XB_TOPGEN   3392
#define XCD_BAR_WORDS 3456
#define XB_SPIN_CAP (1u << 18)

__device__ __forceinline__ unsigned xb_ld(unsigned* p)              { return __hip_atomic_load(p, __ATOMIC_RELAXED, __HIP_MEMORY_SCOPE_AGENT); }
__device__ __forceinline__ unsigned xb_add(unsigned* p, unsigned v) { return __hip_atomic_fetch_add(p, v, __ATOMIC_RELAXED, __HIP_MEMORY_SCOPE_AGENT); }
__device__ __forceinline__ unsigned xb_xcc_id() { return (unsigned)__builtin_amdgcn_s_getreg((3 << 11) | 20) & 0xFu; }
#define XB_SPIN(cond, bar) do { unsigned _sp = 0; while (cond) { __builtin_amdgcn_s_sleep(1); \
    if ((++_sp & 255u) == 0u) { if (xb_ld(&(bar)[XB_TMO])) break; if (_sp > XB_SPIN_CAP) { atomicAdd(&(bar)[XB_TMO], 1u); break; } } } } while (0)

struct XcdBarrier {
    unsigned* bar; unsigned x;
    volatile LAS unsigned* st;
};

__device__ __forceinline__ XcdBarrier xcd_barrier_post(unsigned* bar, volatile LAS unsigned* st) {
    XcdBarrier b; b.bar = bar; b.x = xb_xcc_id(); b.st = st;
    if (threadIdx.x == 0) (void)xb_add(&bar[XB_XCNT(b.x)], 1u);
    return b;
}
__device__ __forceinline__ void xcd_barrier_complete(unsigned* bar, unsigned x, unsigned& nloc, unsigned& nx) {
    const unsigned G = gridDim.x * gridDim.y * gridDim.z;
    unsigned sum, cnt, mine, sp = 0u;
    for (;;) {
        sum = 0u; cnt = 0u; mine = 0u;
#pragma unroll
        for (unsigned j = 0; j < 16; ++j) { const unsigned c = xb_ld(&bar[XB_XCNT(j)]); sum += c; cnt += (c > 0u) ? 1u : 0u; mine = (j == x) ? c : mine; }
        if (sum == G) break;
        __builtin_amdgcn_s_sleep(1);
        if ((++sp & 255u) == 0u) { if (xb_ld(&bar[XB_TMO])) break; if (sp > XB_SPIN_CAP) { atomicAdd(&bar[XB_TMO], 1u); break; } }
    }
    nloc = mine > 0u ? mine : 1u; nx = cnt > 0u ? cnt : 1u;
}

__device__ __forceinline__ void xcd_barrier(const XcdBarrier& b) {
    asm volatile("s_waitcnt vmcnt(0)" ::: "memory");
    __syncthreads();
    if (threadIdx.x == 0) {
        unsigned* bar = b.bar;
        __builtin_amdgcn_s_waitcnt(0);
        unsigned nloc = b.st[0], nx = b.st[1];
        if (nloc == 0u) { xcd_barrier_complete(bar, b.x, nloc, nx); b.st[0] = nloc; b.st[1] = nx; }
        const unsigned old = xb_add(&bar[XB_XSUB(b.x)], 1u);
        const unsigned gen = old / nloc;
        if (old + 1u == (gen + 1u) * nloc) {
            __builtin_amdgcn_fence(__ATOMIC_RELEASE, "agent");
            asm volatile("s_waitcnt vmcnt(0)" ::: "memory");
            const unsigned og = xb_add(&bar[XB_TOP], 1u);
            const unsigned tg = og / nx;
            if (og + 1u == (tg + 1u) * nx) xb_add(&bar[XB_TOPGEN], 1u);
            else XB_SPIN(xb_ld(&bar[XB_TOPGEN]) == tg, bar);
            __builtin_amdgcn_fence(__ATOMIC_ACQUIRE, "agent");
            xb_add(&bar[XB_XGEN(b.x)], 1u);
            asm volatile("s_waitcnt vmcnt(0)" ::: "memory");
        } else {
            XB_SPIN(xb_ld(&bar[XB_XGEN(b.x)]) == gen, bar);
            __builtin_amdgcn_fence(__ATOMIC_ACQUIRE, "agent");
            asm volatile("s_waitcnt vmcnt(0)" ::: "memory");
        }
    }
    __syncthreads();
}
struct Frame {
    LAS unsigned char* lds;
    volatile LAS unsigned* MISC;
    gu32* ctl;
    int tid, lane, wave;
    int vcu, G;
};
__device__ __forceinline__ float wave_sum(float v) {
#pragma unroll
    for (int o = 1; o < 64; o <<= 1) v += __shfl_xor(v, o);
    return v;
}
__device__ __forceinline__ unsigned pkbf(float lo, float hi) { unsigned r; asm("v_cvt_pk_bf16_f32 %0, %1, %2" : "=v"(r) : "v"(lo), "v"(hi)); return r; }
__device__ __forceinline__ float bflo(unsigned w) { return __uint_as_float(w << 16); }
__device__ __forceinline__ float bfhi(unsigned w) { return __uint_as_float(w & 0xffff0000u); }
__device__ __forceinline__ float sigmoidf_(float v) { return __builtin_amdgcn_rcpf(1.0f + __builtin_amdgcn_exp2f(-LOG2E * v)); }
__device__ __forceinline__ float gelu_tanhf_(float v) { const float u = v * (0.7978845608028654f + 0.035677408136300125f * v * v);
    return v * __builtin_amdgcn_rcpf(1.0f + __builtin_amdgcn_exp2f(-2.8853900817779268f * u)); }

__device__ __forceinline__ void transpose_item(const float* W, int K, int N, bf16* WT, int k0, int n0, int rowbase, LAS float* scr, int lane) {
#pragma unroll 8
    for (int i = 0; i < 32; ++i) { const int kk = 2 * i + (lane >> 5); scr[kk * 33 + (lane & 31)] = __builtin_nontemporal_load(&W[(size_t)(k0 + kk) * N + n0 + (lane & 31)]);     }
    LDS_WAIT(); asm volatile("" ::: "memory");
    const int c = lane & 7;
#pragma unroll
    for (int j = 0; j < 4; ++j) { const int n = (lane >> 3) + 8 * j; const LAS float* s = scr + (8 * c) * 33 + n;
        v4u o; o.x = pkbf(s[0 * 33], s[1 * 33]); o.y = pkbf(s[2 * 33], s[3 * 33]); o.z = pkbf(s[4 * 33], s[5 * 33]); o.w = pkbf(s[6 * 33], s[7 * 33]);
        *(GAS v4u*)(WT + (size_t)(rowbase + n) * K + k0 + 8 * c) = o; }
    LDS_WAIT(); asm volatile("" ::: "memory");
}
__device__ __forceinline__ unsigned pk4_fp8(float a, float b, float c, float d);
__device__ __forceinline__ void transpose_item_fp8(const float* W, int K, int N, unsigned char* W8, int k0, int n0, int rowbase, LAS float* scr, int lane, float sc) {
#pragma unroll 8
    for (int i = 0; i < 32; ++i) { const int kk = 2 * i + (lane >> 5); scr[kk * 33 + (lane & 31)] = __builtin_nontemporal_load(&W[(size_t)(k0 + kk) * N + n0 + (lane & 31)]) * sc; }
    LDS_WAIT(); asm volatile("" ::: "memory");
    const int c = lane & 7;
#pragma unroll
    for (int j = 0; j < 4; ++j) { const int n = (lane >> 3) + 8 * j; const LAS float* s = scr + (8 * c) * 33 + n;
        const unsigned long long o = (unsigned long long)pk4_fp8(s[0 * 33], s[1 * 33], s[2 * 33], s[3 * 33]) | ((unsigned long long)pk4_fp8(s[4 * 33], s[5 * 33], s[6 * 33], s[7 * 33]) << 32);
        *(GAS unsigned long long*)(W8 + (size_t)(rowbase + n) * K + k0 + 8 * c) = o; }
    LDS_WAIT(); asm volatile("" ::: "memory");
}
__device__ __forceinline__ void transpose_matrix_item(const float* W, int K, int N, bf16* WT, int item, int mode, LAS float* scr, int lane) {
    const int nblk = N / 32, kb = item / nblk, nb = item % nblk, n0 = 32 * nb;
    int rowbase = n0;
    if (mode == 1) { rowbase = (n0 < DFF) ? (n0 / 128) * 256 + (n0 % 128) : ((n0 - DFF) / 128) * 256 + 128 + ((n0 - DFF) % 128); }
    transpose_item(W, K, N, WT, 64 * kb, n0, rowbase, scr, lane);
}

__device__ __forceinline__ void transpose_up_item(const float* W, bf16* WT, int item, const LAS float* a2, const LAS float* sh2, float* BPART, LAS float* scr, int lane) {
    constexpr int K = DM, N = NUP; constexpr int nblk = N / 32; const int kb = item / nblk, nb = item % nblk, n0 = 32 * nb, k0 = 64 * kb;
    const int rowbase = (n0 < DFF) ? (n0 / 128) * 256 + (n0 % 128) : ((n0 - DFF) / 128) * 256 + 128 + ((n0 - DFF) % 128);
    float bsum = 0.f;
#pragma unroll 8
    for (int i = 0; i < 32; ++i) { const int kk = 2 * i + (lane >> 5); const float w = __builtin_nontemporal_load(&W[(size_t)(k0 + kk) * N + n0 + (lane & 31)]); bsum += sh2[k0 + kk] * w; scr[kk * 33 + (lane & 31)] = w * a2[k0 + kk]; }
    bsum += __shfl_xor(bsum, 32);
    if (lane < 32) BPART[(size_t)kb * N + n0 + lane] = bsum;
    LDS_WAIT(); asm volatile("" ::: "memory");
    const int c = lane & 7;
#pragma unroll
    for (int j = 0; j < 4; ++j) { const int n = (lane >> 3) + 8 * j; const LAS float* s = scr + (8 * c) * 33 + n;
        v4u o; o.x = pkbf(s[0 * 33], s[1 * 33]); o.y = pkbf(s[2 * 33], s[3 * 33]); o.z = pkbf(s[4 * 33], s[5 * 33]); o.w = pkbf(s[6 * 33], s[7 * 33]);
        *(GAS v4u*)(WT + (size_t)(rowbase + n) * K + k0 + 8 * c) = o; }
    LDS_WAIT(); asm volatile("" ::: "memory");
}

__device__ __forceinline__ void conv64_plain(const float* W, int K, int N, bf16* WT, int item, LAS float* scr, int lane) {
    const int nblk = N / 64, kb = item / nblk, nb = item % nblk, n0 = 64 * nb, k0 = 64 * kb;
    const int lr = lane >> 4, lc = (lane & 15) * 4;
    f32x4 v[16];
#pragma unroll
    for (int i = 0; i < 16; ++i) v[i] = __builtin_nontemporal_load((const GAS f32x4*)(W + (size_t)(k0 + 4 * i + lr) * N + n0 + lc));
#pragma unroll
    for (int i = 0; i < 16; ++i) { LAS float* p = scr + (4 * i + lr) * 65 + lc; p[0] = v[i].x; p[1] = v[i].y; p[2] = v[i].z; p[3] = v[i].w; }
    LDS_WAIT(); asm volatile("" ::: "memory");
    const int c = lane & 7;
#pragma unroll
    for (int j = 0; j < 8; ++j) { const int n = (lane >> 3) + 8 * j; const LAS float* s = scr + (8 * c) * 65 + n;
        v4u o; o.x = pkbf(s[0 * 65], s[1 * 65]); o.y = pkbf(s[2 * 65], s[3 * 65]); o.z = pkbf(s[4 * 65], s[5 * 65]); o.w = pkbf(s[6 * 65], s[7 * 65]);
        *(GAS v4u*)(WT + (size_t)(n0 + n) * K + k0 + 8 * c) = o; }
    LDS_WAIT(); asm volatile("" ::: "memory");
}

__device__ __forceinline__ unsigned pk4_fp8(float a, float b, float c, float d) { int w = __builtin_amdgcn_cvt_pk_fp8_f32(a, b, 0, false); w = __builtin_amdgcn_cvt_pk_fp8_f32(c, d, w, true); return (unsigned)w; }
__device__ __forceinline__ void norm_row_to_bf16(const float* xrow, bf16* orow, const LAS float* avec, const LAS float* bvec, int lane, unsigned* o4row = nullptr) {
    asm volatile("" ::: "memory");
    const GAS f32x4* xr = (const GAS f32x4*)xrow + lane;
    f32x4 v[16]; float s = 0.f;
#pragma unroll
    for (int j = 0; j < 16; ++j) { v[j] = __builtin_nontemporal_load(&xr[64 * j]); s += (v[j].x * v[j].x + v[j].y * v[j].y) + (v[j].z * v[j].z + v[j].w * v[j].w); }
    const float rstd = 1.0f / sqrtf(wave_sum(s) * (1.f / DM) + EPS);
    GAS unsigned long long* o8 = (GAS unsigned long long*)orow + lane;
#pragma unroll
    for (int j = 0; j < 16; ++j) { const f32x4 a = *(const LAS f32x4*)(avec + 256 * j + 4 * lane), b = *(const LAS f32x4*)(bvec + 256 * j + 4 * lane);
        const f32x4 y = v[j] * rstd * a + b;
        o8[64 * j] = (unsigned long long)pkbf(y.x, y.y) | ((unsigned long long)pkbf(y.z, y.w) << 32);
        if (o4row) ((GAS unsigned*)o4row)[64 * j + lane] = pk4_fp8(y.x, y.y, y.z, y.w);
        if ((j & 3) == 3) __builtin_amdgcn_sched_barrier(0); }
}
namespace rgl {
constexpr int T = 64;
constexpr int L_XRF = 0, L_AF = 32768, L_BF = 65536, L_XRB = 98304, L_SA = 115712, L_SB = 117760, L_END = 119808;
typedef short bf16x8 __attribute__((ext_vector_type(8)));
struct Ptrs { const bf16* RX; const bf16* RGg; const float* conv_w; const float* conv_b; const bf16* Wt; const float* b_a; const float* b_x; const float* lam; float* CA; float* CB; const float* HC; bf16* YREC; };
struct RxBuf { v4u x[2][4]; };
__device__ __forceinline__ void load_rx(const Ptrs& P, int n, int ch, int tid, RxBuf& B) {
#pragma unroll
    for (int jj = 0; jj < 2; ++jj) { const int it = tid + 512 * jj, r = it >> 4, g = it & 15, t = ch * T + r, col = n * 128 + 8 * g;
#pragma unroll
        for (int j = 0; j < 4; ++j) { const int ts = t - 3 + j; B.x[jj][j] = (ts >= 0) ? *(const GAS v4u*)(P.RX + (size_t)ts * DRNN + col) : (v4u){0u, 0u, 0u, 0u}; } }
}
template <int PASS> __device__ __forceinline__ void unit(const Ptrs& P, int n, int ch, LAS unsigned char* lds, int tid, const bf16x8 (&bw)[2][4], float bias_a, float bias_x, float sp,
                                                         RxBuf& RXB_, const f32x4 (&cwv)[4][2], const f32x4 (&cbv)[2], int un) {
    asm volatile("" : "+v"(tid));
    const int lane = tid & 63, wid = tid >> 6, cbase = n * 128, t0 = ch * T;
    LAS float* XRF = (LAS float*)(lds + L_XRF); LAS float* AF = (LAS float*)(lds + L_AF); LAS float* BF = (LAS float*)(lds + L_BF);
    LAS float* SA = (LAS float*)(lds + L_SA); LAS float* SB = (LAS float*)(lds + L_SB);
#pragma unroll
    for (int jj = 0; jj < 2; ++jj) { const int it = tid + 512 * jj, r = it >> 4, g = it & 15;
        float xr[8];
        xr[0] = cbv[0].x; xr[1] = cbv[0].y; xr[2] = cbv[0].z; xr[3] = cbv[0].w; xr[4] = cbv[1].x; xr[5] = cbv[1].y; xr[6] = cbv[1].z; xr[7] = cbv[1].w;
#pragma unroll
        for (int j = 0; j < 4; ++j) { const v4u x = RXB_.x[jj][j]; const f32x4 w0 = cwv[j][0], w1 = cwv[j][1];
            xr[0] += w0.x * bflo(x.x); xr[1] += w0.y * bfhi(x.x); xr[2] += w0.z * bflo(x.y); xr[3] += w0.w * bfhi(x.y);
            xr[4] += w1.x * bflo(x.z); xr[5] += w1.y * bfhi(x.z); xr[6] += w1.z * bflo(x.w); xr[7] += w1.w * bfhi(x.w); }
        *(LAS f32x4*)(XRF + r * 128 + 8 * g) = (f32x4){xr[0], xr[1], xr[2], xr[3]}; *(LAS f32x4*)(XRF + r * 128 + 8 * g + 4) = (f32x4){xr[4], xr[5], xr[6], xr[7]};
        v4u pk; pk.x = pkbf(xr[0], xr[1]); pk.y = pkbf(xr[2], xr[3]); pk.z = pkbf(xr[4], xr[5]); pk.w = pkbf(xr[6], xr[7]);
        *(LAS v4u*)(lds + L_XRB + r * 272 + 16 * g) = pk; }
    if (un >= 0) load_rx(P, un & 15, un >> 4, tid, RXB_);
    __syncthreads();
    { const int fi = lane & 15, kq = lane >> 4;
#pragma unroll
      for (int rt = 0; rt < 4; ++rt) { f32x4 da = (f32x4){0.f, 0.f, 0.f, 0.f}, dx = da;
#pragma unroll
          for (int s = 0; s < 4; ++s) { const bf16x8 af = *(const LAS bf16x8*)(lds + L_XRB + (16 * rt + fi) * 272 + (32 * s + 8 * kq) * 2);
              da = __builtin_amdgcn_mfma_f32_16x16x32_bf16(af, bw[0][s], da, 0, 0, 0);
              dx = __builtin_amdgcn_mfma_f32_16x16x32_bf16(af, bw[1][s], dx, 0, 0, 0); }
          const int e = 16 * wid + fi;
#pragma unroll
          for (int q = 0; q < 4; ++q) { const int t = 16 * rt + 4 * kq + q;
              const float r = sigmoidf_(da[q] + bias_a), ig = sigmoidf_(dx[q] + bias_x);
              const float z = -16.0f * r * sp;
              const float a = __builtin_amdgcn_exp2f(z * (0.5f * LOG2E));
              const float om = (z > -0.03f) ? -z * (1.0f + z * (0.5f + z * (0.16666667f + z * 0.041666668f))) : 1.0f - a * a;
              const float bxv = __builtin_amdgcn_sqrtf(om) * ig * XRF[t * 128 + e];
              AF[t * 128 + e] = a; BF[t * 128 + e] = bxv; }
          __builtin_amdgcn_sched_barrier(0); } }
    __syncthreads();
    const int e = tid & 127, sub = tid >> 7;
    { float A = 1.f, B = 0.f;
#pragma unroll
      for (int q = 0; q < 16; ++q) { const int t = 16 * sub + q; const float a = AF[t * 128 + e], b = BF[t * 128 + e]; B = a * B + b; A = A * a; }
      SA[sub * 128 + e] = A; SB[sub * 128 + e] = B; }
    __syncthreads();
    if (PASS == 1) {
        if (tid < 128) { float A = 1.f, B = 0.f;
#pragma unroll
            for (int s = 0; s < 4; ++s) { const float a = SA[s * 128 + e], b = SB[s * 128 + e]; B = a * B + b; A = A * a; }
            P.CA[(size_t)ch * DRNN + cbase + e] = A; P.CB[(size_t)ch * DRNN + cbase + e] = B; }
    } else {
        float hst = P.HC[(size_t)ch * DRNN + cbase + e];
        for (int s = 0; s < sub; ++s) hst = SA[s * 128 + e] * hst + SB[s * 128 + e];
#pragma unroll
        for (int q = 0; q < 16; ++q) { const int t = 16 * sub + q; hst = AF[t * 128 + e] * hst + BF[t * 128 + e]; AF[t * 128 + e] = hst; }
        __syncthreads();
#pragma unroll
        for (int jj = 0; jj < 2; ++jj) { const int it = tid + 512 * jj, r = it >> 4, g = it & 15, t = t0 + r, col = cbase + 8 * g;
            const v4u gg = *(const GAS v4u*)(P.RGg + (size_t)t * DRNN + col);
            const f32x4 h0 = *(const LAS f32x4*)(AF + r * 128 + 8 * g), h1 = *(const LAS f32x4*)(AF + r * 128 + 8 * g + 4);
            v4u pk; pk.x = pkbf(h0.x * bflo(gg.x), h0.y * bfhi(gg.x)); pk.y = pkbf(h0.z * bflo(gg.y), h0.w * bfhi(gg.y));
            pk.z = pkbf(h1.x * bflo(gg.z), h1.y * bfhi(gg.z)); pk.w = pkbf(h1.z * bflo(gg.w), h1.w * bfhi(gg.w));
            *(GAS v4u*)(P.YREC + (size_t)t * DRNN + col) = pk; }
    }
    __syncthreads();
}
template <int PASS> __device__ __forceinline__ void phase(const Ptrs& P, LAS unsigned char* lds, int tid, int G) {
    const int lane = tid & 63, wid = tid >> 6, fi = lane & 15, kq = lane >> 4;
    int ncur = -1; bf16x8 bw[2][4]; float bias_a = 0.f, bias_x = 0.f, sp = 0.f; f32x4 cwv[4][2], cbv[2];
#pragma unroll
    for (int g = 0; g < 2; ++g)
#pragma unroll
        for (int s = 0; s < 4; ++s) bw[g][s] = (bf16x8){0, 0, 0, 0, 0, 0, 0, 0};
#pragma unroll
    for (int j = 0; j < 4; ++j) { cwv[j][0] = (f32x4){0.f, 0.f, 0.f, 0.f}; cwv[j][1] = cwv[j][0]; }
    cbv[0] = (f32x4){0.f, 0.f, 0.f, 0.f}; cbv[1] = cbv[0];
    const int NU = 16 * (SEQ / T);
    RxBuf cur;
    if ((int)blockIdx.x < NU) load_rx(P, blockIdx.x & 15, blockIdx.x >> 4, tid, cur);
#pragma unroll 1
    for (int u = blockIdx.x; u < NU; u += G) {
        const int n = u & 15, ch = u >> 4;
        if (n != ncur) { ncur = n; const int e = 16 * wid + fi;
#pragma unroll
            for (int g = 0; g < 2; ++g)
#pragma unroll
                for (int s = 0; s < 4; ++s) bw[g][s] = *(const GAS bf16x8*)(P.Wt + ((size_t)(g * 16 + n) * 128 + e) * 128 + 32 * s + 8 * kq);
            bias_a = P.b_a[n * 128 + e]; bias_x = P.b_x[n * 128 + e]; sp = log1pf(__expf(-P.lam[n * 128 + e]));
            const int col = n * 128 + 8 * (tid & 15);
#pragma unroll
            for (int j = 0; j < 4; ++j) { cwv[j][0] = *(const GAS f32x4*)(P.conv_w + j * DRNN + col); cwv[j][1] = *(const GAS f32x4*)(P.conv_w + j * DRNN + col + 4); }
            cbv[0] = *(const GAS f32x4*)(P.conv_b + col); cbv[1] = *(const GAS f32x4*)(P.conv_b + col + 4); }
        unit<PASS>(P, n, ch, lds, tid, bw, bias_a, bias_x, sp, cur, cwv, cbv, (u + G < NU) ? u + G : -1);
    }
}
}

#ifndef PROBE_DUP
#define PROBE_DUP 0
#endif
#define PROBE_REP(k) ((((PROBE_DUP) >> (k)) & 1) + 1)
struct Args { const float* in[27]; float* out; unsigned char* ws; int ph_lo, ph_hi; };
__global__ void __launch_bounds__(NWAVES * 64, 2) mk_fwd(Args args) {
    extern __shared__ __attribute__((aligned(16))) unsigned char lds[];
    Frame F;
    F.lds = (LAS unsigned char*)lds;
    F.MISC = (volatile LAS unsigned*)(F.lds + MISC_OFF);
    F.tid = ftid(); F.lane = F.tid & 63; F.wave = __builtin_amdgcn_readfirstlane(F.tid >> 6);
    F.G = gridDim.x; { const int bx = blockIdx.x; F.vcu = (F.G % 8 == 0) ? (bx % 8) * (F.G / 8) + bx / 8 : bx; }
    unsigned char* ws = args.ws;
    F.ctl = (gu32*)(ws + WS_CTL);
    for (int u = F.tid; u < (LDS_BYTES - LDSCTL_OFF) / 4; u += NWAVES * 64) ((LAS unsigned*)(F.lds + LDSCTL_OFF))[u] = 0u;
    __syncthreads();
    XcdBarrier bar; bar.bar = (unsigned*)(F.ctl + CW_BAR); bar.x = 0; bar.st = nullptr;
    if (N_LAUNCHES == 1) bar = xcd_barrier_post((unsigned*)(F.ctl + CW_BAR), F.MISC + 8);
#define GRID_BAR() do { if (N_LAUNCHES == 1) xcd_barrier(bar); } while (0)
    const int lo = args.ph_lo, hi = args.ph_hi;
#define IN(k) (lo <= (k) && (k) < hi)
#define BOTH(k) (IN(k) && IN((k) + 1))
    const float* x = args.in[0]; const float* cvec = args.in[1]; const float* w_ada = args.in[2]; const float* b_ada = args.in[3]; const float* norm1_w = args.in[4];
    const float* w_in = args.in[5]; const float* lq1 = args.in[6]; const float* lk1 = args.in[7]; const float* lq2 = args.in[8]; const float* lk2 = args.in[9];
    const float* subln_w = args.in[10]; const float* conv_w = args.in[11]; const float* conv_b = args.in[12]; const float* w_rg_a = args.in[13]; const float* b_rg_a = args.in[14];
    const float* w_rg_x = args.in[15]; const float* b_rg_x = args.in[16]; const float* lru_lambda = args.in[17]; const float* w_pa = args.in[18]; const float* w_pr = args.in[19];
    const float* w_out = args.in[20]; const float* norm2_w = args.in[21]; const float* w_up = args.in[22]; const float* fconv_w = args.in[23]; const float* fconv_b = args.in[24];
    const float* w_dn = args.in[25]; const float* normf_w = args.in[26];
    float* out = args.out;
    float* MOD = (float*)(ws + WS_MOD);
    bf16* RGW = (bf16*)(ws + WS_RGW); float* CA = (float*)(ws + WS_CA); float* CB = (float*)(ws + WS_CB); float* HC = (float*)(ws + WS_HC);
    bf16* WIN = (bf16*)(ws + WS_WIN); bf16* WPA = (bf16*)(ws + WS_WPA); bf16* WPR = (bf16*)(ws + WS_WPR); bf16* WOUT = (bf16*)(ws + WS_WOUT); bf16* WUP = (bf16*)(ws + WS_WUP); bf16* WDN = (bf16*)(ws + WS_WDN);
    bf16* HB = (bf16*)(ws + WS_H); bf16* QB_ = (bf16*)(ws + WS_Q); bf16* KB = (bf16*)(ws + WS_K); bf16* VB = (bf16*)(ws + WS_V); bf16* RXB = (bf16*)(ws + WS_RX); bf16* RGB = (bf16*)(ws + WS_RG);
    bf16* GAB = (bf16*)(ws + WS_GA); bf16* GBB = (bf16*)(ws + WS_GB); bf16* O1 = (bf16*)(ws + WS_O1); bf16* O2 = (bf16*)(ws + WS_O2); bf16* MIX = (bf16*)(ws + WS_MIX);
    bf16* ACT = (bf16*)(ws + WS_ACT); float* GT = (float*)(ws + WS_GT); float* GH = (float*)(ws + WS_GH); float* UH = (float*)(ws + WS_UH);
    bf16* YATT = QB_; bf16* YREC = KB; bf16* M1 = HB; bf16* X1B = HB;
    unsigned char* H8 = ws + WS_H8; unsigned char* W8 = ws + WS_W8;
    float* PART = (float*)(ws + WS_PART); float* RSTD = (float*)(ws + WS_RSTD); float* BIAS2 = (float*)(ws + WS_BIAS2); float* BPART = (float*)(ws + WS_BPART);
    const int gw = F.vcu * NWAVES + F.wave, NGW = F.G * NWAVES;

#ifndef NO_P0
    if (IN(0)) { F.tid = ftid(); F.lane = F.tid & 63;
      for (int rep = 0; rep < PROBE_REP(0); ++rep) {
        { LAS float* sc_l = (LAS float*)(F.lds);
          LAS float* red = (LAS float*)(F.lds + 16384);
          for (int i = F.tid; i < DM; i += NWAVES * 64) { const float cv = cvec[i]; sc_l[i] = cv * sigmoidf_(cv); }
          __syncthreads();
          for (int cb = blockIdx.x; cb < (6 * DM) / 96; cb += F.G) {
              const int rgp = F.tid >> 5, cl = F.tid & 31;
              f32x4 a = (f32x4){0.f, 0.f, 0.f, 0.f};
              if (cl < 24) { const float* wp = w_ada + (size_t)rgp * (6 * DM) + 96 * cb + 4 * cl;
#pragma unroll 8
                  for (int k = 0; k < DM / 16; ++k) { const f32x4 w = __builtin_nontemporal_load((const GAS f32x4*)(wp + (size_t)k * 16 * (6 * DM))); a += w * sc_l[rgp + 16 * k]; }
                  *(LAS f32x4*)(red + rgp * 96 + 4 * cl) = a; }
              __syncthreads();
              if (F.tid < 96) { float s = 0.f;
#pragma unroll
                  for (int g = 0; g < 16; ++g) s += red[g * 96 + F.tid];
                  MOD[96 * cb + F.tid] = s + b_ada[96 * cb + F.tid]; }
              __syncthreads(); } }
        { LAS float* scr = (LAS float*)(F.lds + RING_OFF + F.wave * 16384);
          constexpr int I_IN = (DM / 64) * (DIN / 32), I_PA = (2048 / 64) * (DM / 32), I_OUT = (DM / 64) * (DM / 32), I_DN = (DFF / 64) * (DM / 32), I_RG = 16 * 2 * 4;
          constexpr int NITEMS = I_IN + 2 * I_PA + I_OUT + 2 * I_RG;
          for (int it = gw; it < NITEMS; it += NGW) {
              int r = it;
              if (r < I_IN) { const int nb = r % (DIN / 32), kb = r / (DIN / 32);
                  const int n0 = 32 * nb, r8 = (n0 >= 2048 && n0 < 6144) ? n0 - 2048 : ((n0 >= 10240 && n0 < 14336) ? n0 - 10240 + 4096 : -1);
                  if (r8 >= 0) transpose_item_fp8(w_in, DM, DIN, W8, 64 * kb, n0, r8, scr, F.lane, W8SCALE);
                  else transpose_matrix_item(w_in, DM, DIN, WIN, r, 0, scr, F.lane);
                  continue; } r -= I_IN;
              if (r < I_PA) { const int nb = r % (DM / 32), kb = r / (DM / 32); transpose_item_fp8(w_pa, 2048, DM, (unsigned char*)WPA, 64 * kb, 32 * nb, 32 * nb, scr, F.lane, WPA8SCALE); continue; } r -= I_PA;
              if (r < I_PA) { transpose_matrix_item(w_pr, 2048, DM, WPR, r, 0, scr, F.lane); continue; } r -= I_PA;
              if (r < I_OUT) { transpose_matrix_item(w_out, DM, DM, WOUT, r, 0, scr, F.lane); continue; } r -= I_OUT;
              if (r < I_RG) { const int nb = r >> 3; transpose_matrix_item(w_rg_a + (size_t)nb * 16384, 128, 128, RGW + (size_t)nb * 16384, r & 7, 0, scr, F.lane); continue; } r -= I_RG;
              { const int nb = r >> 3; transpose_matrix_item(w_rg_x + (size_t)nb * 16384, 128, 128, RGW + (size_t)(16 + nb) * 16384, r & 7, 0, scr, F.lane); }
          } }
        if (PROBE_REP(0) > 1) __syncthreads();
      }
        if (BOTH(0)) GRID_BAR();
    }
#endif
#ifndef NO_P1
    if (IN(1)) { F.tid = ftid(); F.lane = F.tid & 63;
        LAS float* av = (LAS float*)(F.lds); LAS float* bv = (LAS float*)(F.lds + 16384); LAS float* a2 = (LAS float*)(F.lds + 32768); LAS float* s2 = (LAS float*)(F.lds + 49152);
        for (int i = F.tid; i < DM; i += NWAVES * 64) { av[i] = norm1_w[i] * (1.0f + MOD[DM + i]); bv[i] = MOD[i]; a2[i] = norm2_w[i] * (1.0f + MOD[4 * DM + i]); s2[i] = MOD[3 * DM + i]; }
        __syncthreads();
        for (int rep = 0; rep < PROBE_REP(1); ++rep) {
#pragma unroll 1
        for (int m = gw; m < SEQ; m += NGW) norm_row_to_bf16(x + (size_t)m * DM, HB + (size_t)m * DM, av, bv, F.lane, (unsigned*)(H8 + (size_t)m * DM));
        { LAS float* scr = (LAS float*)(F.lds + 65536 + F.wave * 8448);
          constexpr int I_UP = (DM / 64) * (NUP / 32);
#pragma unroll 1
          for (int it = gw; it < I_UP; it += NGW) transpose_up_item(w_up, WUP, it, a2, s2, BPART, scr, F.lane); }
        }
        if (BOTH(1)) GRID_BAR();
    }
#endif
#ifndef NO_P2
    if (IN(2)) { F.tid = ftid(); F.lane = F.tid & 63;
        { pg8::Gemm g{HB, WIN, SEQ, DIN - NPROJ8, DM, DM}; pg8::ProjOrder16 S; S.init(SEQ, DIN - NPROJ8, F.G, (int)blockIdx.x);
          pg8::EpiProj E{QB_, KB, VB, RXB, RGB, GAB, GBB, QSCALE, 1.0f};
          pg8::gemm_phase<pg8::EpiProj, pg8::ProjOrder16, true, true>(F.lds + RING_OFF, g, S, E); }
        VM_WAIT(); __syncthreads();
        { pg8::Gemm g{(const pg8::bf16_t*)H8, (const pg8::bf16_t*)W8, SEQ, NPROJ8, DM, DM}; pg8::StaticOrder S; S.init(SEQ, NPROJ8, F.G, (int)blockIdx.x);
          pg8::EpiProjF8 E2{pg8::EpiProj{QB_, KB, VB, RXB, RGB, GAB, GBB, QSCALE, 1.0f / W8SCALE}};
          pg8::gemm_phase<pg8::EpiProjF8, pg8::StaticOrder, true, true, true>(F.lds + RING_OFF, g, S, E2); }
        if (BOTH(2)) GRID_BAR();
    }
#endif
    const rgl::Ptrs RP{RXB, RGB, conv_w, conv_b, RGW, b_rg_a, b_rg_x, lru_lambda, CA, CB, HC, YREC};
#ifndef NO_P3
    if (IN(3)) { F.tid = ftid(); F.lane = F.tid & 63;
        for (int rep = 0; rep < PROBE_REP(3); ++rep) {
        rgl::phase<1>(RP, F.lds, F.tid, F.G);
        { float qm[4] = {0.f, 0.f, 0.f, 0.f};
#pragma unroll 1
          for (int m = gw; m < SEQ; m += NGW) {
#pragma unroll
              for (int j = 0; j < 4; ++j) { const size_t off = (size_t)m * 2048 + 512 * j + 8 * F.lane;
                  const v4u a = *(const GAS v4u*)(QB_ + off);
                  float sa = (bflo(a.x) * bflo(a.x) + bfhi(a.x) * bfhi(a.x)) + (bflo(a.y) * bflo(a.y) + bfhi(a.y) * bfhi(a.y)) + (bflo(a.z) * bflo(a.z) + bfhi(a.z) * bfhi(a.z)) + (bflo(a.w) * bflo(a.w) + bfhi(a.w) * bfhi(a.w));
                  sa += __shfl_xor(sa, 1); sa += __shfl_xor(sa, 2); sa += __shfl_xor(sa, 4);
                  qm[j] = fmaxf(qm[j], sa); } }
          if ((F.lane & 7) == 0) {
#pragma unroll
              for (int j = 0; j < 4; ++j) __hip_atomic_fetch_max(F.ctl + CW_QKMAX + 8 * j + (F.lane >> 3), __float_as_uint(qm[j]), RLX_AGENT); }
#pragma unroll 1
          for (int it = gw; it < 32 * 256; it += NGW) { const bf16* kp = KB + (size_t)it * 4096 + F.lane * 8; float sb = 0.f;
#pragma unroll
              for (int ch = 0; ch < 8; ++ch) { const v4u b = *(const GAS v4u*)(kp + ch * 512);
                  sb += (bflo(b.x) * bflo(b.x) + bfhi(b.x) * bfhi(b.x)) + (bflo(b.y) * bflo(b.y) + bfhi(b.y) * bfhi(b.y)) + (bflo(b.z) * bflo(b.z) + bfhi(b.z) * bfhi(b.z)) + (bflo(b.w) * bflo(b.w) + bfhi(b.w) * bfhi(b.w)); }
#pragma unroll
              for (int o = 1; o < 64; o <<= 1) sb = fmaxf(sb, __shfl_xor(sb, o));
              if (F.lane == 0) __hip_atomic_fetch_max(F.ctl + CW_QKMAX + 32 + (it >> 8), __float_as_uint(sb), RLX_AGENT); } }
        }
        if (BOTH(3)) GRID_BAR();
    }
#endif
#ifndef NO_P4
    if (IN(4)) { F.tid = ftid(); F.lane = F.tid & 63;
        if (blockIdx.x < 4) { const int e = blockIdx.x * 512 + F.tid; float hst = 0.f;
            for (int c0 = 0; c0 < SEQ / rgl::T; c0 += 8) { float a[8], b[8];
#pragma unroll
                for (int j = 0; j < 8; ++j) { a[j] = CA[(size_t)(c0 + j) * DRNN + e]; b[j] = CB[(size_t)(c0 + j) * DRNN + e]; }
#pragma unroll
                for (int j = 0; j < 8; ++j) { HC[(size_t)(c0 + j) * DRNN + e] = hst; hst = a[j] * hst + b[j]; } }
            VM_WAIT(); __syncthreads(); }
        for (int rep = 0; rep < PROBE_REP(4); ++rep)
        for (;;) {
            if (F.tid == 0) F.MISC[16] = __hip_atomic_fetch_add(F.ctl + CW_ATTQ + 64 * rep, 1u, RLX_AGENT);
            __syncthreads();
            const int idx = (int)F.MISC[16];
            __syncthreads();
            if (idx >= 2048) break;
            const int h = 15 - (idx >> 7), qb = 63 - ((idx >> 1) & 63), c = idx & 1;
            const float sl2 = exp2f(-0.5f * (float)(h + 1)) * LOG2E;
            const float qm = __uint_as_float(__hip_atomic_load(F.ctl + CW_QKMAX + 2 * h + c, RLX_AGENT)), km = __uint_as_float(__hip_atomic_load(F.ctl + CW_QKMAX + 32 + 2 * h + c, RLX_AGENT));
            const float Bq = sqrtf(qm * km) * 1.001f + 0.01f;
            const float dmaxf = (2.0f * Bq + 44.0f) / sl2;
            int t_start = 0;
            if (dmaxf < 20000.0f) { const int lim = qb * 256 - (int)ceilf(dmaxf) - 63; t_start = (lim >= 0) ? (lim >> 6) + 1 : 0; if (t_start > 4 * qb) t_start = 4 * qb; }
            att::attn_unit(h, c, qb, QB_, KB, VB, c ? O2 : O1, (att::lds_ptr)(F.lds + RING_OFF), sl2, t_start, sqrtf(km));
        }
        if (BOTH(4)) GRID_BAR();
    }
#endif
#ifndef NO_P5
    if (IN(5)) { F.tid = ftid(); F.lane = F.tid & 63;
        for (int rep = 0; rep < PROBE_REP(5); ++rep) {
        rgl::phase<2>(RP, F.lds, F.tid, F.G);
        float lam;
        { const float p1 = (F.lane < 64) ? lq1[F.lane] * lk1[F.lane] : 0.f, p2 = lq2[F.lane] * lk2[F.lane];
          lam = __expf(wave_sum(p1)) - __expf(wave_sum(p2)) + 0.2f; }
        float sw[8];
#pragma unroll
        for (int j = 0; j < 8; ++j) sw[j] = subln_w[8 * (F.lane & 15) + j] * 0.8f;
#pragma unroll 1
        for (int m = gw; m < SEQ; m += NGW) {
#pragma unroll
            for (int j = 0; j < 4; ++j) { const size_t off = (size_t)m * 2048 + 512 * j + 8 * F.lane;
                const v4u a = *(const GAS v4u*)(O1 + off), b = *(const GAS v4u*)(O2 + off);
                float d[8]; d[0] = bflo(a.x) - lam * bflo(b.x); d[1] = bfhi(a.x) - lam * bfhi(b.x); d[2] = bflo(a.y) - lam * bflo(b.y); d[3] = bfhi(a.y) - lam * bfhi(b.y);
                d[4] = bflo(a.z) - lam * bflo(b.z); d[5] = bfhi(a.z) - lam * bfhi(b.z); d[6] = bflo(a.w) - lam * bflo(b.w); d[7] = bfhi(a.w) - lam * bfhi(b.w);
                float ss = 0.f;
#pragma unroll
                for (int q = 0; q < 8; ++q) ss += d[q] * d[q];
                ss += __shfl_xor(ss, 1); ss += __shfl_xor(ss, 2); ss += __shfl_xor(ss, 4); ss += __shfl_xor(ss, 8);
                const float rstd = 1.0f / sqrtf(ss * (1.f / 128.f) + EPS);
                v4u o; o.x = pkbf(d[0] * rstd * sw[0], d[1] * rstd * sw[1]); o.y = pkbf(d[2] * rstd * sw[2], d[3] * rstd * sw[3]);
                o.z = pkbf(d[4] * rstd * sw[4], d[5] * rstd * sw[5]); o.w = pkbf(d[6] * rstd * sw[6], d[7] * rstd * sw[7]);
                (void)o;
                *(GAS unsigned long long*)((unsigned char*)YATT + off) = (unsigned long long)pk4_fp8(d[0] * rstd * sw[0], d[1] * rstd * sw[1], d[2] * rstd * sw[2], d[3] * rstd * sw[3])
                    | ((unsigned long long)pk4_fp8(d[4] * rstd * sw[4], d[5] * rstd * sw[5], d[6] * rstd * sw[6], d[7] * rstd * sw[7]) << 32); } }
        }
        if (BOTH(5)) GRID_BAR();
    }
#endif
#ifndef NO_P6
    if (IN(6)) { F.tid = ftid(); F.lane = F.tid & 63;
        { pg8::Gemm g{YATT, WPA, SEQ, DM, 2048, 2048}; pg8::StaticOrder S; S.init(SEQ, DM, F.G, (int)blockIdx.x);
          pg8::EpiGate<false> E{GAB, nullptr, M1, 1.0f / WPA8SCALE};
          pg8::gemm_phase<pg8::EpiGate<false>, pg8::StaticOrder, true, true, true>(F.lds + RING_OFF, g, S, E); }
        VM_WAIT(); __syncthreads();
        { pg8::Gemm g{YREC, WPR, SEQ, DM, 2048, 2048}; pg8::StaticOrder S; S.init(SEQ, DM, F.G, (int)blockIdx.x);
          pg8::EpiGate<true> E{GBB, M1, MIX, 1.0f};
          pg8::gemm_phase<pg8::EpiGate<true>, pg8::StaticOrder, true, true>(F.lds + RING_OFF, g, S, E); }
        if (BOTH(6)) GRID_BAR();
    }
#endif
#ifndef NO_P7
    if (IN(7)) { F.tid = ftid(); F.lane = F.tid & 63;
        pg8::Gemm g{MIX, WOUT, SEQ, DM, DM, DM}; pg8::StaticOrder S; S.init(SEQ, DM, F.G, (int)blockIdx.x);
        pg8::EpiRes1 E{x, MOD + 2 * DM, X1B, PART};
        for (int rep = 0; rep < PROBE_REP(7); ++rep) pg8::gemm_phase<pg8::EpiRes1, pg8::StaticOrder, true, true>(F.lds + RING_OFF, g, S, E);
        if (BOTH(7)) GRID_BAR();
    }
#endif
#ifndef NO_P8
    if (IN(8)) { F.tid = ftid(); F.lane = F.tid & 63;
        const int gt = blockIdx.x * (NWAVES * 64) + F.tid, GT_ = F.G * NWAVES * 64;
        for (int row = gt; row < SEQ; row += GT_) { const GAS f32x4* p = (const GAS f32x4*)(PART + (size_t)row * 64); float s = 0.f;
#pragma unroll
            for (int j = 0; j < 16; ++j) { const f32x4 v = p[j]; s += (v.x + v.y) + (v.z + v.w); }
            RSTD[row] = 1.0f / sqrtf(s * (1.f / DM) + EPS); }
        for (int n = gt; n < NUP; n += GT_) { float s = 0.f;
#pragma unroll 8
            for (int kb = 0; kb < DM / 64; ++kb) s += BPART[(size_t)kb * NUP + n];
            BIAS2[n] = s; }
        if (BOTH(8)) GRID_BAR();
    }
#endif
#ifndef NO_P9
    if (IN(9)) { F.tid = ftid(); F.lane = F.tid & 63;
        { F.tid = ftid(); F.lane = F.tid & 63;
          if (F.G == 256 && ((int)blockIdx.x & 7) >= 4) { const int wi = ((((int)blockIdx.x >> 3) * 4) + (((int)blockIdx.x & 7) - 4)) * NWAVES + F.wave;
              LAS float* scr = (LAS float*)(F.lds + RING_OFF + F.wave * 16640);
              constexpr int I_DN64 = (DFF / 64) * (DM / 64);
#pragma unroll 1
              for (int it = wi; it < I_DN64; it += 128 * NWAVES) conv64_plain(w_dn, DFF, DM, WDN, it, scr, F.lane); }
          else if (F.G != 256) { const int wi = (int)blockIdx.x * NWAVES + F.wave; LAS float* scr = (LAS float*)(F.lds + RING_OFF + F.wave * 16640); constexpr int I_DN64 = (DFF / 64) * (DM / 64);
#pragma unroll 1
              for (int it = wi; it < I_DN64; it += F.G * NWAVES) conv64_plain(w_dn, DFF, DM, WDN, it, scr, F.lane); } }
        __syncthreads();
        F.tid = ftid(); F.lane = F.tid & 63;
        pg8::Gemm g{X1B, WUP, SEQ, NUP, DM, DM}; pg8::HalfXcdOrder S; S.init(SEQ, NUP, F.G, (int)blockIdx.x);
        pg8::EpiFfn E{ACT, fconv_w, fconv_b, GT, GH, UH, (LAS float*)(F.lds + BND_OFF), DFF, RSTD, BIAS2, (LAS float*)(F.lds + BND_OFF + 4096)};
        for (int rep = 0; rep < PROBE_REP(9); ++rep) pg8::gemm_phase<pg8::EpiFfn, pg8::HalfXcdOrder, true, true>(F.lds + RING_OFF, g, S, E);
        if (BOTH(9)) GRID_BAR();
    }
#endif
#ifndef NO_P10
    if (IN(10)) { F.tid = ftid(); F.lane = F.tid & 63;
        for (int it = blockIdx.x * (NWAVES * 64) + F.tid; it < 64 * DFF; it += F.G * NWAVES * 64) {
            const int pm = it / DFF, cc = it % DFF;
            const float w0 = fconv_w[cc], w1 = fconv_w[DFF + cc], w2 = fconv_w[2 * DFF + cc], bb = fconv_b[cc];
            const float gm2 = pm ? GT[((size_t)(pm - 1) * 2 + 0) * DFF + cc] : 0.f, gm1 = pm ? GT[((size_t)(pm - 1) * 2 + 1) * DFF + cc] : 0.f;
            const float g0 = GH[((size_t)pm * 2 + 0) * DFF + cc], g1 = GH[((size_t)pm * 2 + 1) * DFF + cc];
            const float u0 = UH[((size_t)pm * 2 + 0) * DFF + cc], u1 = UH[((size_t)pm * 2 + 1) * DFF + cc];
            const float y0 = gelu_tanhf_(bb + w0 * gm2 + w1 * gm1 + w2 * g0) * u0, y1 = gelu_tanhf_(bb + w0 * gm1 + w1 * g0 + w2 * g1) * u1;
            ACT[(size_t)(256 * pm) * DFF + cc] = (bf16)(pkbf(y0, y0) & 0xffffu); ACT[(size_t)(256 * pm + 1) * DFF + cc] = (bf16)(pkbf(y1, y1) & 0xffffu);
        }
        if (BOTH(10)) GRID_BAR();
    }
#endif
#ifndef NO_P11
    if (IN(11)) { F.tid = ftid(); F.lane = F.tid & 63;
        pg8::Gemm g{ACT, WDN, SEQ, DM, DFF, DFF}; pg8::StaticOrder S; S.init(SEQ, DM, F.G, (int)blockIdx.x);
        pg8::EpiRes2 E{X1B, MOD + 5 * DM};
        pg8::gemm_phase<pg8::EpiRes2, pg8::StaticOrder, true, true>(F.lds + RING_OFF, g, S, E);
        if (BOTH(11)) GRID_BAR();
    }
#endif
#ifndef NO_P12
    if (IN(12)) { F.tid = ftid(); F.lane = F.tid & 63;
#pragma unroll 1
        for (int m = gw; m < SEQ; m += NGW) {
            const GAS v4u* xr = (const GAS v4u*)(X1B + (size_t)m * DM) + F.lane;
            v4u v[8]; float s = 0.f;
#pragma unroll
            for (int j = 0; j < 8; ++j) { v[j] = xr[64 * j];
                s += (bflo(v[j].x) * bflo(v[j].x) + bfhi(v[j].x) * bfhi(v[j].x)) + (bflo(v[j].y) * bflo(v[j].y) + bfhi(v[j].y) * bfhi(v[j].y))
                   + (bflo(v[j].z) * bflo(v[j].z) + bfhi(v[j].z) * bfhi(v[j].z)) + (bflo(v[j].w) * bflo(v[j].w) + bfhi(v[j].w) * bfhi(v[j].w)); }
            const float rstd = 1.0f / sqrtf(wave_sum(s) * (1.f / DM) + EPS);
            GAS f32x4* orow = (GAS f32x4*)(out + (size_t)m * DM);
#pragma unroll
            for (int j = 0; j < 8; ++j) { const int c0 = 512 * j + 8 * F.lane;
                const f32x4 w0 = *(const GAS f32x4*)(normf_w + c0), w1 = *(const GAS f32x4*)(normf_w + c0 + 4);
                orow[c0 / 4] = (f32x4){bflo(v[j].x) * rstd * w0.x, bfhi(v[j].x) * rstd * w0.y, bflo(v[j].y) * rstd * w0.z, bfhi(v[j].y) * rstd * w0.w};
                orow[c0 / 4 + 1] = (f32x4){bflo(v[j].z) * rstd * w1.x, bfhi(v[j].z) * rstd * w1.y, bflo(v[j].w) * rstd * w1.z, bfhi(v[j].w) * rstd * w1.w}; }
        }
    }
#endif
#undef IN
#undef BOTH
#undef GRID_BAR
}

extern "C" void kernel_launch(void* const* d_in, const int* in_sizes, int n_in, void* d_out, int out_size, void* d_ws, size_t ws_size, hipStream_t stream) {
    static int grid = 0;
    if (grid == 0) {
        if (n_in != 27 || out_size != SEQ * DM || ws_size < WS_END) { fprintf(stderr, "kernel_launch: unexpected problem (n_in %d, out %d, ws %zu); nothing launched\n", n_in, out_size, ws_size); grid = -1; return; }
        int dev = 0, cus = 0, per_cu = 0;
        if (hipGetDevice(&dev) != hipSuccess || hipDeviceGetAttribute(&cus, hipDeviceAttributeMultiprocessorCount, dev) != hipSuccess) { grid = -1; return; }
        if (hipFuncSetAttribute((const void*)mk_fwd, hipFuncAttributeMaxDynamicSharedMemorySize, LDS_BYTES) != hipSuccess) { fprintf(stderr, "kernel_launch: hipFuncSetAttribute failed\n"); grid = -1; return; }
        if (hipOccupancyMaxActiveBlocksPerMultiprocessor(&per_cu, (const void*)mk_fwd, NWAVES * 64, LDS_BYTES) != hipSuccess || per_cu < 1)
            fprintf(stderr, "kernel_launch: note: occupancy query reports %d workgroups per CU\n", per_cu);
        (void)hipGetLastError();
        grid = cus;
    }
    if (grid < 0) return;
    if (hipMemsetAsync((char*)d_ws + WS_CTL, 0, CTL_ZERO_BYTES, stream) != hipSuccess) return;
    Args a{};
    for (int i = 0; i < 27; ++i) a.in[i] = (const float*)d_in[i];
    a.out = (float*)d_out; a.ws = (unsigned char*)d_ws;
    for (int li = 0; li < N_LAUNCHES; ++li) {
        a.ph_lo = (N_LAUNCHES == 1) ? 0 : li; a.ph_hi = (N_LAUNCHES == 1) ? N_PHASES : li + 1;
        hipLaunchKernelGGL(mk_fwd, dim3(grid), dim3(NWAVES * 64), LDS_BYTES, stream, a);
        const hipError_t le = hipPeekAtLastError();
        if (le != hipSuccess) { fprintf(stderr, "kernel_launch: launch %d failed: %s\n", li, hipGetErrorName(le)); break; }
    }
}
```

```cpp
#include <hip/hip_runtime.h>
#include <cstdio>
#include <cstdint>
#ifndef MK_N_LAUNCHES
#define MK_N_LAUNCHES 1
#endif
__device__ __forceinline__ int ftid() { int t = (int)threadIdx.x; asm volatile("" : "+v"(t)); return t; }
namespace pg8 {
#define PG8_LAS __attribute__((address_space(3)))
typedef unsigned short bf16_t;
typedef short bf16x8 __attribute__((ext_vector_type(8)));
typedef float f32x4 __attribute__((ext_vector_type(4)));
typedef unsigned u32x4 __attribute__((ext_vector_type(4)));
constexpr int BM = 256, BK = 64, HALF = 128, HTB = HALF * BK * 2  , STAGE_BYTES = 8 * HTB, NXCD = 8, WGM = 8;

__host__ __device__ __forceinline__ int lds_byte(int r, int c) { const int st = (r >> 4) * 2 + (c >> 5), rr = r & 15, cc = c & 31, ob = rr * 64 + cc * 2; return st * 1024 + (ob ^ (((ob >> 9) & 1) << 5)); }
__host__ __device__ __forceinline__ void stage_rc(int b, int& R, int& C) { const int st = b / 1024, sb = b % 1024, swz = sb ^ (((sb >> 9) & 1) << 5); R = (st >> 1) * 16 + swz / 64; C = (st & 1) * 32 + (swz % 64) / 2; }
__host__ __device__ __forceinline__ int perm32(int rho) { const int n = rho >> 4, i = rho & 15; return 8 * (i >> 2) + 4 * n + (i & 3); }

struct Unit { int pm, pn; };
struct Gemm { const bf16_t* A; const bf16_t* Bt; int M, N, K, ld; };

struct StaticOrder {
    int nM, nN, nwg, G, c;
    __host__ __device__ void init(int M, int N, int G_, int c_) { nM = M / BM; nN = N / BM; nwg = nM * nN; G = G_; c = c_; }
    __host__ __device__ bool next(int i, Unit& u) const {
        const long L = (long)i * G + c; if (L >= nwg) return false;
        int wgid = (int)L; { const int q = nwg / NXCD, r = nwg % NXCD, xcd = wgid % NXCD, off = wgid / NXCD; wgid = (xcd < r ? xcd * (q + 1) : r * (q + 1) + (xcd - r) * q) + off; }
        const int nig = WGM * nN, gid = wgid / nig, fm = gid * WGM, gsz = (nM - fm) < WGM ? (nM - fm) : WGM;
        u.pm = fm + ((wgid % nig) % gsz); u.pn = (wgid % nig) / gsz; return true;
    }
    __device__ __forceinline__ void a_ready(const Unit&) const {}
    __device__ __forceinline__ void done(const Unit&) const {}
};

struct HalfXcdOrder : StaticOrder {
    __host__ __device__ bool next(int i, Unit& u) const {
        const int full = nwg / G;
        if (i < full) return StaticOrder::next(i, u);
        if (i > full || (nwg % G) * 2 != G || G != 256) return (nwg % G) * 2 != G || G != 256 ? StaticOrder::next(i, u) : false;
        const int xcd = c % NXCD, slot = c / NXCD, q = nwg / NXCD; if (xcd >= 4) return false;
        const int wgid = (slot < 16 ? xcd : xcd + 4) * q + full * (G / NXCD) + (slot & 15);
        const int nig = WGM * nN, gid = wgid / nig, fm = gid * WGM, gsz = (nM - fm) < WGM ? (nM - fm) : WGM;
        u.pm = fm + ((wgid % nig) % gsz); u.pn = (wgid % nig) / gsz; return true;
    }
};
struct ProjOrder16 : StaticOrder {
    __host__ __device__ bool next(int i, Unit& u) const { if (!StaticOrder::next(i, u)) return false; u.pn = u.pn < 16 ? u.pn + 24 : u.pn + 40; return true; }
};
struct StaticOrderFixed : StaticOrder {
    __host__ __device__ bool next(int i, Unit& u) const { const long L = (long)i * G + c; if (L >= nwg) return false; StaticOrder t = *this; return t.StaticOrder::next(0, u); }
};
__device__ __forceinline__ unsigned cvt_pk_bf16(float lo, float hi) { unsigned r; asm volatile("v_cvt_pk_bf16_f32 %0, %1, %2" : "=v"(r) : "v"(lo), "v"(hi)); return r; }
typedef float f32x2 __attribute__((ext_vector_type(2)));
__device__ __forceinline__ float sigmoid_f(float v) { return __builtin_amdgcn_rcpf(1.0f + __builtin_amdgcn_exp2f(-1.4426950408889634f * v)); }
__device__ __forceinline__ float gelu_tanh_f(float v) { const float u = v * (0.7978845608028654f + 0.035677408136300125f * v * v);
    return v * __builtin_amdgcn_rcpf(1.0f + __builtin_amdgcn_exp2f(-2.8853900817779268f * u)); }
__device__ __forceinline__ float bf_lo(unsigned w) { return __uint_as_float(w << 16); }
__device__ __forceinline__ float bf_hi(unsigned w) { return __uint_as_float(w & 0xffff0000u); }

template <int ACT, int LAYOUT = 0> __device__ __forceinline__ void store_tile_bf16(const f32x4 (&acc)[2][2][4][2], bf16_t* base, int ldc, int row0, int col0, float sc) {
#pragma unroll
    for (int ai = 0; ai < 2; ++ai)
#pragma unroll
        for (int m = 0; m < 4; ++m) { const int row = row0 + ai * HALF + m * 16; bf16_t* rowp = base + (size_t)row * ldc + col0;
            if (LAYOUT == 1) rowp = base + ((size_t)((col0 >> 6) * 256 + (row >> 6)) * 4096 + ((col0 & 63) >> 3) * 512 + (row & 63) * 8);
            if (LAYOUT == 2) rowp = base + ((size_t)((col0 >> 7) * 256 + (row >> 6)) * 8192 + (((col0 & 127) >> 5) * 4 + ((row & 63) >> 4)) * 512 + (row & 15) * 32 + (col0 & 31));
#pragma unroll
            for (int bj = 0; bj < 2; ++bj) { f32x4 v0 = acc[ai][bj][m][0], v1 = acc[ai][bj][m][1];
                if (ACT == 0) { v0 = v0 * sc; v1 = v1 * sc; }
                if (ACT == 2) {
#pragma unroll
                    for (int j = 0; j < 4; ++j) { v0[j] = gelu_tanh_f(v0[j]); v1[j] = gelu_tanh_f(v1[j]); } }
                if (ACT == 3) {
#pragma unroll
                    for (int j = 0; j < 4; ++j) { v0[j] = sigmoid_f(v0[j] * sc); v1[j] = sigmoid_f(v1[j] * sc); } }
                u32x4 w; w.x = cvt_pk_bf16(v0[0], v0[1]); w.y = cvt_pk_bf16(v0[2], v0[3]); w.z = cvt_pk_bf16(v1[0], v1[1]); w.w = cvt_pk_bf16(v1[2], v1[3]);
                *(u32x4*)(rowp + (LAYOUT == 1 ? bj * 2 * 256 * 4096 : LAYOUT == 2 ? bj * 256 * 8192 : bj * HALF)) = w;
                if (ACT != 0) __builtin_amdgcn_sched_barrier(0); } }
}
struct EpiProj {
    static constexpr bool PERM = true, AFTER_DRAIN = false;
    bf16_t *Q, *K, *V, *RX, *RG, *GA, *GB; float qscale, gscale;
    __device__ __forceinline__ void operator()(const f32x4 (&acc)[2][2][4][2], const Unit& u, int wr, int wc, int fr, int fq) const {
        const int pn = u.pn; const int row0 = u.pm * BM + wr * 64 + fr, cw = wc * 32 + 8 * fq;
        bf16_t* base; int ldc = 2048, colt, kind = 0; float sc = 1.0f;
        if (pn < 8)       { base = Q;  colt = pn * 256; sc = qscale * gscale; }
        else if (pn < 16) { base = K;  colt = (pn - 8) * 256; kind = 4; sc = gscale; }
        else if (pn < 24) { base = V;  colt = (pn - 16) * 256; kind = 5; sc = gscale; }
        else if (pn < 32) { base = RX; colt = (pn - 24) * 256; }
        else if (pn < 40) { base = RG; colt = (pn - 32) * 256; kind = 2; }
        else if (pn < 56) { base = GA; colt = (pn - 40) * 256; kind = 3; ldc = 4096; sc = gscale; }
        else              { base = GB; colt = (pn - 56) * 256; kind = 3; ldc = 4096; sc = gscale; }
        if (kind == 4)      store_tile_bf16<0, 1>(acc, base, ldc, row0, colt + cw, sc);
        else if (kind == 5) store_tile_bf16<0, 2>(acc, base, ldc, row0, colt + cw, sc);
        else if (kind == 0) store_tile_bf16<0>(acc, base, ldc, row0, colt + cw, sc);
        else if (kind == 2) store_tile_bf16<2>(acc, base, ldc, row0, colt + cw, sc);
        else                store_tile_bf16<3>(acc, base, ldc, row0, colt + cw, sc);
    }
};
struct EpiProjOff {
    static constexpr bool PERM = true, AFTER_DRAIN = false;
    EpiProj e; int off;
    __device__ __forceinline__ void operator()(const f32x4 (&acc)[2][2][4][2], const Unit& u, int wr, int wc, int fr, int fq) const { Unit u2 = u; u2.pn += off; e(acc, u2, wr, wc, fr, fq); }
};
struct EpiProjF8 {
    static constexpr bool PERM = true, AFTER_DRAIN = false;
    EpiProj e;
    __device__ __forceinline__ void operator()(const f32x4 (&acc)[2][2][4][2], const Unit& u, int wr, int wc, int fr, int fq) const { Unit u2 = u; u2.pn = u.pn < 24 ? u.pn : u.pn + 16; e(acc, u2, wr, wc, fr, fq); }
};
struct EpiPlain {
    static constexpr bool PERM = true, AFTER_DRAIN = false;
    bf16_t* O; int ldc;
    __device__ __forceinline__ void operator()(const f32x4 (&acc)[2][2][4][2], const Unit& u, int wr, int wc, int fr, int fq) const {
        store_tile_bf16<0>(acc, O, ldc, u.pm * BM + wr * 64 + fr, u.pn * BM + wc * 32 + 8 * fq, 1.0f);
    }
};
template <bool HAS_ADD> struct EpiGate {
    static constexpr bool PERM = true, AFTER_DRAIN = false;
    const bf16_t* G; const bf16_t* ADD; bf16_t* O; float sc;
    __device__ __forceinline__ void operator()(const f32x4 (&acc)[2][2][4][2], const Unit& u, int wr, int wc, int fr, int fq) const {
        const int row0 = u.pm * BM + wr * 64 + fr, col0 = u.pn * BM + wc * 32 + 8 * fq;
#pragma unroll
        for (int ai = 0; ai < 2; ++ai)
#pragma unroll
            for (int mh = 0; mh < 2; ++mh) {
                u32x4 g[2][2], ad[2][2];
#pragma unroll
                for (int mm = 0; mm < 2; ++mm) { const size_t off = (size_t)(row0 + ai * HALF + (2 * mh + mm) * 16) * 4096 + col0;
#pragma unroll
                    for (int bj = 0; bj < 2; ++bj) { g[mm][bj] = *(const u32x4*)(G + off + bj * HALF); if (HAS_ADD) ad[mm][bj] = *(const u32x4*)(ADD + off + bj * HALF); } }
#pragma unroll
                for (int mm = 0; mm < 2; ++mm) { const int m = 2 * mh + mm; const size_t off = (size_t)(row0 + ai * HALF + m * 16) * 4096 + col0;
#pragma unroll
                    for (int bj = 0; bj < 2; ++bj) { const u32x4 gg = g[mm][bj];
                        f32x4 v0 = acc[ai][bj][m][0] * sc, v1 = acc[ai][bj][m][1] * sc;
                        v0[0] *= bf_lo(gg.x); v0[1] *= bf_hi(gg.x); v0[2] *= bf_lo(gg.y); v0[3] *= bf_hi(gg.y); v1[0] *= bf_lo(gg.z); v1[1] *= bf_hi(gg.z); v1[2] *= bf_lo(gg.w); v1[3] *= bf_hi(gg.w);
                        if (HAS_ADD) { const u32x4 a = ad[mm][bj];
                            v0[0] += bf_lo(a.x); v0[1] += bf_hi(a.x); v0[2] += bf_lo(a.y); v0[3] += bf_hi(a.y); v1[0] += bf_lo(a.z); v1[1] += bf_hi(a.z); v1[2] += bf_lo(a.w); v1[3] += bf_hi(a.w); }
                        u32x4 w; w.x = cvt_pk_bf16(v0[0], v0[1]); w.y = cvt_pk_bf16(v0[2], v0[3]); w.z = cvt_pk_bf16(v1[0], v1[1]); w.w = cvt_pk_bf16(v1[2], v1[3]);
                        *(u32x4*)(O + off + bj * HALF) = w; } }
                asm volatile("" ::: "memory"); }
    }
};
struct EpiRes1 {
    static constexpr bool PERM = true, AFTER_DRAIN = false;
    const float* x; const float* gvec; bf16_t* X1B; float* PART;
    __device__ __forceinline__ void operator()(const f32x4 (&acc)[2][2][4][2], const Unit& u, int wr, int wc, int fr, int fq) const {
        const int row0 = u.pm * BM + wr * 64 + fr, col0 = u.pn * BM + wc * 32 + 8 * fq;
        f32x4 gv[2][2];
#pragma unroll
        for (int bj = 0; bj < 2; ++bj)
#pragma unroll
            for (int n = 0; n < 2; ++n) gv[bj][n] = *(const f32x4*)(gvec + col0 + bj * HALF + n * 4);
#pragma unroll
        for (int ai = 0; ai < 2; ++ai)
#pragma unroll
            for (int mh = 0; mh < 2; ++mh) {
                f32x4 bs[2][2][2];
#pragma unroll
                for (int mm = 0; mm < 2; ++mm) { const size_t off = (size_t)(row0 + ai * HALF + (2 * mh + mm) * 16) * 4096 + col0;
#pragma unroll
                    for (int bj = 0; bj < 2; ++bj)
#pragma unroll
                        for (int n = 0; n < 2; ++n) bs[mm][bj][n] = *(const f32x4*)(x + off + bj * HALF + n * 4); }
#pragma unroll
                for (int mm = 0; mm < 2; ++mm) { const int m = 2 * mh + mm, row = row0 + ai * HALF + m * 16; const size_t off = (size_t)row * 4096 + col0; float ss = 0.f;
#pragma unroll
                    for (int bj = 0; bj < 2; ++bj) { const f32x4 v0 = bs[mm][bj][0] + gv[bj][0] * acc[ai][bj][m][0], v1 = bs[mm][bj][1] + gv[bj][1] * acc[ai][bj][m][1];
                        ss += (v0[0] * v0[0] + v0[1] * v0[1]) + (v0[2] * v0[2] + v0[3] * v0[3]) + (v1[0] * v1[0] + v1[1] * v1[1]) + (v1[2] * v1[2] + v1[3] * v1[3]);
                        u32x4 w; w.x = cvt_pk_bf16(v0[0], v0[1]); w.y = cvt_pk_bf16(v0[2], v0[3]); w.z = cvt_pk_bf16(v1[0], v1[1]); w.w = cvt_pk_bf16(v1[2], v1[3]);
                        *(u32x4*)(X1B + off + bj * HALF) = w; }
                    ss += __shfl_xor(ss, 16); ss += __shfl_xor(ss, 32);
                    if (fq == 0) PART[(size_t)row * 64 + u.pn * 4 + wc] = ss; }
                asm volatile("" ::: "memory"); }
    }
};
struct EpiRes2 {
    static constexpr bool PERM = true, AFTER_DRAIN = false;
    bf16_t* XB; const float* gvec;
    __device__ __forceinline__ void operator()(const f32x4 (&acc)[2][2][4][2], const Unit& u, int wr, int wc, int fr, int fq) const {
        const int row0 = u.pm * BM + wr * 64 + fr, col0 = u.pn * BM + wc * 32 + 8 * fq;
        f32x4 gv[2][2];
#pragma unroll
        for (int bj = 0; bj < 2; ++bj)
#pragma unroll
            for (int n = 0; n < 2; ++n) gv[bj][n] = *(const f32x4*)(gvec + col0 + bj * HALF + n * 4);
#pragma unroll
        for (int ai = 0; ai < 2; ++ai) {
            u32x4 bs[4][2];
#pragma unroll
            for (int m = 0; m < 4; ++m)
#pragma unroll
                for (int bj = 0; bj < 2; ++bj) bs[m][bj] = *(const u32x4*)(XB + (size_t)(row0 + ai * HALF + m * 16) * 4096 + col0 + bj * HALF);
#pragma unroll
            for (int m = 0; m < 4; ++m)
#pragma unroll
                for (int bj = 0; bj < 2; ++bj) { const u32x4 b = bs[m][bj];
                    f32x4 v0 = gv[bj][0] * acc[ai][bj][m][0], v1 = gv[bj][1] * acc[ai][bj][m][1];
                    v0[0] += bf_lo(b.x); v0[1] += bf_hi(b.x); v0[2] += bf_lo(b.y); v0[3] += bf_hi(b.y); v1[0] += bf_lo(b.z); v1[1] += bf_hi(b.z); v1[2] += bf_lo(b.w); v1[3] += bf_hi(b.w);
                    u32x4 w; w.x = cvt_pk_bf16(v0[0], v0[1]); w.y = cvt_pk_bf16(v0[2], v0[3]); w.z = cvt_pk_bf16(v1[0], v1[1]); w.w = cvt_pk_bf16(v1[2], v1[3]);
                    *(u32x4*)(XB + (size_t)(row0 + ai * HALF + m * 16) * 4096 + col0 + bj * HALF) = w; }
            asm volatile("" ::: "memory"); }
    }
};
__device__ __forceinline__ float dpp_ror1(float v) { return __int_as_float(__builtin_amdgcn_mov_dpp(__float_as_int(v), 0x121, 0xf, 0xf, true)); }
__device__ __forceinline__ float dpp_ror2(float v) { return __int_as_float(__builtin_amdgcn_mov_dpp(__float_as_int(v), 0x122, 0xf, 0xf, true)); }
struct EpiFfn {
    static constexpr bool PERM = true, AFTER_DRAIN = false, HAS_PREF = true;
    bf16_t* ACT; const float* cw; const float* cb; float* GT; float* GH; float* UH; PG8_LAS float* bnd; int dff; const float* rstd; const float* bias2;
    PG8_LAS float* stg;
    __device__ __forceinline__ void prefetch(const Unit& u, int par, int wid, int lane) const {
        if (wid < 4) { const int hi = lane >> 5, l4 = 4 * (lane & 31), c0 = u.pn * 128 + l4; const float* src;
            if (wid == 0) src = rstd + u.pm * BM + 4 * lane;
            else if (wid == 1) src = bias2 + hi * dff + c0;
            else if (wid == 2) src = cw + hi * dff + c0;
            else src = hi ? (cb + c0) : (cw + 2 * dff + c0);
            __builtin_amdgcn_global_load_lds((const unsigned*)src, (PG8_LAS unsigned*)(stg + par * 1024 + wid * 256), 16, 0, 0); }
    }
    __device__ __forceinline__ void operator()(const f32x4 (&acc)[2][2][4][2], const Unit& u, int wr, int wc, int fr, int fq, int par) const {
        const int cl = wc * 32 + 8 * fq, cact = u.pn * 128 + cl, row0 = u.pm * BM + wr * 64 + fr;
        const PG8_LAS float* sg = stg + par * 1024;
        float rs[2][4], bg[8], bu[8];
#pragma unroll
        for (int ai = 0; ai < 2; ++ai)
#pragma unroll
            for (int m = 0; m < 4; ++m) rs[ai][m] = sg[wr * 64 + fr + ai * HALF + m * 16];
        { const f32x4 a0 = *(const PG8_LAS f32x4*)(sg + 256 + cl), a1 = *(const PG8_LAS f32x4*)(sg + 256 + cl + 4), b0 = *(const PG8_LAS f32x4*)(sg + 384 + cl), b1 = *(const PG8_LAS f32x4*)(sg + 384 + cl + 4);
#pragma unroll
          for (int q = 0; q < 4; ++q) { bg[q] = a0[q]; bg[4 + q] = a1[q]; bu[q] = b0[q]; bu[4 + q] = b1[q]; } }
#define FFN_G(ai, m, q) (rs[ai][m] * acc[ai][0][m][(q) >> 2][(q) & 3] + bg[q])
#define FFN_U(ai, m, q) (rs[ai][m] * acc[ai][1][m][(q) >> 2][(q) & 3] + bu[q])
        if (fr >= 14) {
#pragma unroll
            for (int ai = 0; ai < 2; ++ai) { PG8_LAS float* d = bnd + ((ai * 2 + wr) * 2 + (fr - 14)) * 128 + cl;
                *(PG8_LAS f32x4*)d = (f32x4){FFN_G(ai, 3, 0), FFN_G(ai, 3, 1), FFN_G(ai, 3, 2), FFN_G(ai, 3, 3)}; *(PG8_LAS f32x4*)(d + 4) = (f32x4){FFN_G(ai, 3, 4), FFN_G(ai, 3, 5), FFN_G(ai, 3, 6), FFN_G(ai, 3, 7)}; }
            if (wr == 1) { float* d = GT + ((size_t)u.pm * 2 + (fr - 14)) * dff + cact;
                *(f32x4*)d = (f32x4){FFN_G(1, 3, 0), FFN_G(1, 3, 1), FFN_G(1, 3, 2), FFN_G(1, 3, 3)}; *(f32x4*)(d + 4) = (f32x4){FFN_G(1, 3, 4), FFN_G(1, 3, 5), FFN_G(1, 3, 6), FFN_G(1, 3, 7)}; }
        }
        if (fr < 2 && wr == 0) { float* d = GH + ((size_t)u.pm * 2 + fr) * dff + cact;
            *(f32x4*)d = (f32x4){FFN_G(0, 0, 0), FFN_G(0, 0, 1), FFN_G(0, 0, 2), FFN_G(0, 0, 3)}; *(f32x4*)(d + 4) = (f32x4){FFN_G(0, 0, 4), FFN_G(0, 0, 5), FFN_G(0, 0, 6), FFN_G(0, 0, 7)};
            float* e2 = UH + ((size_t)u.pm * 2 + fr) * dff + cact;
            *(f32x4*)e2 = (f32x4){FFN_U(0, 0, 0), FFN_U(0, 0, 1), FFN_U(0, 0, 2), FFN_U(0, 0, 3)}; *(f32x4*)(e2 + 4) = (f32x4){FFN_U(0, 0, 4), FFN_U(0, 0, 5), FFN_U(0, 0, 6), FFN_U(0, 0, 7)}; }
        float w0[8], w1[8], w2[8], bb[8];
        { const f32x4 a0 = *(const PG8_LAS f32x4*)(sg + 512 + cl), a1 = *(const PG8_LAS f32x4*)(sg + 512 + cl + 4), b0 = *(const PG8_LAS f32x4*)(sg + 640 + cl), b1 = *(const PG8_LAS f32x4*)(sg + 640 + cl + 4);
          const f32x4 c0 = *(const PG8_LAS f32x4*)(sg + 768 + cl), c1 = *(const PG8_LAS f32x4*)(sg + 768 + cl + 4), d0 = *(const PG8_LAS f32x4*)(sg + 896 + cl), d1 = *(const PG8_LAS f32x4*)(sg + 896 + cl + 4);
#pragma unroll
          for (int q = 0; q < 4; ++q) { w0[q] = a0[q]; w0[4 + q] = a1[q]; w1[q] = b0[q]; w1[4 + q] = b1[q]; w2[q] = c0[q]; w2[4 + q] = c1[q]; bb[q] = d0[q]; bb[4 + q] = d1[q]; } }
        asm volatile("s_waitcnt lgkmcnt(0)" ::: "memory"); __builtin_amdgcn_s_barrier(); asm volatile("" ::: "memory");
#pragma unroll
        for (int ai = 0; ai < 2; ++ai) {
            float prv[8];
            { const bool have = (wr == 1) || (ai == 1);
              const int src = (wr == 1) ? (ai * 2 + 0) : (0 * 2 + 1);
              const PG8_LAS float* sp = bnd + (src * 2 + ((fr >= 14) ? (fr - 14) : 0)) * 128 + cl;
              const f32x4 x0 = *(const PG8_LAS f32x4*)sp, x1 = *(const PG8_LAS f32x4*)(sp + 4);
#pragma unroll
              for (int q = 0; q < 4; ++q) { prv[q] = have ? x0[q] : 0.f; prv[4 + q] = have ? x1[q] : 0.f; } }
#pragma unroll
            for (int m = 0; m < 4; ++m) {
                const f32x2 rs2 = {rs[ai][m], rs[ai][m]};
                unsigned wo[4];
#pragma unroll
                for (int p = 0; p < 4; ++p) {
                    const f32x4 ag = acc[ai][0][m][p >> 1], au = acc[ai][1][m][p >> 1];
                    const f32x2 a2 = (p & 1) ? __builtin_shufflevector(ag, ag, 2, 3) : __builtin_shufflevector(ag, ag, 0, 1);
                    const f32x2 u2 = (p & 1) ? __builtin_shufflevector(au, au, 2, 3) : __builtin_shufflevector(au, au, 0, 1);
                    const f32x2 cur = rs2 * a2 + (f32x2){bg[2 * p], bg[2 * p + 1]};
                    const f32x2 up = rs2 * u2 + (f32x2){bu[2 * p], bu[2 * p + 1]};
                    f32x2 cv = (f32x2){w2[2 * p], w2[2 * p + 1]} * cur + (f32x2){bb[2 * p], bb[2 * p + 1]};
#pragma unroll
                    for (int e = 0; e < 2; ++e) { const int q = 2 * p + e; const float c = cur[e], pv = prv[q];
                        const float t1 = (fr == 15) ? pv : c, t2 = (fr >= 14) ? pv : c;
                        cv[e] = __builtin_fmaf(dpp_ror1(t1), w1[q], cv[e]); cv[e] = __builtin_fmaf(dpp_ror2(t2), w0[q], cv[e]); prv[q] = c; }
                    const f32x2 t = cv * cv, pp = t * (f32x2){-0.10294324f, -0.10294324f} + (f32x2){-2.3022082f, -2.3022082f}, uu = cv * pp;
                    const f32x2 d = (f32x2){__builtin_amdgcn_exp2f(uu.x), __builtin_amdgcn_exp2f(uu.y)} + (f32x2){1.f, 1.f};
                    const f32x2 y = cv * (f32x2){__builtin_amdgcn_rcpf(d.x), __builtin_amdgcn_rcpf(d.y)} * up;
                    wo[p] = cvt_pk_bf16(y.x, y.y); }
                u32x4 w; w.x = wo[0]; w.y = wo[1]; w.z = wo[2]; w.w = wo[3];
                *(u32x4*)(ACT + (size_t)(row0 + ai * HALF + m * 16) * dff + cact) = w;
                __builtin_amdgcn_sched_barrier(0); }
        }
#undef FFN_G
#undef FFN_U
    }
};

struct EpiNone {
    static constexpr bool PERM = true, AFTER_DRAIN = false;
    __device__ __forceinline__ void operator()(const f32x4 (&acc)[2][2][4][2], const Unit& u, int wr, int wc, int fr, int fq) const {
#pragma unroll
        for (int ai = 0; ai < 2; ++ai)
#pragma unroll
            for (int bj = 0; bj < 2; ++bj)
#pragma unroll
                for (int m = 0; m < 4; ++m)
#pragma unroll
                    for (int n = 0; n < 2; ++n) asm volatile("" :: "v"(acc[ai][bj][m][n]));
    }
};

template <class T, class = void> struct epi_has_pref { static constexpr bool value = false; };
template <class T> struct epi_has_pref<T, decltype((void)T::HAS_PREF)> { static constexpr bool value = true; };
typedef int pg8_i32x4 __attribute__((ext_vector_type(4)));
typedef int pg8_i32x8 __attribute__((ext_vector_type(8)));
template <class Epi, class Sched, bool ALIGN_EPI = false, bool SP2 = false, bool F8 = false>
__device__ __forceinline__ void gemm_phase(PG8_LAS unsigned char* lds, const Gemm g, const Sched& S, const Epi& E) {
    const int tid = ftid(), wid = __builtin_amdgcn_readfirstlane(tid >> 6), lane = tid & 63, wr = wid >> 2, wc = wid & 3, fr = lane & 15, fq = lane >> 4;
    const int sc8 = __builtin_amdgcn_readfirstlane(0x7F7F7F7F);
    constexpr int ES = F8 ? 1 : 2, KSTR = F8 ? 16 : 1024;
    const int K = g.K, nt = K * ES / (BK * 2), LD = g.ld;
    unsigned voffA[2], voffB[2];
#pragma unroll
    for (int i = 0; i < 2; ++i) { int R, C; stage_rc(tid * 16 + i * 8192, R, C); const int Rb = Epi::PERM ? ((R & ~31) + perm32(R & 31)) : R;
        voffA[i] = (unsigned)(R * LD) * (unsigned)ES + (unsigned)C * 2u; voffB[i] = (unsigned)(Rb * LD) * (unsigned)ES + (unsigned)C * 2u; }
    const size_t kstep = (size_t)(BK * 2);
    const size_t hstep = (size_t)HALF * LD * ES;
    const size_t tstep = 2 * hstep;
    const unsigned ldsw = (unsigned)wid * 1024u;
    const int aoff = lds_byte(wr * 64 + fr, fq * (F8 ? 16 : 8)), boff = lds_byte(wc * 32 + fr, fq * (F8 ? 16 : 8));
#define PG8_SA(b, h) (((b) * 2 + (h)) * HTB)
#define PG8_SB(b, h) ((4 + (b) * 2 + (h)) * HTB)
#define PG8_STAGE(bufoff, gbase, voff) do { _Pragma("unroll") for (int _i = 0; _i < 2; ++_i) \
        __builtin_amdgcn_global_load_lds((const unsigned*)((const char*)(gbase) + (voff)[_i]), (PG8_LAS unsigned*)(lds + (bufoff) + ldsw + _i * 8192), 16, 0, 0); } while (0)
#define PG8_LDA(dst, b, h) do { _Pragma("unroll") for (int m = 0; m < 4; ++m) _Pragma("unroll") for (int k = 0; k < 2; ++k) dst[m][k] = *(const PG8_LAS bf16x8*)(lds + PG8_SA(b, h) + aoff + m * 2048 + k * KSTR); } while (0)
#define PG8_LDB(dst, b, h) do { _Pragma("unroll") for (int n = 0; n < 2; ++n) _Pragma("unroll") for (int k = 0; k < 2; ++k) dst[n][k] = *(const PG8_LAS bf16x8*)(lds + PG8_SB(b, h) + boff + n * 2048 + k * KSTR); } while (0)
#define PG8_CAT8(x0, x1) __builtin_shufflevector(__builtin_bit_cast(pg8_i32x4, x0), __builtin_bit_cast(pg8_i32x4, x1), 0, 1, 2, 3, 4, 5, 6, 7)
#define PG8_MMA(ai, bj, At, Bt) do { __builtin_amdgcn_s_setprio(1); \
        if constexpr (F8) { _Pragma("unroll") for (int m = 0; m < 4; ++m) _Pragma("unroll") for (int n = 0; n < 2; ++n) \
            asm volatile("v_mfma_scale_f32_16x16x128_f8f6f4 %0, %1, %2, %0, %3, %3 op_sel_hi:[0,0,0]" : "+v"(acc[ai][bj][m][n]) : "v"(PG8_CAT8(Bt[n][0], Bt[n][1])), "v"(PG8_CAT8(At[m][0], At[m][1])), "v"(sc8)); } \
        else { _Pragma("unroll") for (int m = 0; m < 4; ++m) _Pragma("unroll") for (int n = 0; n < 2; ++n) _Pragma("unroll") for (int k = 0; k < 2; ++k) \
            acc[ai][bj][m][n] = __builtin_amdgcn_mfma_f32_16x16x32_bf16(Bt[n][k], At[m][k], acc[ai][bj][m][n], 0, 0, 0); } \
        __builtin_amdgcn_s_setprio(0); } while (0)
#define PG8_WAIT_V(n) asm volatile("s_waitcnt vmcnt(" #n ")" ::: "memory")
#define PG8_WAIT_L(n) asm volatile("s_waitcnt lgkmcnt(" #n ")" ::: "memory")
#define PG8_BAR __builtin_amdgcn_s_barrier()
#define PG8_SCHED __builtin_amdgcn_sched_barrier(0)
    Unit cur, nxt; int ui = 0;
    if (!S.next(0, cur)) return;
    f32x4 acc[2][2][4][2];
#pragma unroll
    for (int a = 0; a < 2; ++a)
#pragma unroll
        for (int b = 0; b < 2; ++b)
#pragma unroll
            for (int m = 0; m < 4; ++m)
#pragma unroll
                for (int n = 0; n < 2; ++n) acc[a][b][m][n] = (f32x4){0.f, 0.f, 0.f, 0.f};
    bf16x8 At[4][2], B0[2][2], B1[2][2];
    const char* cA = (const char*)g.A + (size_t)cur.pm * tstep; const char* cB = (const char*)g.Bt + (size_t)cur.pn * tstep;
    S.a_ready(cur);
    if constexpr (epi_has_pref<Epi>::value) E.prefetch(cur, 0, wid, lane);
    if constexpr (SP2) {
        PG8_STAGE(PG8_SB(0, 0), cB, voffB); PG8_STAGE(PG8_SB(0, 1), cB + hstep, voffB); PG8_STAGE(PG8_SA(0, 0), cA, voffA); PG8_STAGE(PG8_SA(0, 1), cA + hstep, voffA);
        if (wr == 1) PG8_BAR;
        PG8_WAIT_V(2); PG8_BAR;
        PG8_STAGE(PG8_SB(1, 0), cB + kstep, voffB); PG8_STAGE(PG8_SA(1, 0), cA + kstep, voffA); PG8_STAGE(PG8_SB(1, 1), cB + hstep + kstep, voffB);
        PG8_WAIT_V(6); PG8_BAR;
    } else {
        PG8_STAGE(PG8_SB(0, 0), cB, voffB); PG8_STAGE(PG8_SA(0, 0), cA, voffA); PG8_STAGE(PG8_SB(0, 1), cB + hstep, voffB); PG8_STAGE(PG8_SA(0, 1), cA + hstep, voffA);
        if (wr == 1) PG8_BAR;
        PG8_WAIT_V(4); PG8_BAR;
        PG8_STAGE(PG8_SB(1, 0), cB + kstep, voffB); PG8_STAGE(PG8_SA(1, 0), cA + kstep, voffA); PG8_STAGE(PG8_SB(1, 1), cB + hstep + kstep, voffB);
        PG8_WAIT_V(6); PG8_BAR;
    }
    for (;;) {
        const bool has_next = S.next(ui + 1, nxt);
        const char* nA = has_next ? (const char*)g.A + (size_t)nxt.pm * tstep : cA; const char* nB = has_next ? (const char*)g.Bt + (size_t)nxt.pn * tstep : cB;
        for (int t = 0; t < nt; t += 2) {
            const bool last = (t == nt - 2);
            const char* a1 = cA + (size_t)(t + 1) * kstep;
            const char* a2 = last ? nA : cA + (size_t)(t + 2) * kstep; const char* b2 = last ? nB : cB + (size_t)(t + 2) * kstep;
            const char* a3 = a2 + kstep; const char* b3 = b2 + kstep;
            if (last && has_next) S.a_ready(nxt);
            if constexpr (SP2) {
            PG8_LDB(B0, 0, 0); PG8_LDB(B1, 0, 1); PG8_SCHED; PG8_LDA(At, 0, 0); PG8_STAGE(PG8_SA(1, 1), a1 + hstep, voffA);
            PG8_WAIT_V(8); PG8_WAIT_L(0); PG8_BAR; PG8_MMA(0, 0, At, B0); PG8_MMA(0, 1, At, B1); PG8_BAR; PG8_SCHED;
            PG8_LDA(At, 0, 1); PG8_STAGE(PG8_SB(0, 0), b2, voffB); PG8_STAGE(PG8_SB(0, 1), b2 + hstep, voffB); PG8_STAGE(PG8_SA(0, 0), a2, voffA);
            PG8_WAIT_V(8); PG8_WAIT_L(0); PG8_BAR; PG8_MMA(1, 0, At, B0); PG8_MMA(1, 1, At, B1); PG8_BAR; PG8_SCHED;
            PG8_LDB(B0, 1, 0); PG8_LDB(B1, 1, 1); PG8_SCHED; PG8_LDA(At, 1, 0); PG8_STAGE(PG8_SA(0, 1), a2 + hstep, voffA);
            PG8_WAIT_V(8); PG8_WAIT_L(0); PG8_BAR; PG8_MMA(0, 0, At, B0); PG8_MMA(0, 1, At, B1); PG8_BAR; PG8_SCHED;
            PG8_LDA(At, 1, 1); PG8_STAGE(PG8_SB(1, 0), b3, voffB); PG8_STAGE(PG8_SB(1, 1), b3 + hstep, voffB); PG8_STAGE(PG8_SA(1, 0), a3, voffA);
            PG8_WAIT_V(8); PG8_WAIT_L(0); PG8_BAR; PG8_MMA(1, 0, At, B0); PG8_MMA(1, 1, At, B1); PG8_BAR; PG8_SCHED;
            } else {
            PG8_LDB(B0, 0, 0); PG8_SCHED; PG8_LDA(At, 0, 0); PG8_STAGE(PG8_SA(1, 1), a1 + hstep, voffA);
            PG8_WAIT_L(8); PG8_BAR; PG8_WAIT_L(0); PG8_MMA(0, 0, At, B0); PG8_BAR; PG8_SCHED;
            PG8_LDB(B1, 0, 1); PG8_STAGE(PG8_SB(0, 0), b2, voffB);
            PG8_BAR; PG8_WAIT_L(0); PG8_MMA(0, 1, At, B1); PG8_BAR;
            PG8_LDA(At, 0, 1); PG8_STAGE(PG8_SA(0, 0), a2, voffA);
            PG8_BAR; PG8_WAIT_L(0); PG8_MMA(1, 0, At, B0); PG8_BAR; PG8_SCHED;
            PG8_STAGE(PG8_SB(0, 1), b2 + hstep, voffB);
            PG8_WAIT_V(6); PG8_BAR; PG8_MMA(1, 1, At, B1); PG8_BAR;
            PG8_LDB(B0, 1, 0); PG8_SCHED; PG8_LDA(At, 1, 0); PG8_STAGE(PG8_SA(0, 1), a2 + hstep, voffA);
            PG8_WAIT_L(8); PG8_BAR; PG8_WAIT_L(0); PG8_MMA(0, 0, At, B0); PG8_BAR; PG8_SCHED;
            PG8_LDB(B1, 1, 1); PG8_STAGE(PG8_SB(1, 0), b3, voffB);
            PG8_BAR; PG8_WAIT_L(0); PG8_MMA(0, 1, At, B1); PG8_BAR;
            PG8_LDA(At, 1, 1); PG8_STAGE(PG8_SA(1, 0), a3, voffA);
            PG8_BAR; PG8_WAIT_L(0); PG8_MMA(1, 0, At, B0); PG8_BAR; PG8_SCHED;
            PG8_STAGE(PG8_SB(1, 1), b3 + hstep, voffB);
            PG8_WAIT_V(6); PG8_BAR; PG8_MMA(1, 1, At, B1); PG8_BAR;
            }
        }
        if constexpr (ALIGN_EPI) { if (wr == 0) PG8_BAR; }
        if constexpr (F8) {
#define PG8_PIN8(ai, bj) "+v"(acc[ai][bj][0][0]), "+v"(acc[ai][bj][0][1]), "+v"(acc[ai][bj][1][0]), "+v"(acc[ai][bj][1][1]), "+v"(acc[ai][bj][2][0]), "+v"(acc[ai][bj][2][1]), "+v"(acc[ai][bj][3][0]), "+v"(acc[ai][bj][3][1])
            asm volatile("s_nop 15\n\ts_nop 15" : PG8_PIN8(0, 0)); asm volatile("" : PG8_PIN8(0, 1)); asm volatile("" : PG8_PIN8(1, 0)); asm volatile("" : PG8_PIN8(1, 1));
#undef PG8_PIN8
        }
        if constexpr (epi_has_pref<Epi>::value) { E(acc, cur, wr, wc, fr, fq, ui & 1); S.done(cur); if (has_next) E.prefetch(nxt, (ui + 1) & 1, wid, lane); }
        else if constexpr (F8) { const int t2 = ftid(); E(acc, cur, wr, wc, t2 & 15, (t2 >> 4) & 3); S.done(cur); }
        else if constexpr (!Epi::AFTER_DRAIN) { E(acc, cur, wr, wc, fr, fq); S.done(cur); }
        if (!has_next) break;
#pragma unroll
        for (int a = 0; a < 2; ++a)
#pragma unroll
            for (int b = 0; b < 2; ++b)
#pragma unroll
                for (int m = 0; m < 4; ++m)
#pragma unroll
                    for (int n = 0; n < 2; ++n) acc[a][b][m][n] = (f32x4){0.f, 0.f, 0.f, 0.f};
        cur = nxt; cA = nA; cB = nB; ++ui;
        if constexpr (F8) { const int t3 = ftid();
#pragma unroll
            for (int i = 0; i < 2; ++i) { int R, C; stage_rc(t3 * 16 + i * 8192, R, C); const int Rb = Epi::PERM ? ((R & ~31) + perm32(R & 31)) : R;
                voffA[i] = (unsigned)(R * LD) * (unsigned)ES + (unsigned)C * 2u; voffB[i] = (unsigned)(Rb * LD) * (unsigned)ES + (unsigned)C * 2u; } }
        if constexpr (ALIGN_EPI) { if (wr == 1) PG8_BAR; }
    }
    PG8_WAIT_V(0);
    if constexpr (!ALIGN_EPI) { if (wr == 0) PG8_BAR; }
    PG8_BAR;
    if constexpr (Epi::AFTER_DRAIN) { E.fused(acc, cur, wr, wc, fr, fq, lds, wid, lane); S.done(cur); }
#undef PG8_SA
#undef PG8_SB
#undef PG8_STAGE
#undef PG8_LDA
#undef PG8_LDB
#undef PG8_MMA
#undef PG8_CAT8
#undef PG8_WAIT_V
#undef PG8_WAIT_L
#undef PG8_BAR
#undef PG8_SCHED
}
}
namespace att {
typedef unsigned short bf16_t;
using bf16x8 = __attribute__((ext_vector_type(8))) short;
using s16x4 = __attribute__((ext_vector_type(4))) short;
using f32x16 = __attribute__((ext_vector_type(16))) float;
using u32x4 = __attribute__((ext_vector_type(4))) unsigned;
typedef __attribute__((address_space(3))) char* lds_ptr;
typedef __attribute__((address_space(3))) const char* lds_cptr;
constexpr int PITCH = 2048, KVBLK = 64, QB = 256, SEQ = 16384;
constexpr int KSLOT = 8192, VSLOT = 16384, NSLOT = 3;
constexpr int LDS_K = 0, LDS_V = NSLOT * KSLOT, LDS_WS = LDS_V + NSLOT * VSLOT, LDS_OST = LDS_WS + 8 * 256, LDS_STOP = LDS_OST + 8 * 8192, LDS_END = LDS_STOP + 64;
constexpr float THR = 8.0f;
#define ATT_SBAR() __builtin_amdgcn_sched_barrier(0)
#define ATT_WAIT_BAR(N) asm volatile("s_waitcnt vmcnt(" #N ") lgkmcnt(0)\n\ts_barrier" ::: "memory")
__device__ __forceinline__ void glds16(const void* gsrc, unsigned lds_dst) { unsigned keep;
    asm volatile("s_mov_b32 %0, m0\n\ts_mov_b32 m0, %2\n\ts_nop 0\n\tglobal_load_lds_dwordx4 %1, off\n\ts_mov_b32 m0, %0" : "=&s"(keep) : "v"(gsrc), "s"(lds_dst) : "memory"); }
__device__ __forceinline__ unsigned cvtpk(float lo, float hi) { unsigned r; asm("v_cvt_pk_bf16_f32 %0, %1, %2" : "=v"(r) : "v"(lo), "v"(hi)); return r; }
__device__ __forceinline__ float add1(float a, float b) { float r; asm("v_add_f32 %0, %1, %2" : "=v"(r) : "v"(a), "v"(b)); return r; }
__device__ __forceinline__ int crow(int r, int hi) { return (r & 3) + 8 * (r >> 2) + 4 * hi; }

__device__ __forceinline__ void attn_unit(int h, int c, int qb, const bf16_t* Q, const bf16_t* __restrict__ K, const bf16_t* __restrict__ V, bf16_t* O, lds_ptr shm, float sl2, int t_start, float kn) {
    const int tid = ftid(), lane = tid & 63, r32 = lane & 31, hi = lane >> 5; const int wid = __builtin_amdgcn_readfirstlane(tid >> 6);
    const int q0 = qb * QB;
    const bf16_t* Qw = Q + (size_t)(q0 + wid * 32) * PITCH + h * 128 + c * 64;
    const unsigned lds0 = (unsigned)(uintptr_t)shm;
    __attribute__((address_space(3))) float* wsf = (__attribute__((address_space(3))) float*)(shm + LDS_WS) + wid * 64;
    const bf16_t* ksrc = K + (size_t)(h * 2 + c) * 256 * 4096 + wid * 512 + lane * 8;
    const bf16_t* vsrc0 = V + (size_t)h * 256 * 8192 + wid * 512 + lane * 8;
    const bf16_t* vsrc1 = vsrc0 + 8 * 512;
    const unsigned kdst = lds0 + LDS_K + wid * 1024, vdst0 = lds0 + LDS_V + wid * 1024, vdst1 = vdst0 + 8192;
#define ATT_DMA(t, sl) do { \
        glds16(ksrc + (size_t)(t) * 4096, (unsigned)__builtin_amdgcn_readfirstlane(kdst + (sl) * KSLOT)); \
        glds16(vsrc0 + (size_t)(t) * 8192, (unsigned)__builtin_amdgcn_readfirstlane(vdst0 + (sl) * VSLOT)); \
        glds16(vsrc1 + (size_t)(t) * 8192, (unsigned)__builtin_amdgcn_readfirstlane(vdst1 + (sl) * VSLOT)); } while (0)
    const int vb0 = (int)(lds0 + LDS_V) + ((lane >> 4) & 1) * 32 + (lane & 3) * 8 + (4 * hi + ((lane & 15) >> 2)) * 64;
    const lds_cptr kp0 = (lds_cptr)shm + LDS_K + hi * 1024 + r32 * 16;
    const int NT = (q0 + QB) / KVBLK, n = NT - t_start;
    bf16x8 qr[4];
#pragma unroll
    for (int d0 = 0; d0 < 4; ++d0) qr[d0] = *reinterpret_cast<const bf16x8*>(Qw + (size_t)r32 * PITCH + d0 * 16 + hi * 8);
    asm volatile("s_waitcnt vmcnt(0)" ::: "memory");
#pragma unroll
    for (int d0 = 0; d0 < 4; ++d0) asm volatile("" : "+v"(qr[d0]));
#define ATT_SEQ(i) (((i) < 4) ? (NT - 4 + (i)) : (NT - 1 - (i)))
    float brow;
    { float qn2 = 0.f;
#pragma unroll
      for (int d0 = 0; d0 < 4; ++d0)
#pragma unroll
          for (int e = 0; e < 8; ++e) { const float v = __uint_as_float(((unsigned)(unsigned short)qr[d0][e]) << 16); qn2 += v * v; }
      auto rr = __builtin_amdgcn_permlane32_swap(__float_as_uint(qn2), __float_as_uint(qn2), false, false);
      qn2 = __uint_as_float(rr[0]) + __uint_as_float(rr[1]);
      brow = sqrtf(qn2) * kn * 1.001f + 0.01f; }
    __attribute__((address_space(3))) float* stopv = (__attribute__((address_space(3))) float*)(shm + LDS_STOP);
    ATT_DMA(ATT_SEQ(0), 0); ATT_DMA(ATT_SEQ(1), 1);
    f32x16 kbv;
#pragma unroll
    for (int r = 0; r < 16; ++r) kbv[r] = sl2 * (float)((r & 3) + 8 * (r >> 2));
    const float sl32 = 32.0f * sl2;
    const int qpos = q0 + wid * 32 + r32;
    float mref = 0.f, l_reg = 0.f; f32x16 o[4];
#pragma unroll
    for (int d = 0; d < 4; ++d) o[d] = f32x16{};
    int slot = 0;
    for (int i = 0; i < n; ++i) {
        const int t = ATT_SEQ(i);
        if (i + 1 < n) { ATT_WAIT_BAR(3); } else { ATT_WAIT_BAR(0); }
        if (i >= 4) { const int pb = ((i - 1) & 1) * 8;
            float mv = stopv[pb];
#pragma unroll
            for (int w = 1; w < 8; ++w) mv = __builtin_fmaxf(mv, stopv[pb + w]);
            if (mv < -44.0f) break; }
        if (i + 2 < n) { const int s2 = (slot == 0) ? 2 : slot - 1; ATT_DMA(ATT_SEQ(i + 2), s2); }
        const int d0i = 64 * t + 4 * hi - qpos;
        const float base0 = sl2 * (float)d0i - mref, base1 = base0 + sl32;
        f32x16 p0, p1;
#pragma unroll
        for (int r = 0; r < 16; ++r) { p0[r] = add1(kbv[r], base0); p1[r] = add1(kbv[r], base1); }
        { const lds_cptr kb = kp0 + slot * KSLOT;
#pragma unroll
          for (int d0 = 0; d0 < 4; ++d0) {
              const bf16x8 b0 = *reinterpret_cast<const __attribute__((address_space(3))) bf16x8*>(kb + d0 * 2048);
              const bf16x8 b1 = *reinterpret_cast<const __attribute__((address_space(3))) bf16x8*>(kb + d0 * 2048 + 512);
              p0 = __builtin_amdgcn_mfma_f32_32x32x16_bf16(b0, qr[d0], p0, 0, 0, 0);
              p1 = __builtin_amdgcn_mfma_f32_32x32x16_bf16(b1, qr[d0], p1, 0, 0, 0); } }
        if (t >= NT - 4) {
#pragma unroll
            for (int r = 0; r < 16; ++r) { const int kv = d0i + (r & 3) + 8 * (r >> 2); if (kv > 0) p0[r] = -__builtin_inff(); if (kv + 32 > 0) p1[r] = -__builtin_inff(); }
        }
        float rm;
        { float a = __builtin_fmaxf(__builtin_fmaxf(p0[0], p0[1]), p1[0]), b = __builtin_fmaxf(__builtin_fmaxf(p0[2], p0[3]), p1[1]); a = __builtin_fmaxf(__builtin_fmaxf(a, p1[2]), p1[3]);
#pragma unroll
          for (int r = 4; r < 16; r += 4) { a = __builtin_fmaxf(__builtin_fmaxf(a, p0[r]), p0[r + 1]); b = __builtin_fmaxf(__builtin_fmaxf(b, p0[r + 2]), p0[r + 3]);
                                            a = __builtin_fmaxf(__builtin_fmaxf(a, p1[r]), p1[r + 1]); b = __builtin_fmaxf(__builtin_fmaxf(b, p1[r + 2]), p1[r + 3]); }
          rm = __builtin_fmaxf(a, b);
          auto rr = __builtin_amdgcn_permlane32_swap(__float_as_uint(rm), __float_as_uint(rm), false, false);
          rm = __builtin_fmaxf(__uint_as_float(rr[0]), __uint_as_float(rr[1])); }
        const bool first = (i == 0);
        if (first || __any(rm > THR)) {
            const float dl = first ? rm : __builtin_fmaxf(rm, 0.f);
            mref += dl;
#pragma unroll
            for (int r = 0; r < 16; ++r) { p0[r] -= dl; p1[r] -= dl; }
            if (!first) {
                const float f = __builtin_amdgcn_exp2f(-dl);
                l_reg *= f;
                if (hi == 0) wsf[r32] = f;
                float fr_[16];
#pragma unroll
                for (int r = 0; r < 16; ++r) fr_[r] = wsf[crow(r, hi)];
#pragma unroll
                for (int d = 0; d < 4; ++d)
#pragma unroll
                    for (int r = 0; r < 16; ++r) o[d][r] *= fr_[r];
            }
        }
        float sacc = 0.f;
#pragma unroll
        for (int r = 0; r < 16; ++r) { p0[r] = __builtin_amdgcn_exp2f(p0[r]); p1[r] = __builtin_amdgcn_exp2f(p1[r]); }
#pragma unroll
        for (int r = 0; r < 16; ++r) sacc += p0[r] + p1[r];
        l_reg += sacc;
        u32x4 pw0, pw1, pw2, pw3;
        pw0 = (u32x4){cvtpk(p0[0], p0[1]), cvtpk(p0[2], p0[3]), cvtpk(p0[4], p0[5]), cvtpk(p0[6], p0[7])};
        pw1 = (u32x4){cvtpk(p0[8], p0[9]), cvtpk(p0[10], p0[11]), cvtpk(p0[12], p0[13]), cvtpk(p0[14], p0[15])};
        pw2 = (u32x4){cvtpk(p1[0], p1[1]), cvtpk(p1[2], p1[3]), cvtpk(p1[4], p1[5]), cvtpk(p1[6], p1[7])};
        pw3 = (u32x4){cvtpk(p1[8], p1[9]), cvtpk(p1[10], p1[11]), cvtpk(p1[12], p1[13]), cvtpk(p1[14], p1[15])};
        { const int vb = vb0 + slot * VSLOT;
          const bf16x8 pa0 = __builtin_bit_cast(bf16x8, pw0), pa1 = __builtin_bit_cast(bf16x8, pw1), pa2 = __builtin_bit_cast(bf16x8, pw2), pa3 = __builtin_bit_cast(bf16x8, pw3);
#pragma unroll
          for (int d0 = 0; d0 < 4; ++d0) { s16x4 lo[4], hh[4];
#pragma unroll
              for (int ks = 0; ks < 4; ++ks) {
                  asm volatile("ds_read_b64_tr_b16 %0,%1 offset:%c2" : "=&v"(lo[ks]) : "v"(vb), "i"(d0 * 4096 + ks * 1024) : "memory");
                  asm volatile("ds_read_b64_tr_b16 %0,%1 offset:%c2" : "=&v"(hh[ks]) : "v"(vb), "i"(d0 * 4096 + ks * 1024 + 512) : "memory"); }
              asm volatile("s_waitcnt lgkmcnt(0)" ::: "memory"); ATT_SBAR();
#define ATT_PK(k) (bf16x8){lo[k][0], lo[k][1], lo[k][2], lo[k][3], hh[k][0], hh[k][1], hh[k][2], hh[k][3]}
              o[d0] = __builtin_amdgcn_mfma_f32_32x32x16_bf16(pa0, ATT_PK(0), o[d0], 0, 0, 0);
              o[d0] = __builtin_amdgcn_mfma_f32_32x32x16_bf16(pa1, ATT_PK(1), o[d0], 0, 0, 0);
              o[d0] = __builtin_amdgcn_mfma_f32_32x32x16_bf16(pa2, ATT_PK(2), o[d0], 0, 0, 0);
              o[d0] = __builtin_amdgcn_mfma_f32_32x32x16_bf16(pa3, ATT_PK(3), o[d0], 0, 0, 0);
#undef ATT_PK
          } }
        if (i >= 3 && i + 1 < n) {
            float v = brow + sl2 * (float)(64 * ATT_SEQ(i + 1) + 63 - qpos) - mref;
            v = __builtin_fmaxf(v, __shfl_xor(v, 1)); v = __builtin_fmaxf(v, __shfl_xor(v, 2)); v = __builtin_fmaxf(v, __shfl_xor(v, 4)); v = __builtin_fmaxf(v, __shfl_xor(v, 8)); v = __builtin_fmaxf(v, __shfl_xor(v, 16));
            if (lane == 0) stopv[(i & 1) * 8 + wid] = v; }
        slot = (slot == 2) ? 0 : slot + 1;
    }
#undef ATT_SEQ
    { auto rr = __builtin_amdgcn_permlane32_swap(__float_as_uint(l_reg), __float_as_uint(l_reg), false, false); l_reg = __uint_as_float(rr[0]) + __uint_as_float(rr[1]); }
    if (hi == 0) wsf[32 + r32] = l_reg;
    float rli[16];
#pragma unroll
    for (int r = 0; r < 16; ++r) rli[r] = 1.0f / wsf[32 + crow(r, hi)];
    { __attribute__((address_space(3))) bf16_t* stg = (__attribute__((address_space(3))) bf16_t*)(shm + LDS_OST) + wid * 4096;
#pragma unroll
      for (int r = 0; r < 16; ++r) { const int orow = crow(r, hi);
#pragma unroll
          for (int d0 = 0; d0 < 4; ++d0) { const float v = o[d0][r] * rli[r]; stg[orow * 128 + d0 * 32 + r32] = (bf16_t)(cvtpk(v, v) & 0xffffu); } }
      asm volatile("s_waitcnt lgkmcnt(0)" ::: "memory");
      bf16_t* Ow = O + (size_t)(q0 + wid * 32) * PITCH + h * 128;
#pragma unroll
      for (int it = 0; it < 8; ++it) { const int row = it * 4 + (lane >> 4), ch = lane & 15;
          const u32x4 v = *(const __attribute__((address_space(3))) u32x4*)(stg + row * 128 + ch * 8);
          *(u32x4*)(Ow + (size_t)row * PITCH + ch * 8) = v; } }
    asm volatile("s_waitcnt vmcnt(0) lgkmcnt(0)\n\ts_barrier" ::: "memory");
#undef ATT_DMA
}
#undef ATT_SBAR
#undef ATT_WAIT_BAR
}

constexpr int NWAVES = 8;
constexpr int N_LAUNCHES = MK_N_LAUNCHES;
constexpr int N_PHASES = 13;
constexpr int SEQ = 16384, DM = 4096, DIN = 18432, DRNN = 2048, DFF = 11008, NUP = 2 * DFF  ;
constexpr float EPS = 1e-6f;
constexpr float QSCALE = 0.125f * 1.4426950408889634f;
constexpr float LOG2E = 1.4426950408889634f;
constexpr size_t MiB = 1u << 20;
constexpr size_t WS_CTL = 0, CTL_ZERO_BYTES = 64 * 1024;
constexpr size_t WS_MOD = 1 * MiB;
constexpr size_t WS_RGW = 2 * MiB;
constexpr size_t WS_CA = 4 * MiB, WS_CB = 6 * MiB, WS_HC = 8 * MiB;
constexpr size_t WS_PART = 10 * MiB;
constexpr size_t WS_RSTD = 14 * MiB, WS_BIAS2 = 14 * MiB + 512 * 1024;
constexpr size_t WS_WIN = 16 * MiB;
constexpr size_t WS_WPA = 160 * MiB, WS_WPR = 176 * MiB;
constexpr size_t WS_WOUT = 192 * MiB;
constexpr size_t WS_WUP = 224 * MiB;
constexpr size_t WS_WDN = 396 * MiB;
constexpr size_t WS_H = 482 * MiB;
constexpr size_t WS_Q = 610 * MiB, WS_K = 674 * MiB, WS_V = 738 * MiB;
constexpr size_t WS_RX = 802 * MiB, WS_RG = 866 * MiB;
constexpr size_t WS_GA = 930 * MiB, WS_GB = 1058 * MiB;
constexpr size_t WS_O1 = 1186 * MiB, WS_O2 = 1250 * MiB;
constexpr size_t WS_H8 = 1186 * MiB, WS_W8 = 1250 * MiB;
constexpr int NPROJ8 = 10240;
constexpr float W8SCALE = 128.0f, WPA8SCALE = 64.0f;
constexpr size_t WS_MIX = 1314 * MiB;
constexpr size_t WS_GT = 1314 * MiB, WS_GH = 1320 * MiB, WS_UH = 1326 * MiB;
constexpr size_t WS_ACT = 610 * MiB;
constexpr size_t WS_BPART = 1442 * MiB;
constexpr size_t WS_END = 1448 * MiB;
static_assert(WS_UH + (size_t)64 * 2 * DFF * 4 <= WS_BPART && WS_BPART + (size_t)64 * NUP * 4 <= WS_END && WS_ACT + (size_t)SEQ * DFF * 2 <= WS_GT, "d_ws map");
constexpr int CW_BAR = 4096;
constexpr int CW_ATTQ = 8192;
constexpr int CW_QKMAX = 8320;
constexpr int RING_OFF = 0, BND_OFF = 131072;
constexpr int LDSCTL_OFF = 143360, MISC_OFF = LDSCTL_OFF + 320;
constexpr int LDS_BYTES = 147456;
static_assert(att::LDS_END <= LDSCTL_OFF && MISC_OFF + 128 <= LDS_BYTES, "LDS map");
#define GAS __attribute__((address_space(1)))
#define LAS __attribute__((address_space(3)))
typedef unsigned short bf16;
typedef unsigned v4u __attribute__((ext_vector_type(4)));
typedef float f32x4 __attribute__((ext_vector_type(4)));
typedef short bf16x8 __attribute__((ext_vector_type(8)));
typedef GAS unsigned gu32;
typedef GAS unsigned long long gu64;
#define RLX_AGENT __ATOMIC_RELAXED, __HIP_MEMORY_SCOPE_AGENT
#define LDS_WAIT() asm volatile("s_waitcnt lgkmcnt(0)" ::: "memory")
#define VM_WAIT() asm volatile("s_waitcnt vmcnt(0)" ::: "memory")
__device__ __forceinline__ unsigned long long rt() { return __builtin_amdgcn_s_memrealtime(); }
__device__ __forceinline__ unsigned f2bf(float f) { unsigned u = __builtin_bit_cast(unsigned, f); return (u + 0x7fffu + ((u >> 16) & 1u)) >> 16; }
__device__ __forceinline__ unsigned pk2(float lo, float hi) { return f2bf(lo) | (f2bf(hi) << 16); }

#define XB_TMO      128
#define XB_XCNT(j)  (256  + 64 * (j))
#define XB_XSUB(j)  (1280 + 64 * (j))
#define XB_XGEN(j)  (2304 + 64 * (j))
#define XB_TOP      3328
#define XB_TOPGEN   3392
#define XCD_BAR_WORDS 3456
#define XB_SPIN_CAP (1u << 18)

__device__ __forceinline__ unsigned xb_ld(unsigned* p)              { return __hip_atomic_load(p, __ATOMIC_RELAXED, __HIP_MEMORY_SCOPE_AGENT); }
__device__ __forceinline__ unsigned xb_add(unsigned* p, unsigned v) { return __hip_atomic_fetch_add(p, v, __ATOMIC_RELAXED, __HIP_MEMORY_SCOPE_AGENT); }
__device__ __forceinline__ unsigned xb_xcc_id() { return (unsigned)__builtin_amdgcn_s_getreg((3 << 11) | 20) & 0xFu; }
#define XB_SPIN(cond, bar) do { unsigned _sp = 0; while (cond) { __builtin_amdgcn_s_sleep(1); \
    if ((++_sp & 255u) == 0u) { if (xb_ld(&(bar)[XB_TMO])) break; if (_sp > XB_SPIN_CAP) { atomicAdd(&(bar)[XB_TMO], 1u); break; } } } } while (0)

struct XcdBarrier {
    unsigned* bar; unsigned x;
    volatile LAS unsigned* st;
};

__device__ __forceinline__ XcdBarrier xcd_barrier_post(unsigned* bar, volatile LAS unsigned* st) {
    XcdBarrier b; b.bar = bar; b.x = xb_xcc_id(); b.st = st;
    if (threadIdx.x == 0) (void)xb_add(&bar[XB_XCNT(b.x)], 1u);
    return b;
}
__device__ __forceinline__ void xcd_barrier_complete(unsigned* bar, unsigned x, unsigned& nloc, unsigned& nx) {
    const unsigned G = gridDim.x * gridDim.y * gridDim.z;
    unsigned sum, cnt, mine, sp = 0u;
    for (;;) {
        sum = 0u; cnt = 0u; mine = 0u;
#pragma unroll
        for (unsigned j = 0; j < 16; ++j) { const unsigned c = xb_ld(&bar[XB_XCNT(j)]); sum += c; cnt += (c > 0u) ? 1u : 0u; mine = (j == x) ? c : mine; }
        if (sum == G) break;
        __builtin_amdgcn_s_sleep(1);
        if ((++sp & 255u) == 0u) { if (xb_ld(&bar[XB_TMO])) break; if (sp > XB_SPIN_CAP) { atomicAdd(&bar[XB_TMO], 1u); break; } }
    }
    nloc = mine > 0u ? mine : 1u; nx = cnt > 0u ? cnt : 1u;
}

__device__ __forceinline__ void xcd_barrier(const XcdBarrier& b) {
    asm volatile("s_waitcnt vmcnt(0)" ::: "memory");
    __syncthreads();
    if (threadIdx.x == 0) {
        unsigned* bar = b.bar;
        __builtin_amdgcn_s_waitcnt(0);
        unsigned nloc = b.st[0], nx = b.st[1];
        if (nloc == 0u) { xcd_barrier_complete(bar, b.x, nloc, nx); b.st[0] = nloc; b.st[1] = nx; }
        const unsigned old = xb_add(&bar[XB_XSUB(b.x)], 1u);
        const unsigned gen = old / nloc;
        if (old + 1u == (gen + 1u) * nloc) {
            __builtin_amdgcn_fence(__ATOMIC_RELEASE, "agent");
            asm volatile("s_waitcnt vmcnt(0)" ::: "memory");
            const unsigned og = xb_add(&bar[XB_TOP], 1u);
            const unsigned tg = og / nx;
            if (og + 1u == (tg + 1u) * nx) xb_add(&bar[XB_TOPGEN], 1u);
            else XB_SPIN(xb_ld(&bar[XB_TOPGEN]) == tg, bar);
            __builtin_amdgcn_fence(__ATOMIC_ACQUIRE, "agent");
            xb_add(&bar[XB_XGEN(b.x)], 1u);
            asm volatile("s_waitcnt vmcnt(0)" ::: "memory");
        } else {
            XB_SPIN(xb_ld(&bar[XB_XGEN(b.x)]) == gen, bar);
            __builtin_amdgcn_fence(__ATOMIC_ACQUIRE, "agent");
            asm volatile("s_waitcnt vmcnt(0)" ::: "memory");
        }
    }
    __syncthreads();
}
struct Frame {
    LAS unsigned char* lds;
    volatile LAS unsigned* MISC;
    gu32* ctl;
    int tid, lane, wave;
    int vcu, G;
};
__device__ __forceinline__ float wave_sum(float v) {
#pragma unroll
    for (int o = 1; o < 64; o <<= 1) v += __shfl_xor(v, o);
    return v;
}
__device__ __forceinline__ unsigned pkbf(float lo, float hi) { unsigned r; asm("v_cvt_pk_bf16_f32 %0, %1, %2" : "=v"(r) : "v"(lo), "v"(hi)); return r; }
__device__ __forceinline__ float bflo(unsigned w) { return __uint_as_float(w << 16); }
__device__ __forceinline__ float bfhi(unsigned w) { return __uint_as_float(w & 0xffff0000u); }
__device__ __forceinline__ float sigmoidf_(float v) { return __builtin_amdgcn_rcpf(1.0f + __builtin_amdgcn_exp2f(-LOG2E * v)); }
__device__ __forceinline__ float gelu_tanhf_(float v) { const float u = v * (0.7978845608028654f + 0.035677408136300125f * v * v);
    return v * __builtin_amdgcn_rcpf(1.0f + __builtin_amdgcn_exp2f(-2.8853900817779268f * u)); }

__device__ __forceinline__ void transpose_item(const float* W, int K, int N, bf16* WT, int k0, int n0, int rowbase, LAS float* scr, int lane) {
#pragma unroll 8
    for (int i = 0; i < 32; ++i) { const int kk = 2 * i + (lane >> 5); scr[kk * 33 + (lane & 31)] = __builtin_nontemporal_load(&W[(size_t)(k0 + kk) * N + n0 + (lane & 31)]);     }
    LDS_WAIT(); asm volatile("" ::: "memory");
    const int c = lane & 7;
#pragma unroll
    for (int j = 0; j < 4; ++j) { const int n = (lane >> 3) + 8 * j; const LAS float* s = scr + (8 * c) * 33 + n;
        v4u o; o.x = pkbf(s[0 * 33], s[1 * 33]); o.y = pkbf(s[2 * 33], s[3 * 33]); o.z = pkbf(s[4 * 33], s[5 * 33]); o.w = pkbf(s[6 * 33], s[7 * 33]);
        *(GAS v4u*)(WT + (size_t)(rowbase + n) * K + k0 + 8 * c) = o; }
    LDS_WAIT(); asm volatile("" ::: "memory");
}
__device__ __forceinline__ unsigned pk4_fp8(float a, float b, float c, float d);
__device__ __forceinline__ void transpose_item_fp8(const float* W, int K, int N, unsigned char* W8, int k0, int n0, int rowbase, LAS float* scr, int lane, float sc) {
#pragma unroll 8
    for (int i = 0; i < 32; ++i) { const int kk = 2 * i + (lane >> 5); scr[kk * 33 + (lane & 31)] = __builtin_nontemporal_load(&W[(size_t)(k0 + kk) * N + n0 + (lane & 31)]) * sc; }
    LDS_WAIT(); asm volatile("" ::: "memory");
    const int c = lane & 7;
#pragma unroll
    for (int j = 0; j < 4; ++j) { const int n = (lane >> 3) + 8 * j; const LAS float* s = scr + (8 * c) * 33 + n;
        const unsigned long long o = (unsigned long long)pk4_fp8(s[0 * 33], s[1 * 33], s[2 * 33], s[3 * 33]) | ((unsigned long long)pk4_fp8(s[4 * 33], s[5 * 33], s[6 * 33], s[7 * 33]) << 32);
        *(GAS unsigned long long*)(W8 + (size_t)(rowbase + n) * K + k0 + 8 * c) = o; }
    LDS_WAIT(); asm volatile("" ::: "memory");
}
__device__ __forceinline__ void transpose_matrix_item(const float* W, int K, int N, bf16* WT, int item, int mode, LAS float* scr, int lane) {
    const int nblk = N / 32, kb = item / nblk, nb = item % nblk, n0 = 32 * nb;
    int rowbase = n0;
    if (mode == 1) { rowbase = (n0 < DFF) ? (n0 / 128) * 256 + (n0 % 128) : ((n0 - DFF) / 128) * 256 + 128 + ((n0 - DFF) % 128); }
    transpose_item(W, K, N, WT, 64 * kb, n0, rowbase, scr, lane);
}

__device__ __forceinline__ void transpose_up_item(const float* W, bf16* WT, int item, const LAS float* a2, const LAS float* sh2, float* BPART, LAS float* scr, int lane) {
    constexpr int K = DM, N = NUP; constexpr int nblk = N / 32; const int kb = item / nblk, nb = item % nblk, n0 = 32 * nb, k0 = 64 * kb;
    const int rowbase = (n0 < DFF) ? (n0 / 128) * 256 + (n0 % 128) : ((n0 - DFF) / 128) * 256 + 128 + ((n0 - DFF) % 128);
    float bsum = 0.f;
#pragma unroll 8
    for (int i = 0; i < 32; ++i) { const int kk = 2 * i + (lane >> 5); const float w = __builtin_nontemporal_load(&W[(size_t)(k0 + kk) * N + n0 + (lane & 31)]); bsum += sh2[k0 + kk] * w; scr[kk * 33 + (lane & 31)] = w * a2[k0 + kk]; }
    bsum += __shfl_xor(bsum, 32);
    if (lane < 32) BPART[(size_t)kb * N + n0 + lane] = bsum;
    LDS_WAIT(); asm volatile("" ::: "memory");
    const int c = lane & 7;
#pragma unroll
    for (int j = 0; j < 4; ++j) { const int n = (lane >> 3) + 8 * j; const LAS float* s = scr + (8 * c) * 33 + n;
        v4u o; o.x = pkbf(s[0 * 33], s[1 * 33]); o.y = pkbf(s[2 * 33], s[3 * 33]); o.z = pkbf(s[4 * 33], s[5 * 33]); o.w = pkbf(s[6 * 33], s[7 * 33]);
        *(GAS v4u*)(WT + (size_t)(rowbase + n) * K + k0 + 8 * c) = o; }
    LDS_WAIT(); asm volatile("" ::: "memory");
}

__device__ __forceinline__ void conv64_plain(const float* W, int K, int N, bf16* WT, int item, LAS float* scr, int lane) {
    const int nblk = N / 64, kb = item / nblk, nb = item % nblk, n0 = 64 * nb, k0 = 64 * kb;
    const int lr = lane >> 4, lc = (lane & 15) * 4;
    f32x4 v[16];
#pragma unroll
    for (int i = 0; i < 16; ++i) v[i] = __builtin_nontemporal_load((const GAS f32x4*)(W + (size_t)(k0 + 4 * i + lr) * N + n0 + lc));
#pragma unroll
    for (int i = 0; i < 16; ++i) { LAS float* p = scr + (4 * i + lr) * 65 + lc; p[0] = v[i].x; p[1] = v[i].y; p[2] = v[i].z; p[3] = v[i].w; }
    LDS_WAIT(); asm volatile("" ::: "memory");
    const int c = lane & 7;
#pragma unroll
    for (int j = 0; j < 8; ++j) { const int n = (lane >> 3) + 8 * j; const LAS float* s = scr + (8 * c) * 65 + n;
        v4u o; o.x = pkbf(s[0 * 65], s[1 * 65]); o.y = pkbf(s[2 * 65], s[3 * 65]); o.z = pkbf(s[4 * 65], s[5 * 65]); o.w = pkbf(s[6 * 65], s[7 * 65]);
        *(GAS v4u*)(WT + (size_t)(n0 + n) * K + k0 + 8 * c) = o; }
    LDS_WAIT(); asm volatile("" ::: "memory");
}

__device__ __forceinline__ unsigned pk4_fp8(float a, float b, float c, float d) { int w = __builtin_amdgcn_cvt_pk_fp8_f32(a, b, 0, false); w = __builtin_amdgcn_cvt_pk_fp8_f32(c, d, w, true); return (unsigned)w; }
__device__ __forceinline__ void norm_row_to_bf16(const float* xrow, bf16* orow, const LAS float* avec, const LAS float* bvec, int lane, unsigned* o4row = nullptr) {
    asm volatile("" ::: "memory");
    const GAS f32x4* xr = (const GAS f32x4*)xrow + lane;
    f32x4 v[16]; float s = 0.f;
#pragma unroll
    for (int j = 0; j < 16; ++j) { v[j] = __builtin_nontemporal_load(&xr[64 * j]); s += (v[j].x * v[j].x + v[j].y * v[j].y) + (v[j].z * v[j].z + v[j].w * v[j].w); }
    const float rstd = 1.0f / sqrtf(wave_sum(s) * (1.f / DM) + EPS);
    GAS unsigned long long* o8 = (GAS unsigned long long*)orow + lane;
#pragma unroll
    for (int j = 0; j < 16; ++j) { const f32x4 a = *(const LAS f32x4*)(avec + 256 * j + 4 * lane), b = *(const LAS f32x4*)(bvec + 256 * j + 4 * lane);
        const f32x4 y = v[j] * rstd * a + b;
        o8[64 * j] = (unsigned long long)pkbf(y.x, y.y) | ((unsigned long long)pkbf(y.z, y.w) << 32);
        if (o4row) ((GAS unsigned*)o4row)[64 * j + lane] = pk4_fp8(y.x, y.y, y.z, y.w);
        if ((j & 3) == 3) __builtin_amdgcn_sched_barrier(0); }
}
namespace rgl {
constexpr int T = 64;
constexpr int L_XRF = 0, L_AF = 32768, L_BF = 65536, L_XRB = 98304, L_SA = 115712, L_SB = 117760, L_END = 119808;
typedef short bf16x8 __attribute__((ext_vector_type(8)));
struct Ptrs { const bf16* RX; const bf16* RGg; const float* conv_w; const float* conv_b; const bf16* Wt; const float* b_a; const float* b_x; const float* lam; float* CA; float* CB; const float* HC; bf16* YREC; };
struct RxBuf { v4u x[2][4]; };
__device__ __forceinline__ void load_rx(const Ptrs& P, int n, int ch, int tid, RxBuf& B) {
#pragma unroll
    for (int jj = 0; jj < 2; ++jj) { const int it = tid + 512 * jj, r = it >> 4, g = it & 15, t = ch * T + r, col = n * 128 + 8 * g;
#pragma unroll
        for (int j = 0; j < 4; ++j) { const int ts = t - 3 + j; B.x[jj][j] = (ts >= 0) ? *(const GAS v4u*)(P.RX + (size_t)ts * DRNN + col) : (v4u){0u, 0u, 0u, 0u}; } }
}
template <int PASS> __device__ __forceinline__ void unit(const Ptrs& P, int n, int ch, LAS unsigned char* lds, int tid, const bf16x8 (&bw)[2][4], float bias_a, float bias_x, float sp,
                                                         RxBuf& RXB_, const f32x4 (&cwv)[4][2], const f32x4 (&cbv)[2], int un) {
    asm volatile("" : "+v"(tid));
    const int lane = tid & 63, wid = tid >> 6, cbase = n * 128, t0 = ch * T;
    LAS float* XRF = (LAS float*)(lds + L_XRF); LAS float* AF = (LAS float*)(lds + L_AF); LAS float* BF = (LAS float*)(lds + L_BF);
    LAS float* SA = (LAS float*)(lds + L_SA); LAS float* SB = (LAS float*)(lds + L_SB);
#pragma unroll
    for (int jj = 0; jj < 2; ++jj) { const int it = tid + 512 * jj, r = it >> 4, g = it & 15;
        float xr[8];
        xr[0] = cbv[0].x; xr[1] = cbv[0].y; xr[2] = cbv[0].z; xr[3] = cbv[0].w; xr[4] = cbv[1].x; xr[5] = cbv[1].y; xr[6] = cbv[1].z; xr[7] = cbv[1].w;
#pragma unroll
        for (int j = 0; j < 4; ++j) { const v4u x = RXB_.x[jj][j]; const f32x4 w0 = cwv[j][0], w1 = cwv[j][1];
            xr[0] += w0.x * bflo(x.x); xr[1] += w0.y * bfhi(x.x); xr[2] += w0.z * bflo(x.y); xr[3] += w0.w * bfhi(x.y);
            xr[4] += w1.x * bflo(x.z); xr[5] += w1.y * bfhi(x.z); xr[6] += w1.z * bflo(x.w); xr[7] += w1.w * bfhi(x.w); }
        *(LAS f32x4*)(XRF + r * 128 + 8 * g) = (f32x4){xr[0], xr[1], xr[2], xr[3]}; *(LAS f32x4*)(XRF + r * 128 + 8 * g + 4) = (f32x4){xr[4], xr[5], xr[6], xr[7]};
        v4u pk; pk.x = pkbf(xr[0], xr[1]); pk.y = pkbf(xr[2], xr[3]); pk.z = pkbf(xr[4], xr[5]); pk.w = pkbf(xr[6], xr[7]);
        *(LAS v4u*)(lds + L_XRB + r * 272 + 16 * g) = pk; }
    if (un >= 0) load_rx(P, un & 15, un >> 4, tid, RXB_);
    __syncthreads();
    { const int fi = lane & 15, kq = lane >> 4;
#pragma unroll
      for (int rt = 0; rt < 4; ++rt) { f32x4 da = (f32x4){0.f, 0.f, 0.f, 0.f}, dx = da;
#pragma unroll
          for (int s = 0; s < 4; ++s) { const bf16x8 af = *(const LAS bf16x8*)(lds + L_XRB + (16 * rt + fi) * 272 + (32 * s + 8 * kq) * 2);
              da = __builtin_amdgcn_mfma_f32_16x16x32_bf16(af, bw[0][s], da, 0, 0, 0);
              dx = __builtin_amdgcn_mfma_f32_16x16x32_bf16(af, bw[1][s], dx, 0, 0, 0); }
          const int e = 16 * wid + fi;
#pragma unroll
          for (int q = 0; q < 4; ++q) { const int t = 16 * rt + 4 * kq + q;
              const float r = sigmoidf_(da[q] + bias_a), ig = sigmoidf_(dx[q] + bias_x);
              const float z = -16.0f * r * sp;
              const float a = __builtin_amdgcn_exp2f(z * (0.5f * LOG2E));
              const float om = (z > -0.03f) ? -z * (1.0f + z * (0.5f + z * (0.16666667f + z * 0.041666668f))) : 1.0f - a * a;
              const float bxv = __builtin_amdgcn_sqrtf(om) * ig * XRF[t * 128 + e];
              AF[t * 128 + e] = a; BF[t * 128 + e] = bxv; }
          __builtin_amdgcn_sched_barrier(0); } }
    __syncthreads();
    const int e = tid & 127, sub = tid >> 7;
    { float A = 1.f, B = 0.f;
#pragma unroll
      for (int q = 0; q < 16; ++q) { const int t = 16 * sub + q; const float a = AF[t * 128 + e], b = BF[t * 128 + e]; B = a * B + b; A = A * a; }
      SA[sub * 128 + e] = A; SB[sub * 128 + e] = B; }
    __syncthreads();
    if (PASS == 1) {
        if (tid < 128) { float A = 1.f, B = 0.f;
#pragma unroll
            for (int s = 0; s < 4; ++s) { const float a = SA[s * 128 + e], b = SB[s * 128 + e]; B = a * B + b; A = A * a; }
            P.CA[(size_t)ch * DRNN + cbase + e] = A; P.CB[(size_t)ch * DRNN + cbase + e] = B; }
    } else {
        float hst = P.HC[(size_t)ch * DRNN + cbase + e];
        for (int s = 0; s < sub; ++s) hst = SA[s * 128 + e] * hst + SB[s * 128 + e];
#pragma unroll
        for (int q = 0; q < 16; ++q) { const int t = 16 * sub + q; hst = AF[t * 128 + e] * hst + BF[t * 128 + e]; AF[t * 128 + e] = hst; }
        __syncthreads();
#pragma unroll
        for (int jj = 0; jj < 2; ++jj) { const int it = tid + 512 * jj, r = it >> 4, g = it & 15, t = t0 + r, col = cbase + 8 * g;
            const v4u gg = *(const GAS v4u*)(P.RGg + (size_t)t * DRNN + col);
            const f32x4 h0 = *(const LAS f32x4*)(AF + r * 128 + 8 * g), h1 = *(const LAS f32x4*)(AF + r * 128 + 8 * g + 4);
            v4u pk; pk.x = pkbf(h0.x * bflo(gg.x), h0.y * bfhi(gg.x)); pk.y = pkbf(h0.z * bflo(gg.y), h0.w * bfhi(gg.y));
            pk.z = pkbf(h1.x * bflo(gg.z), h1.y * bfhi(gg.z)); pk.w = pkbf(h1.z * bflo(gg.w), h1.w * bfhi(gg.w));
            *(GAS v4u*)(P.YREC + (size_t)t * DRNN + col) = pk; }
    }
    __syncthreads();
}
template <int PASS> __device__ __forceinline__ void phase(const Ptrs& P, LAS unsigned char* lds, int tid, int G) {
    const int lane = tid & 63, wid = tid >> 6, fi = lane & 15, kq = lane >> 4;
    int ncur = -1; bf16x8 bw[2][4]; float bias_a = 0.f, bias_x = 0.f, sp = 0.f; f32x4 cwv[4][2], cbv[2];
#pragma unroll
    for (int g = 0; g < 2; ++g)
#pragma unroll
        for (int s = 0; s < 4; ++s) bw[g][s] = (bf16x8){0, 0, 0, 0, 0, 0, 0, 0};
#pragma unroll
    for (int j = 0; j < 4; ++j) { cwv[j][0] = (f32x4){0.f, 0.f, 0.f, 0.f}; cwv[j][1] = cwv[j][0]; }
    cbv[0] = (f32x4){0.f, 0.f, 0.f, 0.f}; cbv[1] = cbv[0];
    const int NU = 16 * (SEQ / T);
    RxBuf cur;
    if ((int)blockIdx.x < NU) load_rx(P, blockIdx.x & 15, blockIdx.x >> 4, tid, cur);
#pragma unroll 1
    for (int u = blockIdx.x; u < NU; u += G) {
        const int n = u & 15, ch = u >> 4;
        if (n != ncur) { ncur = n; const int e = 16 * wid + fi;
#pragma unroll
            for (int g = 0; g < 2; ++g)
#pragma unroll
                for (int s = 0; s < 4; ++s) bw[g][s] = *(const GAS bf16x8*)(P.Wt + ((size_t)(g * 16 + n) * 128 + e) * 128 + 32 * s + 8 * kq);
            bias_a = P.b_a[n * 128 + e]; bias_x = P.b_x[n * 128 + e]; sp = log1pf(__expf(-P.lam[n * 128 + e]));
            const int col = n * 128 + 8 * (tid & 15);
#pragma unroll
            for (int j = 0; j < 4; ++j) { cwv[j][0] = *(const GAS f32x4*)(P.conv_w + j * DRNN + col); cwv[j][1] = *(const GAS f32x4*)(P.conv_w + j * DRNN + col + 4); }
            cbv[0] = *(const GAS f32x4*)(P.conv_b + col); cbv[1] = *(const GAS f32x4*)(P.conv_b + col + 4); }
        unit<PASS>(P, n, ch, lds, tid, bw, bias_a, bias_x, sp, cur, cwv, cbv, (u + G < NU) ? u + G : -1);
    }
}
}

#ifndef PROBE_DUP
#define PROBE_DUP 0
#endif
#define PROBE_REP(k) ((((PROBE_DUP) >> (k)) & 1) + 1)
struct Args { const float* in[27]; float* out; unsigned char* ws; int ph_lo, ph_hi; };
__global__ void __launch_bounds__(NWAVES * 64, 2) mk_fwd(Args args) {
    extern __shared__ __attribute__((aligned(16))) unsigned char lds[];
    Frame F;
    F.lds = (LAS unsigned char*)lds;
    F.MISC = (volatile LAS unsigned*)(F.lds + MISC_OFF);
    F.tid = ftid(); F.lane = F.tid & 63; F.wave = __builtin_amdgcn_readfirstlane(F.tid >> 6);
    F.G = gridDim.x; { const int bx = blockIdx.x; F.vcu = (F.G % 8 == 0) ? (bx % 8) * (F.G / 8) + bx / 8 : bx; }
    unsigned char* ws = args.ws;
    F.ctl = (gu32*)(ws + WS_CTL);
    for (int u = F.tid; u < (LDS_BYTES - LDSCTL_OFF) / 4; u += NWAVES * 64) ((LAS unsigned*)(F.lds + LDSCTL_OFF))[u] = 0u;
    __syncthreads();
    XcdBarrier bar; bar.bar = (unsigned*)(F.ctl + CW_BAR); bar.x = 0; bar.st = nullptr;
    if (N_LAUNCHES == 1) bar = xcd_barrier_post((unsigned*)(F.ctl + CW_BAR), F.MISC + 8);
#define GRID_BAR() do { if (N_LAUNCHES == 1) xcd_barrier(bar); } while (0)
    const int lo = args.ph_lo, hi = args.ph_hi;
#define IN(k) (lo <= (k) && (k) < hi)
#define BOTH(k) (IN(k) && IN((k) + 1))
    const float* x = args.in[0]; const float* cvec = args.in[1]; const float* w_ada = args.in[2]; const float* b_ada = args.in[3]; const float* norm1_w = args.in[4];
    const float* w_in = args.in[5]; const float* lq1 = args.in[6]; const float* lk1 = args.in[7]; const float* lq2 = args.in[8]; const float* lk2 = args.in[9];
    const float* subln_w = args.in[10]; const float* conv_w = args.in[11]; const float* conv_b = args.in[12]; const float* w_rg_a = args.in[13]; const float* b_rg_a = args.in[14];
    const float* w_rg_x = args.in[15]; const float* b_rg_x = args.in[16]; const float* lru_lambda = args.in[17]; const float* w_pa = args.in[18]; const float* w_pr = args.in[19];
    const float* w_out = args.in[20]; const float* norm2_w = args.in[21]; const float* w_up = args.in[22]; const float* fconv_w = args.in[23]; const float* fconv_b = args.in[24];
    const float* w_dn = args.in[25]; const float* normf_w = args.in[26];
    float* out = args.out;
    float* MOD = (float*)(ws + WS_MOD);
    bf16* RGW = (bf16*)(ws + WS_RGW); float* CA = (float*)(ws + WS_CA); float* CB = (float*)(ws + WS_CB); float* HC = (float*)(ws + WS_HC);
    bf16* WIN = (bf16*)(ws + WS_WIN); bf16* WPA = (bf16*)(ws + WS_WPA); bf16* WPR = (bf16*)(ws + WS_WPR); bf16* WOUT = (bf16*)(ws + WS_WOUT); bf16* WUP = (bf16*)(ws + WS_WUP); bf16* WDN = (bf16*)(ws + WS_WDN);
    bf16* HB = (bf16*)(ws + WS_H); bf16* QB_ = (bf16*)(ws + WS_Q); bf16* KB = (bf16*)(ws + WS_K); bf16* VB = (bf16*)(ws + WS_V); bf16* RXB = (bf16*)(ws + WS_RX); bf16* RGB = (bf16*)(ws + WS_RG);
    bf16* GAB = (bf16*)(ws + WS_GA); bf16* GBB = (bf16*)(ws + WS_GB); bf16* O1 = (bf16*)(ws + WS_O1); bf16* O2 = (bf16*)(ws + WS_O2); bf16* MIX = (bf16*)(ws + WS_MIX);
    bf16* ACT = (bf16*)(ws + WS_ACT); float* GT = (float*)(ws + WS_GT); float* GH = (float*)(ws + WS_GH); float* UH = (float*)(ws + WS_UH);
    bf16* YATT = QB_; bf16* YREC = KB; bf16* M1 = HB; bf16* X1B = HB;
    unsigned char* H8 = ws + WS_H8; unsigned char* W8 = ws + WS_W8;
    float* PART = (float*)(ws + WS_PART); float* RSTD = (float*)(ws + WS_RSTD); float* BIAS2 = (float*)(ws + WS_BIAS2); float* BPART = (float*)(ws + WS_BPART);
    const int gw = F.vcu * NWAVES + F.wave, NGW = F.G * NWAVES;

#ifndef NO_P0
    if (IN(0)) { F.tid = ftid(); F.lane = F.tid & 63;
      for (int rep = 0; rep < PROBE_REP(0); ++rep) {
        { LAS float* sc_l = (LAS float*)(F.lds);
          LAS float* red = (LAS float*)(F.lds + 16384);
          for (int i = F.tid; i < DM; i += NWAVES * 64) { const float cv = cvec[i]; sc_l[i] = cv * sigmoidf_(cv); }
          __syncthreads();
          for (int cb = blockIdx.x; cb < (6 * DM) / 96; cb += F.G) {
              const int rgp = F.tid >> 5, cl = F.tid & 31;
              f32x4 a = (f32x4){0.f, 0.f, 0.f, 0.f};
              if (cl < 24) { const float* wp = w_ada + (size_t)rgp * (6 * DM) + 96 * cb + 4 * cl;
#pragma unroll 8
                  for (int k = 0; k < DM / 16; ++k) { const f32x4 w = __builtin_nontemporal_load((const GAS f32x4*)(wp + (size_t)k * 16 * (6 * DM))); a += w * sc_l[rgp + 16 * k]; }
                  *(LAS f32x4*)(red + rgp * 96 + 4 * cl) = a; }
              __syncthreads();
              if (F.tid < 96) { float s = 0.f;
#pragma unroll
                  for (int g = 0; g < 16; ++g) s += red[g * 96 + F.tid];
                  MOD[96 * cb + F.tid] = s + b_ada[96 * cb + F.tid]; }
              __syncthreads(); } }
        { LAS float* scr = (LAS float*)(F.lds + RING_OFF + F.wave * 16384);
          constexpr int I_IN = (DM / 64) * (DIN / 32), I_PA = (2048 / 64) * (DM / 32), I_OUT = (DM / 64) * (DM / 32), I_DN = (DFF / 64) * (DM / 32), I_RG = 16 * 2 * 4;
          constexpr int NITEMS = I_IN + 2 * I_PA + I_OUT + 2 * I_RG;
          for (int it = gw; it < NITEMS; it += NGW) {
              int r = it;
              if (r < I_IN) { const int nb = r % (DIN / 32), kb = r / (DIN / 32);
                  const int n0 = 32 * nb, r8 = (n0 < 6144) ? n0 : ((n0 >= 10240 && n0 < 14336) ? n0 - 10240 + 6144 : -1);
                  if (r8 >= 0) transpose_item_fp8(w_in, DM, DIN, W8, 64 * kb, n0, r8, scr, F.lane, W8SCALE);
                  else transpose_matrix_item(w_in, DM, DIN, WIN, r, 0, scr, F.lane);
                  continue; } r -= I_IN;
              if (r < I_PA) { transpose_matrix_item(w_pa, 2048, DM, WPA, r, 0, scr, F.lane); continue; } r -= I_PA;
              if (r < I_PA) { transpose_matrix_item(w_pr, 2048, DM, WPR, r, 0, scr, F.lane); continue; } r -= I_PA;
              if (r < I_OUT) { transpose_matrix_item(w_out, DM, DM, WOUT, r, 0, scr, F.lane); continue; } r -= I_OUT;
              if (r < I_RG) { const int nb = r >> 3; transpose_matrix_item(w_rg_a + (size_t)nb * 16384, 128, 128, RGW + (size_t)nb * 16384, r & 7, 0, scr, F.lane); continue; } r -= I_RG;
              { const int nb = r >> 3; transpose_matrix_item(w_rg_x + (size_t)nb * 16384, 128, 128, RGW + (size_t)(16 + nb) * 16384, r & 7, 0, scr, F.lane); }
          } }
        if (PROBE_REP(0) > 1) __syncthreads();
      }
        if (BOTH(0)) GRID_BAR();
    }
#endif
#ifndef NO_P1
    if (IN(1)) { F.tid = ftid(); F.lane = F.tid & 63;
        LAS float* av = (LAS float*)(F.lds); LAS float* bv = (LAS float*)(F.lds + 16384); LAS float* a2 = (LAS float*)(F.lds + 32768); LAS float* s2 = (LAS float*)(F.lds + 49152);
        for (int i = F.tid; i < DM; i += NWAVES * 64) { av[i] = norm1_w[i] * (1.0f + MOD[DM + i]); bv[i] = MOD[i]; a2[i] = norm2_w[i] * (1.0f + MOD[4 * DM + i]); s2[i] = MOD[3 * DM + i]; }
        __syncthreads();
        for (int rep = 0; rep < PROBE_REP(1); ++rep) {
#pragma unroll 1
        for (int m = gw; m < SEQ; m += NGW) norm_row_to_bf16(x + (size_t)m * DM, HB + (size_t)m * DM, av, bv, F.lane, (unsigned*)(H8 + (size_t)m * DM));
        { LAS float* scr = (LAS float*)(F.lds + 65536 + F.wave * 8448);
          constexpr int I_UP = (DM / 64) * (NUP / 32);
#pragma unroll 1
          for (int it = gw; it < I_UP; it += NGW) transpose_up_item(w_up, WUP, it, a2, s2, BPART, scr, F.lane); }
        }
        if (BOTH(1)) GRID_BAR();
    }
#endif
#ifndef NO_P2
    if (IN(2)) { F.tid = ftid(); F.lane = F.tid & 63;
        { pg8::Gemm g{HB, WIN, SEQ, DIN - NPROJ8, DM, DM}; pg8::ProjOrder16 S; S.init(SEQ, DIN - NPROJ8, F.G, (int)blockIdx.x);
          pg8::EpiProj E{QB_, KB, VB, RXB, RGB, GAB, GBB, QSCALE, 1.0f};
          pg8::gemm_phase<pg8::EpiProj, pg8::ProjOrder16, true, true>(F.lds + RING_OFF, g, S, E); }
        VM_WAIT(); __syncthreads();
        { pg8::Gemm g{(const pg8::bf16_t*)H8, (const pg8::bf16_t*)W8, SEQ, NPROJ8, DM, DM}; pg8::StaticOrder S; S.init(SEQ, NPROJ8, F.G, (int)blockIdx.x);
          pg8::EpiProjF8 E2{pg8::EpiProj{QB_, KB, VB, RXB, RGB, GAB, GBB, QSCALE, 1.0f / W8SCALE}};
          pg8::gemm_phase<pg8::EpiProjF8, pg8::StaticOrder, true, true, true>(F.lds + RING_OFF, g, S, E2); }
        if (BOTH(2)) GRID_BAR();
    }
#endif
    const rgl::Ptrs RP{RXB, RGB, conv_w, conv_b, RGW, b_rg_a, b_rg_x, lru_lambda, CA, CB, HC, YREC};
#ifndef NO_P3
    if (IN(3)) { F.tid = ftid(); F.lane = F.tid & 63;
        for (int rep = 0; rep < PROBE_REP(3); ++rep) {
        rgl::phase<1>(RP, F.lds, F.tid, F.G);
        { float qm[4] = {0.f, 0.f, 0.f, 0.f};
#pragma unroll 1
          for (int m = gw; m < SEQ; m += NGW) {
#pragma unroll
              for (int j = 0; j < 4; ++j) { const size_t off = (size_t)m * 2048 + 512 * j + 8 * F.lane;
                  const v4u a = *(const GAS v4u*)(QB_ + off);
                  float sa = (bflo(a.x) * bflo(a.x) + bfhi(a.x) * bfhi(a.x)) + (bflo(a.y) * bflo(a.y) + bfhi(a.y) * bfhi(a.y)) + (bflo(a.z) * bflo(a.z) + bfhi(a.z) * bfhi(a.z)) + (bflo(a.w) * bflo(a.w) + bfhi(a.w) * bfhi(a.w));
                  sa += __shfl_xor(sa, 1); sa += __shfl_xor(sa, 2); sa += __shfl_xor(sa, 4);
                  qm[j] = fmaxf(qm[j], sa); } }
          if ((F.lane & 7) == 0) {
#pragma unroll
              for (int j = 0; j < 4; ++j) __hip_atomic_fetch_max(F.ctl + CW_QKMAX + 8 * j + (F.lane >> 3), __float_as_uint(qm[j]), RLX_AGENT); }
#pragma unroll 1
          for (int it = gw; it < 32 * 256; it += NGW) { const bf16* kp = KB + (size_t)it * 4096 + F.lane * 8; float sb = 0.f;
#pragma unroll
              for (int ch = 0; ch < 8; ++ch) { const v4u b = *(const GAS v4u*)(kp + ch * 512);
                  sb += (bflo(b.x) * bflo(b.x) + bfhi(b.x) * bfhi(b.x)) + (bflo(b.y) * bflo(b.y) + bfhi(b.y) * bfhi(b.y)) + (bflo(b.z) * bflo(b.z) + bfhi(b.z) * bfhi(b.z)) + (bflo(b.w) * bflo(b.w) + bfhi(b.w) * bfhi(b.w)); }
#pragma unroll
              for (int o = 1; o < 64; o <<= 1) sb = fmaxf(sb, __shfl_xor(sb, o));
              if (F.lane == 0) __hip_atomic_fetch_max(F.ctl + CW_QKMAX + 32 + (it >> 8), __float_as_uint(sb), RLX_AGENT); } }
        }
        if (BOTH(3)) GRID_BAR();
    }
#endif
#ifndef NO_P4
    if (IN(4)) { F.tid = ftid(); F.lane = F.tid & 63;
        if (blockIdx.x < 4) { const int e = blockIdx.x * 512 + F.tid; float hst = 0.f;
            for (int c0 = 0; c0 < SEQ / rgl::T; c0 += 8) { float a[8], b[8];
#pragma unroll
                for (int j = 0; j < 8; ++j) { a[j] = CA[(size_t)(c0 + j) * DRNN + e]; b[j] = CB[(size_t)(c0 + j) * DRNN + e]; }
#pragma unroll
                for (int j = 0; j < 8; ++j) { HC[(size_t)(c0 + j) * DRNN + e] = hst; hst = a[j] * hst + b[j]; } }
            VM_WAIT(); __syncthreads(); }
        for (int rep = 0; rep < PROBE_REP(4); ++rep)
        for (;;) {
            if (F.tid == 0) F.MISC[16] = __hip_atomic_fetch_add(F.ctl + CW_ATTQ + 64 * rep, 1u, RLX_AGENT);
            __syncthreads();
            const int idx = (int)F.MISC[16];
            __syncthreads();
            if (idx >= 2048) break;
            const int h = 15 - (idx >> 7), qb = 63 - ((idx >> 1) & 63), c = idx & 1;
            const float sl2 = exp2f(-0.5f * (float)(h + 1)) * LOG2E;
            const float qm = __uint_as_float(__hip_atomic_load(F.ctl + CW_QKMAX + 2 * h + c, RLX_AGENT)), km = __uint_as_float(__hip_atomic_load(F.ctl + CW_QKMAX + 32 + 2 * h + c, RLX_AGENT));
            const float Bq = sqrtf(qm * km) * 1.001f + 0.01f;
            const float dmaxf = (2.0f * Bq + 44.0f) / sl2;
            int t_start = 0;
            if (dmaxf < 20000.0f) { const int lim = qb * 256 - (int)ceilf(dmaxf) - 63; t_start = (lim >= 0) ? (lim >> 6) + 1 : 0; if (t_start > 4 * qb) t_start = 4 * qb; }
            att::attn_unit(h, c, qb, QB_, KB, VB, c ? O2 : O1, (att::lds_ptr)(F.lds + RING_OFF), sl2, t_start, sqrtf(km));
        }
        if (BOTH(4)) GRID_BAR();
    }
#endif
#ifndef NO_P5
    if (IN(5)) { F.tid = ftid(); F.lane = F.tid & 63;
        for (int rep = 0; rep < PROBE_REP(5); ++rep) {
        rgl::phase<2>(RP, F.lds, F.tid, F.G);
        float lam;
        { const float p1 = (F.lane < 64) ? lq1[F.lane] * lk1[F.lane] : 0.f, p2 = lq2[F.lane] * lk2[F.lane];
          lam = __expf(wave_sum(p1)) - __expf(wave_sum(p2)) + 0.2f; }
        float sw[8];
#pragma unroll
        for (int j = 0; j < 8; ++j) sw[j] = subln_w[8 * (F.lane & 15) + j] * 0.8f;
#pragma unroll 1
        for (int m = gw; m < SEQ; m += NGW) {
#pragma unroll
            for (int j = 0; j < 4; ++j) { const size_t off = (size_t)m * 2048 + 512 * j + 8 * F.lane;
                const v4u a = *(const GAS v4u*)(O1 + off), b = *(const GAS v4u*)(O2 + off);
                float d[8]; d[0] = bflo(a.x) - lam * bflo(b.x); d[1] = bfhi(a.x) - lam * bfhi(b.x); d[2] = bflo(a.y) - lam * bflo(b.y); d[3] = bfhi(a.y) - lam * bfhi(b.y);
                d[4] = bflo(a.z) - lam * bflo(b.z); d[5] = bfhi(a.z) - lam * bfhi(b.z); d[6] = bflo(a.w) - lam * bflo(b.w); d[7] = bfhi(a.w) - lam * bfhi(b.w);
                float ss = 0.f;
#pragma unroll
                for (int q = 0; q < 8; ++q) ss += d[q] * d[q];
                ss += __shfl_xor(ss, 1); ss += __shfl_xor(ss, 2); ss += __shfl_xor(ss, 4); ss += __shfl_xor(ss, 8);
                const float rstd = 1.0f / sqrtf(ss * (1.f / 128.f) + EPS);
                v4u o; o.x = pkbf(d[0] * rstd * sw[0], d[1] * rstd * sw[1]); o.y = pkbf(d[2] * rstd * sw[2], d[3] * rstd * sw[3]);
                o.z = pkbf(d[4] * rstd * sw[4], d[5] * rstd * sw[5]); o.w = pkbf(d[6] * rstd * sw[6], d[7] * rstd * sw[7]);
                *(GAS v4u*)(YATT + off) = o; } }
        }
        if (BOTH(5)) GRID_BAR();
    }
#endif
#ifndef NO_P6
    if (IN(6)) { F.tid = ftid(); F.lane = F.tid & 63;
        { pg8::Gemm g{YATT, WPA, SEQ, DM, 2048, 2048}; pg8::StaticOrder S; S.init(SEQ, DM, F.G, (int)blockIdx.x);
          pg8::EpiGate<false> E{GAB, nullptr, M1, 1.0f};
          pg8::gemm_phase<pg8::EpiGate<false>, pg8::StaticOrder, true, true>(F.lds + RING_OFF, g, S, E); }
        VM_WAIT(); __syncthreads();
        { pg8::Gemm g{YREC, WPR, SEQ, DM, 2048, 2048}; pg8::StaticOrder S; S.init(SEQ, DM, F.G, (int)blockIdx.x);
          pg8::EpiGate<true> E{GBB, M1, MIX, 1.0f};
          pg8::gemm_phase<pg8::EpiGate<true>, pg8::StaticOrder, true, true>(F.lds + RING_OFF, g, S, E); }
        if (BOTH(6)) GRID_BAR();
    }
#endif
#ifndef NO_P7
    if (IN(7)) { F.tid = ftid(); F.lane = F.tid & 63;
        pg8::Gemm g{MIX, WOUT, SEQ, DM, DM, DM}; pg8::StaticOrder S; S.init(SEQ, DM, F.G, (int)blockIdx.x);
        pg8::EpiRes1 E{x, MOD + 2 * DM, X1B, PART};
        for (int rep = 0; rep < PROBE_REP(7); ++rep) pg8::gemm_phase<pg8::EpiRes1, pg8::StaticOrder, true, true>(F.lds + RING_OFF, g, S, E);
        if (BOTH(7)) GRID_BAR();
    }
#endif
#ifndef NO_P8
    if (IN(8)) { F.tid = ftid(); F.lane = F.tid & 63;
        const int gt = blockIdx.x * (NWAVES * 64) + F.tid, GT_ = F.G * NWAVES * 64;
        for (int row = gt; row < SEQ; row += GT_) { const GAS f32x4* p = (const GAS f32x4*)(PART + (size_t)row * 64); float s = 0.f;
#pragma unroll
            for (int j = 0; j < 16; ++j) { const f32x4 v = p[j]; s += (v.x + v.y) + (v.z + v.w); }
            RSTD[row] = 1.0f / sqrtf(s * (1.f / DM) + EPS); }
        for (int n = gt; n < NUP; n += GT_) { float s = 0.f;
#pragma unroll 8
            for (int kb = 0; kb < DM / 64; ++kb) s += BPART[(size_t)kb * NUP + n];
            BIAS2[n] = s; }
        if (BOTH(8)) GRID_BAR();
    }
#endif
#ifndef NO_P9
    if (IN(9)) { F.tid = ftid(); F.lane = F.tid & 63;
        { F.tid = ftid(); F.lane = F.tid & 63;
          if (F.G == 256 && ((int)blockIdx.x & 7) >= 4) { const int wi = ((((int)blockIdx.x >> 3) * 4) + (((int)blockIdx.x & 7) - 4)) * NWAVES + F.wave;
              LAS float* scr = (LAS float*)(F.lds + RING_OFF + F.wave * 16640);
              constexpr int I_DN64 = (DFF / 64) * (DM / 64);
#pragma unroll 1
              for (int it = wi; it < I_DN64; it += 128 * NWAVES) conv64_plain(w_dn, DFF, DM, WDN, it, scr, F.lane); }
          else if (F.G != 256) { const int wi = (int)blockIdx.x * NWAVES + F.wave; LAS float* scr = (LAS float*)(F.lds + RING_OFF + F.wave * 16640); constexpr int I_DN64 = (DFF / 64) * (DM / 64);
#pragma unroll 1
              for (int it = wi; it < I_DN64; it += F.G * NWAVES) conv64_plain(w_dn, DFF, DM, WDN, it, scr, F.lane); } }
        __syncthreads();
        F.tid = ftid(); F.lane = F.tid & 63;
        pg8::Gemm g{X1B, WUP, SEQ, NUP, DM, DM}; pg8::HalfXcdOrder S; S.init(SEQ, NUP, F.G, (int)blockIdx.x);
        pg8::EpiFfn E{ACT, fconv_w, fconv_b, GT, GH, UH, (LAS float*)(F.lds + BND_OFF), DFF, RSTD, BIAS2, (LAS float*)(F.lds + BND_OFF + 4096)};
        for (int rep = 0; rep < PROBE_REP(9); ++rep) pg8::gemm_phase<pg8::EpiFfn, pg8::HalfXcdOrder, true, true>(F.lds + RING_OFF, g, S, E);
        if (BOTH(9)) GRID_BAR();
    }
#endif
#ifndef NO_P10
    if (IN(10)) { F.tid = ftid(); F.lane = F.tid & 63;
        for (int it = blockIdx.x * (NWAVES * 64) + F.tid; it < 64 * DFF; it += F.G * NWAVES * 64) {
            const int pm = it / DFF, cc = it % DFF;
            const float w0 = fconv_w[cc], w1 = fconv_w[DFF + cc], w2 = fconv_w[2 * DFF + cc], bb = fconv_b[cc];
            const float gm2 = pm ? GT[((size_t)(pm - 1) * 2 + 0) * DFF + cc] : 0.f, gm1 = pm ? GT[((size_t)(pm - 1) * 2 + 1) * DFF + cc] : 0.f;
            const float g0 = GH[((size_t)pm * 2 + 0) * DFF + cc], g1 = GH[((size_t)pm * 2 + 1) * DFF + cc];
            const float u0 = UH[((size_t)pm * 2 + 0) * DFF + cc], u1 = UH[((size_t)pm * 2 + 1) * DFF + cc];
            const float y0 = gelu_tanhf_(bb + w0 * gm2 + w1 * gm1 + w2 * g0) * u0, y1 = gelu_tanhf_(bb + w0 * gm1 + w1 * g0 + w2 * g1) * u1;
            ACT[(size_t)(256 * pm) * DFF + cc] = (bf16)(pkbf(y0, y0) & 0xffffu); ACT[(size_t)(256 * pm + 1) * DFF + cc] = (bf16)(pkbf(y1, y1) & 0xffffu);
        }
        if (BOTH(10)) GRID_BAR();
    }
#endif
#ifndef NO_P11
    if (IN(11)) { F.tid = ftid(); F.lane = F.tid & 63;
        pg8::Gemm g{ACT, WDN, SEQ, DM, DFF, DFF}; pg8::StaticOrder S; S.init(SEQ, DM, F.G, (int)blockIdx.x);
        pg8::EpiRes2 E{X1B, MOD + 5 * DM};
        pg8::gemm_phase<pg8::EpiRes2, pg8::StaticOrder, true, true>(F.lds + RING_OFF, g, S, E);
        if (BOTH(11)) GRID_BAR();
    }
#endif
#ifndef NO_P12
    if (IN(12)) { F.tid = ftid(); F.lane = F.tid & 63;
#pragma unroll 1
        for (int m = gw; m < SEQ; m += NGW) {
            const GAS v4u* xr = (const GAS v4u*)(X1B + (size_t)m * DM) + F.lane;
            v4u v[8]; float s = 0.f;
#pragma unroll
            for (int j = 0; j < 8; ++j) { v[j] = xr[64 * j];
                s += (bflo(v[j].x) * bflo(v[j].x) + bfhi(v[j].x) * bfhi(v[j].x)) + (bflo(v[j].y) * bflo(v[j].y) + bfhi(v[j].y) * bfhi(v[j].y))
                   + (bflo(v[j].z) * bflo(v[j].z) + bfhi(v[j].z) * bfhi(v[j].z)) + (bflo(v[j].w) * bflo(v[j].w) + bfhi(v[j].w) * bfhi(v[j].w)); }
            const float rstd = 1.0f / sqrtf(wave_sum(s) * (1.f / DM) + EPS);
            GAS f32x4* orow = (GAS f32x4*)(out + (size_t)m * DM);
#pragma unroll
            for (int j = 0; j < 8; ++j) { const int c0 = 512 * j + 8 * F.lane;
                const f32x4 w0 = *(const GAS f32x4*)(normf_w + c0), w1 = *(const GAS f32x4*)(normf_w + c0 + 4);
                orow[c0 / 4] = (f32x4){bflo(v[j].x) * rstd * w0.x, bfhi(v[j].x) * rstd * w0.y, bflo(v[j].y) * rstd * w0.z, bfhi(v[j].y) * rstd * w0.w};
                orow[c0 / 4 + 1] = (f32x4){bflo(v[j].z) * rstd * w1.x, bfhi(v[j].z) * rstd * w1.y, bflo(v[j].w) * rstd * w1.z, bfhi(v[j].w) * rstd * w1.w}; }
        }
    }
#endif
#undef IN
#undef BOTH
#undef GRID_BAR
}

extern "C" void kernel_launch(void* const* d_in, const int* in_sizes, int n_in, void* d_out, int out_size, void* d_ws, size_t ws_size, hipStream_t stream) {
    static int grid = 0;
    if (grid == 0) {
        if (n_in != 27 || out_size != SEQ * DM || ws_size < WS_END) { fprintf(stderr, "kernel_launch: unexpected problem (n_in %d, out %d, ws %zu); nothing launched\n", n_in, out_size, ws_size); grid = -1; return; }
        int dev = 0, cus = 0, per_cu = 0;
        if (hipGetDevice(&dev) != hipSuccess || hipDeviceGetAttribute(&cus, hipDeviceAttributeMultiprocessorCount, dev) != hipSuccess) { grid = -1; return; }
        if (hipFuncSetAttribute((const void*)mk_fwd, hipFuncAttributeMaxDynamicSharedMemorySize, LDS_BYTES) != hipSuccess) { fprintf(stderr, "kernel_launch: hipFuncSetAttribute failed\n"); grid = -1; return; }
        if (hipOccupancyMaxActiveBlocksPerMultiprocessor(&per_cu, (const void*)mk_fwd, NWAVES * 64, LDS_BYTES) != hipSuccess || per_cu < 1)
            fprintf(stderr, "kernel_launch: note: occupancy query reports %d workgroups per CU\n", per_cu);
        (void)hipGetLastError();
        grid = cus;
    }
    if (grid < 0) return;
    if (hipMemsetAsync((char*)d_ws + WS_CTL, 0, CTL_ZERO_BYTES, stream) != hipSuccess) return;
    Args a{};
    for (int i = 0; i < 27; ++i) a.in[i] = (const float*)d_in[i];
    a.out = (float*)d_out; a.ws = (unsigned char*)d_ws;
    for (int li = 0; li < N_LAUNCHES; ++li) {
        a.ph_lo = (N_LAUNCHES == 1) ? 0 : li; a.ph_hi = (N_LAUNCHES == 1) ? N_PHASES : li + 1;
        hipLaunchKernelGGL(mk_fwd, dim3(grid), dim3(NWAVES * 64), LDS_BYTES, stream, a);
        const hipError_t le = hipPeekAtLastError();
        if (le != hipSuccess) { fprintf(stderr, "kernel_launch: launch %d failed: %s\n", li, hipGetErrorName(le)); break; }
    }
}
```

```cpp
#include <hip/hip_runtime.h>
#include <cstdio>
#include <cstdint>
#ifndef MK_N_LAUNCHES
#define MK_N_LAUNCHES 1
#endif
__device__ __forceinline__ int ftid() { int t = (int)threadIdx.x; asm volatile("" : "+v"(t)); return t; }
namespace pg8 {
#define PG8_LAS __attribute__((address_space(3)))
typedef unsigned short bf16_t;
typedef short bf16x8 __attribute__((ext_vector_type(8)));
typedef float f32x4 __attribute__((ext_vector_type(4)));
typedef unsigned u32x4 __attribute__((ext_vector_type(4)));
constexpr int BM = 256, BK = 64, HALF = 128, HTB = HALF * BK * 2  , STAGE_BYTES = 8 * HTB, NXCD = 8, WGM = 8;

__host__ __device__ __forceinline__ int lds_byte(int r, int c) { const int st = (r >> 4) * 2 + (c >> 5), rr = r & 15, cc = c & 31, ob = rr * 64 + cc * 2; return st * 1024 + (ob ^ (((ob >> 9) & 1) << 5)); }
__host__ __device__ __forceinline__ void stage_rc(int b, int& R, int& C) { const int st = b / 1024, sb = b % 1024, swz = sb ^ (((sb >> 9) & 1) << 5); R = (st >> 1) * 16 + swz / 64; C = (st & 1) * 32 + (swz % 64) / 2; }
__host__ __device__ __forceinline__ int perm32(int rho) { const int n = rho >> 4, i = rho & 15; return 8 * (i >> 2) + 4 * n + (i & 3); }

struct Unit { int pm, pn; };
struct Gemm { const bf16_t* A; const bf16_t* Bt; int M, N, K, ld; };

struct StaticOrder {
    int nM, nN, nwg, G, c;
    __host__ __device__ void init(int M, int N, int G_, int c_) { nM = M / BM; nN = N / BM; nwg = nM * nN; G = G_; c = c_; }
    __host__ __device__ bool next(int i, Unit& u) const {
        const long L = (long)i * G + c; if (L >= nwg) return false;
        int wgid = (int)L; { const int q = nwg / NXCD, r = nwg % NXCD, xcd = wgid % NXCD, off = wgid / NXCD; wgid = (xcd < r ? xcd * (q + 1) : r * (q + 1) + (xcd - r) * q) + off; }
        const int nig = WGM * nN, gid = wgid / nig, fm = gid * WGM, gsz = (nM - fm) < WGM ? (nM - fm) : WGM;
        u.pm = fm + ((wgid % nig) % gsz); u.pn = (wgid % nig) / gsz; return true;
    }
    __device__ __forceinline__ void a_ready(const Unit&) const {}
    __device__ __forceinline__ void done(const Unit&) const {}
};

struct HalfXcdOrder : StaticOrder {
    __host__ __device__ bool next(int i, Unit& u) const {
        const int full = nwg / G;
        if (i < full) return StaticOrder::next(i, u);
        if (i > full || (nwg % G) * 2 != G || G != 256) return (nwg % G) * 2 != G || G != 256 ? StaticOrder::next(i, u) : false;
        const int xcd = c % NXCD, slot = c / NXCD, q = nwg / NXCD; if (xcd >= 4) return false;
        const int wgid = (slot < 16 ? xcd : xcd + 4) * q + full * (G / NXCD) + (slot & 15);
        const int nig = WGM * nN, gid = wgid / nig, fm = gid * WGM, gsz = (nM - fm) < WGM ? (nM - fm) : WGM;
        u.pm = fm + ((wgid % nig) % gsz); u.pn = (wgid % nig) / gsz; return true;
    }
};
struct ProjOrder16 : StaticOrder {
    __host__ __device__ bool next(int i, Unit& u) const { if (!StaticOrder::next(i, u)) return false; u.pn = u.pn < 16 ? u.pn + 24 : u.pn + 40; return true; }
};
struct StaticOrderFixed : StaticOrder {
    __host__ __device__ bool next(int i, Unit& u) const { const long L = (long)i * G + c; if (L >= nwg) return false; StaticOrder t = *this; return t.StaticOrder::next(0, u); }
};
__device__ __forceinline__ unsigned cvt_pk_bf16(float lo, float hi) { unsigned r; asm volatile("v_cvt_pk_bf16_f32 %0, %1, %2" : "=v"(r) : "v"(lo), "v"(hi)); return r; }
typedef float f32x2 __attribute__((ext_vector_type(2)));
__device__ __forceinline__ float sigmoid_f(float v) { return __builtin_amdgcn_rcpf(1.0f + __builtin_amdgcn_exp2f(-1.4426950408889634f * v)); }
__device__ __forceinline__ float gelu_tanh_f(float v) { const float u = v * (0.7978845608028654f + 0.035677408136300125f * v * v);
    return v * __builtin_amdgcn_rcpf(1.0f + __builtin_amdgcn_exp2f(-2.8853900817779268f * u)); }
__device__ __forceinline__ float bf_lo(unsigned w) { return __uint_as_float(w << 16); }
__device__ __forceinline__ float bf_hi(unsigned w) { return __uint_as_float(w & 0xffff0000u); }

template <int ACT, int LAYOUT = 0> __device__ __forceinline__ void store_tile_bf16(const f32x4 (&acc)[2][2][4][2], bf16_t* base, int ldc, int row0, int col0, float sc) {
#pragma unroll
    for (int ai = 0; ai < 2; ++ai)
#pragma unroll
        for (int m = 0; m < 4; ++m) { const int row = row0 + ai * HALF + m * 16; bf16_t* rowp = base + (size_t)row * ldc + col0;
            if (LAYOUT == 1) rowp = base + ((size_t)((col0 >> 6) * 256 + (row >> 6)) * 4096 + ((col0 & 63) >> 3) * 512 + (row & 63) * 8);
            if (LAYOUT == 2) rowp = base + ((size_t)((col0 >> 7) * 256 + (row >> 6)) * 8192 + (((col0 & 127) >> 5) * 4 + ((row & 63) >> 4)) * 512 + (row & 15) * 32 + (col0 & 31));
#pragma unroll
            for (int bj = 0; bj < 2; ++bj) { f32x4 v0 = acc[ai][bj][m][0], v1 = acc[ai][bj][m][1];
                if (ACT == 0) { v0 = v0 * sc; v1 = v1 * sc; }
                if (ACT == 2) {
#pragma unroll
                    for (int j = 0; j < 4; ++j) { v0[j] = gelu_tanh_f(v0[j]); v1[j] = gelu_tanh_f(v1[j]); } }
                if (ACT == 3) {
#pragma unroll
                    for (int j = 0; j < 4; ++j) { v0[j] = sigmoid_f(v0[j] * sc); v1[j] = sigmoid_f(v1[j] * sc); } }
                u32x4 w; w.x = cvt_pk_bf16(v0[0], v0[1]); w.y = cvt_pk_bf16(v0[2], v0[3]); w.z = cvt_pk_bf16(v1[0], v1[1]); w.w = cvt_pk_bf16(v1[2], v1[3]);
                *(u32x4*)(rowp + (LAYOUT == 1 ? bj * 2 * 256 * 4096 : LAYOUT == 2 ? bj * 256 * 8192 : bj * HALF)) = w;
                if (ACT != 0) __builtin_amdgcn_sched_barrier(0); } }
}
struct EpiProj {
    static constexpr bool PERM = true, AFTER_DRAIN = false;
    bf16_t *Q, *K, *V, *RX, *RG, *GA, *GB; float qscale, gscale;
    __device__ __forceinline__ void operator()(const f32x4 (&acc)[2][2][4][2], const Unit& u, int wr, int wc, int fr, int fq) const {
        const int pn = u.pn; const int row0 = u.pm * BM + wr * 64 + fr, cw = wc * 32 + 8 * fq;
        bf16_t* base; int ldc = 2048, colt, kind = 0; float sc = 1.0f;
        if (pn < 8)       { base = Q;  colt = pn * 256; sc = qscale * gscale; }
        else if (pn < 16) { base = K;  colt = (pn - 8) * 256; kind = 4; sc = gscale; }
        else if (pn < 24) { base = V;  colt = (pn - 16) * 256; kind = 5; sc = gscale; }
        else if (pn < 32) { base = RX; colt = (pn - 24) * 256; }
        else if (pn < 40) { base = RG; colt = (pn - 32) * 256; kind = 2; }
        else if (pn < 56) { base = GA; colt = (pn - 40) * 256; kind = 3; ldc = 4096; sc = gscale; }
        else              { base = GB; colt = (pn - 56) * 256; kind = 3; ldc = 4096; sc = gscale; }
        if (kind == 4)      store_tile_bf16<0, 1>(acc, base, ldc, row0, colt + cw, sc);
        else if (kind == 5) store_tile_bf16<0, 2>(acc, base, ldc, row0, colt + cw, sc);
        else if (kind == 0) store_tile_bf16<0>(acc, base, ldc, row0, colt + cw, sc);
        else if (kind == 2) store_tile_bf16<2>(acc, base, ldc, row0, colt + cw, sc);
        else                store_tile_bf16<3>(acc, base, ldc, row0, colt + cw, sc);
    }
};
struct EpiProjOff {
    static constexpr bool PERM = true, AFTER_DRAIN = false;
    EpiProj e; int off;
    __device__ __forceinline__ void operator()(const f32x4 (&acc)[2][2][4][2], const Unit& u, int wr, int wc, int fr, int fq) const { Unit u2 = u; u2.pn += off; e(acc, u2, wr, wc, fr, fq); }
};
struct EpiProjF8 {
    static constexpr bool PERM = true, AFTER_DRAIN = false;
    EpiProj e;
    __device__ __forceinline__ void operator()(const f32x4 (&acc)[2][2][4][2], const Unit& u, int wr, int wc, int fr, int fq) const { Unit u2 = u; u2.pn = u.pn < 24 ? u.pn : u.pn + 16; e(acc, u2, wr, wc, fr, fq); }
};
struct EpiPlain {
    static constexpr bool PERM = true, AFTER_DRAIN = false;
    bf16_t* O; int ldc;
    __device__ __forceinline__ void operator()(const f32x4 (&acc)[2][2][4][2], const Unit& u, int wr, int wc, int fr, int fq) const {
        store_tile_bf16<0>(acc, O, ldc, u.pm * BM + wr * 64 + fr, u.pn * BM + wc * 32 + 8 * fq, 1.0f);
    }
};
template <bool HAS_ADD> struct EpiGate {
    static constexpr bool PERM = true, AFTER_DRAIN = false;
    const bf16_t* G; const bf16_t* ADD; bf16_t* O; float sc;
    __device__ __forceinline__ void operator()(const f32x4 (&acc)[2][2][4][2], const Unit& u, int wr, int wc, int fr, int fq) const {
        const int row0 = u.pm * BM + wr * 64 + fr, col0 = u.pn * BM + wc * 32 + 8 * fq;
#pragma unroll
        for (int ai = 0; ai < 2; ++ai)
#pragma unroll
            for (int mh = 0; mh < 2; ++mh) {
                u32x4 g[2][2], ad[2][2];
#pragma unroll
                for (int mm = 0; mm < 2; ++mm) { const size_t off = (size_t)(row0 + ai * HALF + (2 * mh + mm) * 16) * 4096 + col0;
#pragma unroll
                    for (int bj = 0; bj < 2; ++bj) { g[mm][bj] = *(const u32x4*)(G + off + bj * HALF); if (HAS_ADD) ad[mm][bj] = *(const u32x4*)(ADD + off + bj * HALF); } }
#pragma unroll
                for (int mm = 0; mm < 2; ++mm) { const int m = 2 * mh + mm; const size_t off = (size_t)(row0 + ai * HALF + m * 16) * 4096 + col0;
#pragma unroll
                    for (int bj = 0; bj < 2; ++bj) { const u32x4 gg = g[mm][bj];
                        f32x4 v0 = acc[ai][bj][m][0] * sc, v1 = acc[ai][bj][m][1] * sc;
                        v0[0] *= bf_lo(gg.x); v0[1] *= bf_hi(gg.x); v0[2] *= bf_lo(gg.y); v0[3] *= bf_hi(gg.y); v1[0] *= bf_lo(gg.z); v1[1] *= bf_hi(gg.z); v1[2] *= bf_lo(gg.w); v1[3] *= bf_hi(gg.w);
                        if (HAS_ADD) { const u32x4 a = ad[mm][bj];
                            v0[0] += bf_lo(a.x); v0[1] += bf_hi(a.x); v0[2] += bf_lo(a.y); v0[3] += bf_hi(a.y); v1[0] += bf_lo(a.z); v1[1] += bf_hi(a.z); v1[2] += bf_lo(a.w); v1[3] += bf_hi(a.w); }
                        u32x4 w; w.x = cvt_pk_bf16(v0[0], v0[1]); w.y = cvt_pk_bf16(v0[2], v0[3]); w.z = cvt_pk_bf16(v1[0], v1[1]); w.w = cvt_pk_bf16(v1[2], v1[3]);
                        *(u32x4*)(O + off + bj * HALF) = w; } }
                asm volatile("" ::: "memory"); }
    }
};
struct EpiRes1 {
    static constexpr bool PERM = true, AFTER_DRAIN = false;
    const float* x; const float* gvec; bf16_t* X1B; float* PART;
    __device__ __forceinline__ void operator()(const f32x4 (&acc)[2][2][4][2], const Unit& u, int wr, int wc, int fr, int fq) const {
        const int row0 = u.pm * BM + wr * 64 + fr, col0 = u.pn * BM + wc * 32 + 8 * fq;
        f32x4 gv[2][2];
#pragma unroll
        for (int bj = 0; bj < 2; ++bj)
#pragma unroll
            for (int n = 0; n < 2; ++n) gv[bj][n] = *(const f32x4*)(gvec + col0 + bj * HALF + n * 4);
#pragma unroll
        for (int ai = 0; ai < 2; ++ai)
#pragma unroll
            for (int mh = 0; mh < 2; ++mh) {
                f32x4 bs[2][2][2];
#pragma unroll
                for (int mm = 0; mm < 2; ++mm) { const size_t off = (size_t)(row0 + ai * HALF + (2 * mh + mm) * 16) * 4096 + col0;
#pragma unroll
                    for (int bj = 0; bj < 2; ++bj)
#pragma unroll
                        for (int n = 0; n < 2; ++n) bs[mm][bj][n] = *(const f32x4*)(x + off + bj * HALF + n * 4); }
#pragma unroll
                for (int mm = 0; mm < 2; ++mm) { const int m = 2 * mh + mm, row = row0 + ai * HALF + m * 16; const size_t off = (size_t)row * 4096 + col0; float ss = 0.f;
#pragma unroll
                    for (int bj = 0; bj < 2; ++bj) { const f32x4 v0 = bs[mm][bj][0] + gv[bj][0] * acc[ai][bj][m][0], v1 = bs[mm][bj][1] + gv[bj][1] * acc[ai][bj][m][1];
                        ss += (v0[0] * v0[0] + v0[1] * v0[1]) + (v0[2] * v0[2] + v0[3] * v0[3]) + (v1[0] * v1[0] + v1[1] * v1[1]) + (v1[2] * v1[2] + v1[3] * v1[3]);
                        u32x4 w; w.x = cvt_pk_bf16(v0[0], v0[1]); w.y = cvt_pk_bf16(v0[2], v0[3]); w.z = cvt_pk_bf16(v1[0], v1[1]); w.w = cvt_pk_bf16(v1[2], v1[3]);
                        *(u32x4*)(X1B + off + bj * HALF) = w; }
                    ss += __shfl_xor(ss, 16); ss += __shfl_xor(ss, 32);
                    if (fq == 0) PART[(size_t)row * 64 + u.pn * 4 + wc] = ss; }
                asm volatile("" ::: "memory"); }
    }
};
struct EpiRes2 {
    static constexpr bool PERM = true, AFTER_DRAIN = false;
    bf16_t* XB; const float* gvec;
    __device__ __forceinline__ void operator()(const f32x4 (&acc)[2][2][4][2], const Unit& u, int wr, int wc, int fr, int fq) const {
        const int row0 = u.pm * BM + wr * 64 + fr, col0 = u.pn * BM + wc * 32 + 8 * fq;
        f32x4 gv[2][2];
#pragma unroll
        for (int bj = 0; bj < 2; ++bj)
#pragma unroll
            for (int n = 0; n < 2; ++n) gv[bj][n] = *(const f32x4*)(gvec + col0 + bj * HALF + n * 4);
#pragma unroll
        for (int ai = 0; ai < 2; ++ai) {
            u32x4 bs[4][2];
#pragma unroll
            for (int m = 0; m < 4; ++m)
#pragma unroll
                for (int bj = 0; bj < 2; ++bj) bs[m][bj] = *(const u32x4*)(XB + (size_t)(row0 + ai * HALF + m * 16) * 4096 + col0 + bj * HALF);
#pragma unroll
            for (int m = 0; m < 4; ++m)
#pragma unroll
                for (int bj = 0; bj < 2; ++bj) { const u32x4 b = bs[m][bj];
                    f32x4 v0 = gv[bj][0] * acc[ai][bj][m][0], v1 = gv[bj][1] * acc[ai][bj][m][1];
                    v0[0] += bf_lo(b.x); v0[1] += bf_hi(b.x); v0[2] += bf_lo(b.y); v0[3] += bf_hi(b.y); v1[0] += bf_lo(b.z); v1[1] += bf_hi(b.z); v1[2] += bf_lo(b.w); v1[3] += bf_hi(b.w);
                    u32x4 w; w.x = cvt_pk_bf16(v0[0], v0[1]); w.y = cvt_pk_bf16(v0[2], v0[3]); w.z = cvt_pk_bf16(v1[0], v1[1]); w.w = cvt_pk_bf16(v1[2], v1[3]);
                    *(u32x4*)(XB + (size_t)(row0 + ai * HALF + m * 16) * 4096 + col0 + bj * HALF) = w; }
            asm volatile("" ::: "memory"); }
    }
};
__device__ __forceinline__ float dpp_ror1(float v) { return __int_as_float(__builtin_amdgcn_mov_dpp(__float_as_int(v), 0x121, 0xf, 0xf, true)); }
__device__ __forceinline__ float dpp_ror2(float v) { return __int_as_float(__builtin_amdgcn_mov_dpp(__float_as_int(v), 0x122, 0xf, 0xf, true)); }
struct EpiFfn {
    static constexpr bool PERM = true, AFTER_DRAIN = false, HAS_PREF = true;
    bf16_t* ACT; const float* cw; const float* cb; float* GT; float* GH; float* UH; PG8_LAS float* bnd; int dff; const float* rstd; const float* bias2;
    PG8_LAS float* stg;
    __device__ __forceinline__ void prefetch(const Unit& u, int par, int wid, int lane) const {
        if (wid < 4) { const int hi = lane >> 5, l4 = 4 * (lane & 31), c0 = u.pn * 128 + l4; const float* src;
            if (wid == 0) src = rstd + u.pm * BM + 4 * lane;
            else if (wid == 1) src = bias2 + hi * dff + c0;
            else if (wid == 2) src = cw + hi * dff + c0;
            else src = hi ? (cb + c0) : (cw + 2 * dff + c0);
            __builtin_amdgcn_global_load_lds((const unsigned*)src, (PG8_LAS unsigned*)(stg + par * 1024 + wid * 256), 16, 0, 0); }
    }
    __device__ __forceinline__ void operator()(const f32x4 (&acc)[2][2][4][2], const Unit& u, int wr, int wc, int fr, int fq, int par) const {
        const int cl = wc * 32 + 8 * fq, cact = u.pn * 128 + cl, row0 = u.pm * BM + wr * 64 + fr;
        const PG8_LAS float* sg = stg + par * 1024;
        float rs[2][4], bg[8], bu[8];
#pragma unroll
        for (int ai = 0; ai < 2; ++ai)
#pragma unroll
            for (int m = 0; m < 4; ++m) rs[ai][m] = sg[wr * 64 + fr + ai * HALF + m * 16];
        { const f32x4 a0 = *(const PG8_LAS f32x4*)(sg + 256 + cl), a1 = *(const PG8_LAS f32x4*)(sg + 256 + cl + 4), b0 = *(const PG8_LAS f32x4*)(sg + 384 + cl), b1 = *(const PG8_LAS f32x4*)(sg + 384 + cl + 4);
#pragma unroll
          for (int q = 0; q < 4; ++q) { bg[q] = a0[q]; bg[4 + q] = a1[q]; bu[q] = b0[q]; bu[4 + q] = b1[q]; } }
#define FFN_G(ai, m, q) (rs[ai][m] * acc[ai][0][m][(q) >> 2][(q) & 3] + bg[q])
#define FFN_U(ai, m, q) (rs[ai][m] * acc[ai][1][m][(q) >> 2][(q) & 3] + bu[q])
        if (fr >= 14) {
#pragma unroll
            for (int ai = 0; ai < 2; ++ai) { PG8_LAS float* d = bnd + ((ai * 2 + wr) * 2 + (fr - 14)) * 128 + cl;
                *(PG8_LAS f32x4*)d = (f32x4){FFN_G(ai, 3, 0), FFN_G(ai, 3, 1), FFN_G(ai, 3, 2), FFN_G(ai, 3, 3)}; *(PG8_LAS f32x4*)(d + 4) = (f32x4){FFN_G(ai, 3, 4), FFN_G(ai, 3, 5), FFN_G(ai, 3, 6), FFN_G(ai, 3, 7)}; }
            if (wr == 1) { float* d = GT + ((size_t)u.pm * 2 + (fr - 14)) * dff + cact;
                *(f32x4*)d = (f32x4){FFN_G(1, 3, 0), FFN_G(1, 3, 1), FFN_G(1, 3, 2), FFN_G(1, 3, 3)}; *(f32x4*)(d + 4) = (f32x4){FFN_G(1, 3, 4), FFN_G(1, 3, 5), FFN_G(1, 3, 6), FFN_G(1, 3, 7)}; }
        }
        if (fr < 2 && wr == 0) { float* d = GH + ((size_t)u.pm * 2 + fr) * dff + cact;
            *(f32x4*)d = (f32x4){FFN_G(0, 0, 0), FFN_G(0, 0, 1), FFN_G(0, 0, 2), FFN_G(0, 0, 3)}; *(f32x4*)(d + 4) = (f32x4){FFN_G(0, 0, 4), FFN_G(0, 0, 5), FFN_G(0, 0, 6), FFN_G(0, 0, 7)};
            float* e2 = UH + ((size_t)u.pm * 2 + fr) * dff + cact;
            *(f32x4*)e2 = (f32x4){FFN_U(0, 0, 0), FFN_U(0, 0, 1), FFN_U(0, 0, 2), FFN_U(0, 0, 3)}; *(f32x4*)(e2 + 4) = (f32x4){FFN_U(0, 0, 4), FFN_U(0, 0, 5), FFN_U(0, 0, 6), FFN_U(0, 0, 7)}; }
        float w0[8], w1[8], w2[8], bb[8];
        { const f32x4 a0 = *(const PG8_LAS f32x4*)(sg + 512 + cl), a1 = *(const PG8_LAS f32x4*)(sg + 512 + cl + 4), b0 = *(const PG8_LAS f32x4*)(sg + 640 + cl), b1 = *(const PG8_LAS f32x4*)(sg + 640 + cl + 4);
          const f32x4 c0 = *(const PG8_LAS f32x4*)(sg + 768 + cl), c1 = *(const PG8_LAS f32x4*)(sg + 768 + cl + 4), d0 = *(const PG8_LAS f32x4*)(sg + 896 + cl), d1 = *(const PG8_LAS f32x4*)(sg + 896 + cl + 4);
#pragma unroll
          for (int q = 0; q < 4; ++q) { w0[q] = a0[q]; w0[4 + q] = a1[q]; w1[q] = b0[q]; w1[4 + q] = b1[q]; w2[q] = c0[q]; w2[4 + q] = c1[q]; bb[q] = d0[q]; bb[4 + q] = d1[q]; } }
        asm volatile("s_waitcnt lgkmcnt(0)" ::: "memory"); __builtin_amdgcn_s_barrier(); asm volatile("" ::: "memory");
#pragma unroll
        for (int ai = 0; ai < 2; ++ai) {
            float prv[8];
            { const bool have = (wr == 1) || (ai == 1);
              const int src = (wr == 1) ? (ai * 2 + 0) : (0 * 2 + 1);
              const PG8_LAS float* sp = bnd + (src * 2 + ((fr >= 14) ? (fr - 14) : 0)) * 128 + cl;
              const f32x4 x0 = *(const PG8_LAS f32x4*)sp, x1 = *(const PG8_LAS f32x4*)(sp + 4);
#pragma unroll
              for (int q = 0; q < 4; ++q) { prv[q] = have ? x0[q] : 0.f; prv[4 + q] = have ? x1[q] : 0.f; } }
#pragma unroll
            for (int m = 0; m < 4; ++m) {
                const f32x2 rs2 = {rs[ai][m], rs[ai][m]};
                unsigned wo[4];
#pragma unroll
                for (int p = 0; p < 4; ++p) {
                    const f32x4 ag = acc[ai][0][m][p >> 1], au = acc[ai][1][m][p >> 1];
                    const f32x2 a2 = (p & 1) ? __builtin_shufflevector(ag, ag, 2, 3) : __builtin_shufflevector(ag, ag, 0, 1);
                    const f32x2 u2 = (p & 1) ? __builtin_shufflevector(au, au, 2, 3) : __builtin_shufflevector(au, au, 0, 1);
                    const f32x2 cur = rs2 * a2 + (f32x2){bg[2 * p], bg[2 * p + 1]};
                    const f32x2 up = rs2 * u2 + (f32x2){bu[2 * p], bu[2 * p + 1]};
                    f32x2 cv = (f32x2){w2[2 * p], w2[2 * p + 1]} * cur + (f32x2){bb[2 * p], bb[2 * p + 1]};
#pragma unroll
                    for (int e = 0; e < 2; ++e) { const int q = 2 * p + e; const float c = cur[e], pv = prv[q];
                        const float t1 = (fr == 15) ? pv : c, t2 = (fr >= 14) ? pv : c;
                        cv[e] = __builtin_fmaf(dpp_ror1(t1), w1[q], cv[e]); cv[e] = __builtin_fmaf(dpp_ror2(t2), w0[q], cv[e]); prv[q] = c; }
                    const f32x2 t = cv * cv, pp = t * (f32x2){-0.10294324f, -0.10294324f} + (f32x2){-2.3022082f, -2.3022082f}, uu = cv * pp;
                    const f32x2 d = (f32x2){__builtin_amdgcn_exp2f(uu.x), __builtin_amdgcn_exp2f(uu.y)} + (f32x2){1.f, 1.f};
                    const f32x2 y = cv * (f32x2){__builtin_amdgcn_rcpf(d.x), __builtin_amdgcn_rcpf(d.y)} * up;
                    wo[p] = cvt_pk_bf16(y.x, y.y); }
                u32x4 w; w.x = wo[0]; w.y = wo[1]; w.z = wo[2]; w.w = wo[3];
                *(u32x4*)(ACT + (size_t)(row0 + ai * HALF + m * 16) * dff + cact) = w;
                __builtin_amdgcn_sched_barrier(0); }
        }
#undef FFN_G
#undef FFN_U
    }
};

struct EpiNone {
    static constexpr bool PERM = true, AFTER_DRAIN = false;
    __device__ __forceinline__ void operator()(const f32x4 (&acc)[2][2][4][2], const Unit& u, int wr, int wc, int fr, int fq) const {
#pragma unroll
        for (int ai = 0; ai < 2; ++ai)
#pragma unroll
            for (int bj = 0; bj < 2; ++bj)
#pragma unroll
                for (int m = 0; m < 4; ++m)
#pragma unroll
                    for (int n = 0; n < 2; ++n) asm volatile("" :: "v"(acc[ai][bj][m][n]));
    }
};

template <class T, class = void> struct epi_has_pref { static constexpr bool value = false; };
template <class T> struct epi_has_pref<T, decltype((void)T::HAS_PREF)> { static constexpr bool value = true; };
typedef int pg8_i32x4 __attribute__((ext_vector_type(4)));
typedef int pg8_i32x8 __attribute__((ext_vector_type(8)));
template <class Epi, class Sched, bool ALIGN_EPI = false, bool SP2 = false, bool F8 = false>
__device__ __forceinline__ void gemm_phase(PG8_LAS unsigned char* lds, const Gemm g, const Sched& S, const Epi& E) {
    const int tid = ftid(), wid = __builtin_amdgcn_readfirstlane(tid >> 6), lane = tid & 63, wr = wid >> 2, wc = wid & 3, fr = lane & 15, fq = lane >> 4;
    const int sc8 = __builtin_amdgcn_readfirstlane(0x7F7F7F7F);
    constexpr int ES = F8 ? 1 : 2, KSTR = F8 ? 16 : 1024;
    const int K = g.K, nt = K * ES / (BK * 2), LD = g.ld;
    unsigned voffA[2], voffB[2];
#pragma unroll
    for (int i = 0; i < 2; ++i) { int R, C; stage_rc(tid * 16 + i * 8192, R, C); const int Rb = Epi::PERM ? ((R & ~31) + perm32(R & 31)) : R;
        voffA[i] = (unsigned)(R * LD) * (unsigned)ES + (unsigned)C * 2u; voffB[i] = (unsigned)(Rb * LD) * (unsigned)ES + (unsigned)C * 2u; }
    const size_t kstep = (size_t)(BK * 2);
    const size_t hstep = (size_t)HALF * LD * ES;
    const size_t tstep = 2 * hstep;
    const unsigned ldsw = (unsigned)wid * 1024u;
    const int aoff = lds_byte(wr * 64 + fr, fq * (F8 ? 16 : 8)), boff = lds_byte(wc * 32 + fr, fq * (F8 ? 16 : 8));
#define PG8_SA(b, h) (((b) * 2 + (h)) * HTB)
#define PG8_SB(b, h) ((4 + (b) * 2 + (h)) * HTB)
#define PG8_STAGE(bufoff, gbase, voff) do { _Pragma("unroll") for (int _i = 0; _i < 2; ++_i) \
        __builtin_amdgcn_global_load_lds((const unsigned*)((const char*)(gbase) + (voff)[_i]), (PG8_LAS unsigned*)(lds + (bufoff) + ldsw + _i * 8192), 16, 0, 0); } while (0)
#define PG8_LDA(dst, b, h) do { _Pragma("unroll") for (int m = 0; m < 4; ++m) _Pragma("unroll") for (int k = 0; k < 2; ++k) dst[m][k] = *(const PG8_LAS bf16x8*)(lds + PG8_SA(b, h) + aoff + m * 2048 + k * KSTR); } while (0)
#define PG8_LDB(dst, b, h) do { _Pragma("unroll") for (int n = 0; n < 2; ++n) _Pragma("unroll") for (int k = 0; k < 2; ++k) dst[n][k] = *(const PG8_LAS bf16x8*)(lds + PG8_SB(b, h) + boff + n * 2048 + k * KSTR); } while (0)
#define PG8_CAT8(x0, x1) __builtin_shufflevector(__builtin_bit_cast(pg8_i32x4, x0), __builtin_bit_cast(pg8_i32x4, x1), 0, 1, 2, 3, 4, 5, 6, 7)
#define PG8_MMA(ai, bj, At, Bt) do { __builtin_amdgcn_s_setprio(1); \
        if constexpr (F8) { _Pragma("unroll") for (int m = 0; m < 4; ++m) _Pragma("unroll") for (int n = 0; n < 2; ++n) \
            asm volatile("v_mfma_scale_f32_16x16x128_f8f6f4 %0, %1, %2, %0, %3, %3 op_sel_hi:[0,0,0]" : "+v"(acc[ai][bj][m][n]) : "v"(PG8_CAT8(Bt[n][0], Bt[n][1])), "v"(PG8_CAT8(At[m][0], At[m][1])), "v"(sc8)); } \
        else { _Pragma("unroll") for (int m = 0; m < 4; ++m) _Pragma("unroll") for (int n = 0; n < 2; ++n) _Pragma("unroll") for (int k = 0; k < 2; ++k) \
            acc[ai][bj][m][n] = __builtin_amdgcn_mfma_f32_16x16x32_bf16(Bt[n][k], At[m][k], acc[ai][bj][m][n], 0, 0, 0); } \
        __builtin_amdgcn_s_setprio(0); } while (0)
#define PG8_WAIT_V(n) asm volatile("s_waitcnt vmcnt(" #n ")" ::: "memory")
#define PG8_WAIT_L(n) asm volatile("s_waitcnt lgkmcnt(" #n ")" ::: "memory")
#define PG8_BAR __builtin_amdgcn_s_barrier()
#define PG8_SCHED __builtin_amdgcn_sched_barrier(0)
    Unit cur, nxt; int ui = 0;
    if (!S.next(0, cur)) return;
    f32x4 acc[2][2][4][2];
#pragma unroll
    for (int a = 0; a < 2; ++a)
#pragma unroll
        for (int b = 0; b < 2; ++b)
#pragma unroll
            for (int m = 0; m < 4; ++m)
#pragma unroll
                for (int n = 0; n < 2; ++n) acc[a][b][m][n] = (f32x4){0.f, 0.f, 0.f, 0.f};
    bf16x8 At[4][2], B0[2][2], B1[2][2];
    const char* cA = (const char*)g.A + (size_t)cur.pm * tstep; const char* cB = (const char*)g.Bt + (size_t)cur.pn * tstep;
    S.a_ready(cur);
    if constexpr (epi_has_pref<Epi>::value) E.prefetch(cur, 0, wid, lane);
    if constexpr (SP2) {
        PG8_STAGE(PG8_SB(0, 0), cB, voffB); PG8_STAGE(PG8_SB(0, 1), cB + hstep, voffB); PG8_STAGE(PG8_SA(0, 0), cA, voffA); PG8_STAGE(PG8_SA(0, 1), cA + hstep, voffA);
        if (wr == 1) PG8_BAR;
        PG8_WAIT_V(2); PG8_BAR;
        PG8_STAGE(PG8_SB(1, 0), cB + kstep, voffB); PG8_STAGE(PG8_SA(1, 0), cA + kstep, voffA); PG8_STAGE(PG8_SB(1, 1), cB + hstep + kstep, voffB);
        PG8_WAIT_V(6); PG8_BAR;
    } else {
        PG8_STAGE(PG8_SB(0, 0), cB, voffB); PG8_STAGE(PG8_SA(0, 0), cA, voffA); PG8_STAGE(PG8_SB(0, 1), cB + hstep, voffB); PG8_STAGE(PG8_SA(0, 1), cA + hstep, voffA);
        if (wr == 1) PG8_BAR;
        PG8_WAIT_V(4); PG8_BAR;
        PG8_STAGE(PG8_SB(1, 0), cB + kstep, voffB); PG8_STAGE(PG8_SA(1, 0), cA + kstep, voffA); PG8_STAGE(PG8_SB(1, 1), cB + hstep + kstep, voffB);
        PG8_WAIT_V(6); PG8_BAR;
    }
    for (;;) {
        const bool has_next = S.next(ui + 1, nxt);
        const char* nA = has_next ? (const char*)g.A + (size_t)nxt.pm * tstep : cA; const char* nB = has_next ? (const char*)g.Bt + (size_t)nxt.pn * tstep : cB;
        for (int t = 0; t < nt; t += 2) {
            const bool last = (t == nt - 2);
            const char* a1 = cA + (size_t)(t + 1) * kstep;
            const char* a2 = last ? nA : cA + (size_t)(t + 2) * kstep; const char* b2 = last ? nB : cB + (size_t)(t + 2) * kstep;
            const char* a3 = a2 + kstep; const char* b3 = b2 + kstep;
            if (last && has_next) S.a_ready(nxt);
            if constexpr (SP2) {
            PG8_LDB(B0, 0, 0); PG8_LDB(B1, 0, 1); PG8_SCHED; PG8_LDA(At, 0, 0); PG8_STAGE(PG8_SA(1, 1), a1 + hstep, voffA);
            PG8_WAIT_V(8); PG8_WAIT_L(0); PG8_BAR; PG8_MMA(0, 0, At, B0); PG8_MMA(0, 1, At, B1); PG8_BAR; PG8_SCHED;
            PG8_LDA(At, 0, 1); PG8_STAGE(PG8_SB(0, 0), b2, voffB); PG8_STAGE(PG8_SB(0, 1), b2 + hstep, voffB); PG8_STAGE(PG8_SA(0, 0), a2, voffA);
            PG8_WAIT_V(8); PG8_WAIT_L(0); PG8_BAR; PG8_MMA(1, 0, At, B0); PG8_MMA(1, 1, At, B1); PG8_BAR; PG8_SCHED;
            PG8_LDB(B0, 1, 0); PG8_LDB(B1, 1, 1); PG8_SCHED; PG8_LDA(At, 1, 0); PG8_STAGE(PG8_SA(0, 1), a2 + hstep, voffA);
            PG8_WAIT_V(8); PG8_WAIT_L(0); PG8_BAR; PG8_MMA(0, 0, At, B0); PG8_MMA(0, 1, At, B1); PG8_BAR; PG8_SCHED;
            PG8_LDA(At, 1, 1); PG8_STAGE(PG8_SB(1, 0), b3, voffB); PG8_STAGE(PG8_SB(1, 1), b3 + hstep, voffB); PG8_STAGE(PG8_SA(1, 0), a3, voffA);
            PG8_WAIT_V(8); PG8_WAIT_L(0); PG8_BAR; PG8_MMA(1, 0, At, B0); PG8_MMA(1, 1, At, B1); PG8_BAR; PG8_SCHED;
            } else {
            PG8_LDB(B0, 0, 0); PG8_SCHED; PG8_LDA(At, 0, 0); PG8_STAGE(PG8_SA(1, 1), a1 + hstep, voffA);
            PG8_WAIT_L(8); PG8_BAR; PG8_WAIT_L(0); PG8_MMA(0, 0, At, B0); PG8_BAR; PG8_SCHED;
            PG8_LDB(B1, 0, 1); PG8_STAGE(PG8_SB(0, 0), b2, voffB);
            PG8_BAR; PG8_WAIT_L(0); PG8_MMA(0, 1, At, B1); PG8_BAR;
            PG8_LDA(At, 0, 1); PG8_STAGE(PG8_SA(0, 0), a2, voffA);
            PG8_BAR; PG8_WAIT_L(0); PG8_MMA(1, 0, At, B0); PG8_BAR; PG8_SCHED;
            PG8_STAGE(PG8_SB(0, 1), b2 + hstep, voffB);
            PG8_WAIT_V(6); PG8_BAR; PG8_MMA(1, 1, At, B1); PG8_BAR;
            PG8_LDB(B0, 1, 0); PG8_SCHED; PG8_LDA(At, 1, 0); PG8_STAGE(PG8_SA(0, 1), a2 + hstep, voffA);
            PG8_WAIT_L(8); PG8_BAR; PG8_WAIT_L(0); PG8_MMA(0, 0, At, B0); PG8_BAR; PG8_SCHED;
            PG8_LDB(B1, 1, 1); PG8_STAGE(PG8_SB(1, 0), b3, voffB);
            PG8_BAR; PG8_WAIT_L(0); PG8_MMA(0, 1, At, B1); PG8_BAR;
            PG8_LDA(At, 1, 1); PG8_STAGE(PG8_SA(1, 0), a3, voffA);
            PG8_BAR; PG8_WAIT_L(0); PG8_MMA(1, 0, At, B0); PG8_BAR; PG8_SCHED;
            PG8_STAGE(PG8_SB(1, 1), b3 + hstep, voffB);
            PG8_WAIT_V(6); PG8_BAR; PG8_MMA(1, 1, At, B1); PG8_BAR;
            }
        }
        if constexpr (ALIGN_EPI) { if (wr == 0) PG8_BAR; }
        if constexpr (F8) {
#define PG8_PIN8(ai, bj) "+v"(acc[ai][bj][0][0]), "+v"(acc[ai][bj][0][1]), "+v"(acc[ai][bj][1][0]), "+v"(acc[ai][bj][1][1]), "+v"(acc[ai][bj][2][0]), "+v"(acc[ai][bj][2][1]), "+v"(acc[ai][bj][3][0]), "+v"(acc[ai][bj][3][1])
            asm volatile("s_nop 15\n\ts_nop 15" : PG8_PIN8(0, 0)); asm volatile("" : PG8_PIN8(0, 1)); asm volatile("" : PG8_PIN8(1, 0)); asm volatile("" : PG8_PIN8(1, 1));
#undef PG8_PIN8
        }
        if constexpr (epi_has_pref<Epi>::value) { E(acc, cur, wr, wc, fr, fq, ui & 1); S.done(cur); if (has_next) E.prefetch(nxt, (ui + 1) & 1, wid, lane); }
        else if constexpr (F8) { const int t2 = ftid(); E(acc, cur, wr, wc, t2 & 15, (t2 >> 4) & 3); S.done(cur); }
        else if constexpr (!Epi::AFTER_DRAIN) { E(acc, cur, wr, wc, fr, fq); S.done(cur); }
        if (!has_next) break;
#pragma unroll
        for (int a = 0; a < 2; ++a)
#pragma unroll
            for (int b = 0; b < 2; ++b)
#pragma unroll
                for (int m = 0; m < 4; ++m)
#pragma unroll
                    for (int n = 0; n < 2; ++n) acc[a][b][m][n] = (f32x4){0.f, 0.f, 0.f, 0.f};
        cur = nxt; cA = nA; cB = nB; ++ui;
        if constexpr (F8) { const int t3 = ftid();
#pragma unroll
            for (int i = 0; i < 2; ++i) { int R, C; stage_rc(t3 * 16 + i * 8192, R, C); const int Rb = Epi::PERM ? ((R & ~31) + perm32(R & 31)) : R;
                voffA[i] = (unsigned)(R * LD) * (unsigned)ES + (unsigned)C * 2u; voffB[i] = (unsigned)(Rb * LD) * (unsigned)ES + (unsigned)C * 2u; } }
        if constexpr (ALIGN_EPI) { if (wr == 1) PG8_BAR; }
    }
    PG8_WAIT_V(0);
    if constexpr (!ALIGN_EPI) { if (wr == 0) PG8_BAR; }
    PG8_BAR;
    if constexpr (Epi::AFTER_DRAIN) { E.fused(acc, cur, wr, wc, fr, fq, lds, wid, lane); S.done(cur); }
#undef PG8_SA
#undef PG8_SB
#undef PG8_STAGE
#undef PG8_LDA
#undef PG8_LDB
#undef PG8_MMA
#undef PG8_CAT8
#undef PG8_WAIT_V
#undef PG8_WAIT_L
#undef PG8_BAR
#undef PG8_SCHED
}
}
namespace att {
typedef unsigned short bf16_t;
using bf16x8 = __attribute__((ext_vector_type(8))) short;
using s16x4 = __attribute__((ext_vector_type(4))) short;
using f32x16 = __attribute__((ext_vector_type(16))) float;
using u32x4 = __attribute__((ext_vector_type(4))) unsigned;
typedef __attribute__((address_space(3))) char* lds_ptr;
typedef __attribute__((address_space(3))) const char* lds_cptr;
constexpr int PITCH = 2048, KVBLK = 64, QB = 256, SEQ = 16384;
constexpr int KSLOT = 8192, VSLOT = 16384, NSLOT = 3;
constexpr int LDS_K = 0, LDS_V = NSLOT * KSLOT, LDS_WS = LDS_V + NSLOT * VSLOT, LDS_OST = LDS_WS + 8 * 256, LDS_STOP = LDS_OST + 8 * 8192, LDS_END = LDS_STOP + 64;
constexpr float THR = 8.0f;
#define ATT_SBAR() __builtin_amdgcn_sched_barrier(0)
#define ATT_WAIT_BAR(N) asm volatile("s_waitcnt vmcnt(" #N ") lgkmcnt(0)\n\ts_barrier" ::: "memory")
__device__ __forceinline__ void glds16(const void* gsrc, unsigned lds_dst) { unsigned keep;
    asm volatile("s_mov_b32 %0, m0\n\ts_mov_b32 m0, %2\n\ts_nop 0\n\tglobal_load_lds_dwordx4 %1, off\n\ts_mov_b32 m0, %0" : "=&s"(keep) : "v"(gsrc), "s"(lds_dst) : "memory"); }
__device__ __forceinline__ unsigned cvtpk(float lo, float hi) { unsigned r; asm("v_cvt_pk_bf16_f32 %0, %1, %2" : "=v"(r) : "v"(lo), "v"(hi)); return r; }
__device__ __forceinline__ float add1(float a, float b) { float r; asm("v_add_f32 %0, %1, %2" : "=v"(r) : "v"(a), "v"(b)); return r; }
__device__ __forceinline__ int crow(int r, int hi) { return (r & 3) + 8 * (r >> 2) + 4 * hi; }

__device__ __forceinline__ void attn_unit(int h, int c, int qb, const bf16_t* Q, const bf16_t* __restrict__ K, const bf16_t* __restrict__ V, bf16_t* O, lds_ptr shm, float sl2, int t_start, float kn) {
    const int tid = ftid(), lane = tid & 63, r32 = lane & 31, hi = lane >> 5; const int wid = __builtin_amdgcn_readfirstlane(tid >> 6);
    const int q0 = qb * QB;
    const bf16_t* Qw = Q + (size_t)(q0 + wid * 32) * PITCH + h * 128 + c * 64;
    const unsigned lds0 = (unsigned)(uintptr_t)shm;
    __attribute__((address_space(3))) float* wsf = (__attribute__((address_space(3))) float*)(shm + LDS_WS) + wid * 64;
    const bf16_t* ksrc = K + (size_t)(h * 2 + c) * 256 * 4096 + wid * 512 + lane * 8;
    const bf16_t* vsrc0 = V + (size_t)h * 256 * 8192 + wid * 512 + lane * 8;
    const bf16_t* vsrc1 = vsrc0 + 8 * 512;
    const unsigned kdst = lds0 + LDS_K + wid * 1024, vdst0 = lds0 + LDS_V + wid * 1024, vdst1 = vdst0 + 8192;
#define ATT_DMA(t, sl) do { \
        glds16(ksrc + (size_t)(t) * 4096, (unsigned)__builtin_amdgcn_readfirstlane(kdst + (sl) * KSLOT)); \
        glds16(vsrc0 + (size_t)(t) * 8192, (unsigned)__builtin_amdgcn_readfirstlane(vdst0 + (sl) * VSLOT)); \
        glds16(vsrc1 + (size_t)(t) * 8192, (unsigned)__builtin_amdgcn_readfirstlane(vdst1 + (sl) * VSLOT)); } while (0)
    const int vb0 = (int)(lds0 + LDS_V) + ((lane >> 4) & 1) * 32 + (lane & 3) * 8 + (4 * hi + ((lane & 15) >> 2)) * 64;
    const lds_cptr kp0 = (lds_cptr)shm + LDS_K + hi * 1024 + r32 * 16;
    const int NT = (q0 + QB) / KVBLK, n = NT - t_start;
    bf16x8 qr[4];
#pragma unroll
    for (int d0 = 0; d0 < 4; ++d0) qr[d0] = *reinterpret_cast<const bf16x8*>(Qw + (size_t)r32 * PITCH + d0 * 16 + hi * 8);
    asm volatile("s_waitcnt vmcnt(0)" ::: "memory");
#pragma unroll
    for (int d0 = 0; d0 < 4; ++d0) asm volatile("" : "+v"(qr[d0]));
#define ATT_SEQ(i) (((i) < 4) ? (NT - 4 + (i)) : (NT - 1 - (i)))
    float brow;
    { float qn2 = 0.f;
#pragma unroll
      for (int d0 = 0; d0 < 4; ++d0)
#pragma unroll
          for (int e = 0; e < 8; ++e) { const float v = __uint_as_float(((unsigned)(unsigned short)qr[d0][e]) << 16); qn2 += v * v; }
      auto rr = __builtin_amdgcn_permlane32_swap(__float_as_uint(qn2), __float_as_uint(qn2), false, false);
      qn2 = __uint_as_float(rr[0]) + __uint_as_float(rr[1]);
      brow = sqrtf(qn2) * kn * 1.001f + 0.01f; }
    __attribute__((address_space(3))) float* stopv = (__attribute__((address_space(3))) float*)(shm + LDS_STOP);
    ATT_DMA(ATT_SEQ(0), 0); ATT_DMA(ATT_SEQ(1), 1);
    f32x16 kbv;
#pragma unroll
    for (int r = 0; r < 16; ++r) kbv[r] = sl2 * (float)((r & 3) + 8 * (r >> 2));
    const float sl32 = 32.0f * sl2;
    const int qpos = q0 + wid * 32 + r32;
    float mref = 0.f, l_reg = 0.f; f32x16 o[4];
#pragma unroll
    for (int d = 0; d < 4; ++d) o[d] = f32x16{};
    int slot = 0;
    for (int i = 0; i < n; ++i) {
        const int t = ATT_SEQ(i);
        if (i + 1 < n) { ATT_WAIT_BAR(3); } else { ATT_WAIT_BAR(0); }
        if (i >= 4) { const int pb = ((i - 1) & 1) * 8;
            float mv = stopv[pb];
#pragma unroll
            for (int w = 1; w < 8; ++w) mv = __builtin_fmaxf(mv, stopv[pb + w]);
            if (mv < -44.0f) break; }
        if (i + 2 < n) { const int s2 = (slot == 0) ? 2 : slot - 1; ATT_DMA(ATT_SEQ(i + 2), s2); }
        const int d0i = 64 * t + 4 * hi - qpos;
        const float base0 = sl2 * (float)d0i - mref, base1 = base0 + sl32;
        f32x16 p0, p1;
#pragma unroll
        for (int r = 0; r < 16; ++r) { p0[r] = add1(kbv[r], base0); p1[r] = add1(kbv[r], base1); }
        { const lds_cptr kb = kp0 + slot * KSLOT;
#pragma unroll
          for (int d0 = 0; d0 < 4; ++d0) {
              const bf16x8 b0 = *reinterpret_cast<const __attribute__((address_space(3))) bf16x8*>(kb + d0 * 2048);
              const bf16x8 b1 = *reinterpret_cast<const __attribute__((address_space(3))) bf16x8*>(kb + d0 * 2048 + 512);
              p0 = __builtin_amdgcn_mfma_f32_32x32x16_bf16(b0, qr[d0], p0, 0, 0, 0);
              p1 = __builtin_amdgcn_mfma_f32_32x32x16_bf16(b1, qr[d0], p1, 0, 0, 0); } }
        if (t >= NT - 4) {
#pragma unroll
            for (int r = 0; r < 16; ++r) { const int kv = d0i + (r & 3) + 8 * (r >> 2); if (kv > 0) p0[r] = -__builtin_inff(); if (kv + 32 > 0) p1[r] = -__builtin_inff(); }
        }
        float rm;
        { float a = __builtin_fmaxf(__builtin_fmaxf(p0[0], p0[1]), p1[0]), b = __builtin_fmaxf(__builtin_fmaxf(p0[2], p0[3]), p1[1]); a = __builtin_fmaxf(__builtin_fmaxf(a, p1[2]), p1[3]);
#pragma unroll
          for (int r = 4; r < 16; r += 4) { a = __builtin_fmaxf(__builtin_fmaxf(a, p0[r]), p0[r + 1]); b = __builtin_fmaxf(__builtin_fmaxf(b, p0[r + 2]), p0[r + 3]);
                                            a = __builtin_fmaxf(__builtin_fmaxf(a, p1[r]), p1[r + 1]); b = __builtin_fmaxf(__builtin_fmaxf(b, p1[r + 2]), p1[r + 3]); }
          rm = __builtin_fmaxf(a, b);
          auto rr = __builtin_amdgcn_permlane32_swap(__float_as_uint(rm), __float_as_uint(rm), false, false);
          rm = __builtin_fmaxf(__uint_as_float(rr[0]), __uint_as_float(rr[1])); }
        const bool first = (i == 0);
        if (first || __any(rm > THR)) {
            const float dl = first ? rm : __builtin_fmaxf(rm, 0.f);
            mref += dl;
#pragma unroll
            for (int r = 0; r < 16; ++r) { p0[r] -= dl; p1[r] -= dl; }
            if (!first) {
                const float f = __builtin_amdgcn_exp2f(-dl);
                l_reg *= f;
                if (hi == 0) wsf[r32] = f;
                float fr_[16];
#pragma unroll
                for (int r = 0; r < 16; ++r) fr_[r] = wsf[crow(r, hi)];
#pragma unroll
                for (int d = 0; d < 4; ++d)
#pragma unroll
                    for (int r = 0; r < 16; ++r) o[d][r] *= fr_[r];
            }
        }
        float sacc = 0.f;
#pragma unroll
        for (int r = 0; r < 16; ++r) { p0[r] = __builtin_amdgcn_exp2f(p0[r]); p1[r] = __builtin_amdgcn_exp2f(p1[r]); }
#pragma unroll
        for (int r = 0; r < 16; ++r) sacc += p0[r] + p1[r];
        l_reg += sacc;
        u32x4 pw0, pw1, pw2, pw3;
        pw0 = (u32x4){cvtpk(p0[0], p0[1]), cvtpk(p0[2], p0[3]), cvtpk(p0[4], p0[5]), cvtpk(p0[6], p0[7])};
        pw1 = (u32x4){cvtpk(p0[8], p0[9]), cvtpk(p0[10], p0[11]), cvtpk(p0[12], p0[13]), cvtpk(p0[14], p0[15])};
        pw2 = (u32x4){cvtpk(p1[0], p1[1]), cvtpk(p1[2], p1[3]), cvtpk(p1[4], p1[5]), cvtpk(p1[6], p1[7])};
        pw3 = (u32x4){cvtpk(p1[8], p1[9]), cvtpk(p1[10], p1[11]), cvtpk(p1[12], p1[13]), cvtpk(p1[14], p1[15])};
        { const int vb = vb0 + slot * VSLOT;
          const bf16x8 pa0 = __builtin_bit_cast(bf16x8, pw0), pa1 = __builtin_bit_cast(bf16x8, pw1), pa2 = __builtin_bit_cast(bf16x8, pw2), pa3 = __builtin_bit_cast(bf16x8, pw3);
#pragma unroll
          for (int d0 = 0; d0 < 4; ++d0) { s16x4 lo[4], hh[4];
#pragma unroll
              for (int ks = 0; ks < 4; ++ks) {
                  asm volatile("ds_read_b64_tr_b16 %0,%1 offset:%c2" : "=&v"(lo[ks]) : "v"(vb), "i"(d0 * 4096 + ks * 1024) : "memory");
                  asm volatile("ds_read_b64_tr_b16 %0,%1 offset:%c2" : "=&v"(hh[ks]) : "v"(vb), "i"(d0 * 4096 + ks * 1024 + 512) : "memory"); }
              asm volatile("s_waitcnt lgkmcnt(0)" ::: "memory"); ATT_SBAR();
#define ATT_PK(k) (bf16x8){lo[k][0], lo[k][1], lo[k][2], lo[k][3], hh[k][0], hh[k][1], hh[k][2], hh[k][3]}
              o[d0] = __builtin_amdgcn_mfma_f32_32x32x16_bf16(pa0, ATT_PK(0), o[d0], 0, 0, 0);
              o[d0] = __builtin_amdgcn_mfma_f32_32x32x16_bf16(pa1, ATT_PK(1), o[d0], 0, 0, 0);
              o[d0] = __builtin_amdgcn_mfma_f32_32x32x16_bf16(pa2, ATT_PK(2), o[d0], 0, 0, 0);
              o[d0] = __builtin_amdgcn_mfma_f32_32x32x16_bf16(pa3, ATT_PK(3), o[d0], 0, 0, 0);
#undef ATT_PK
          } }
        if (i >= 3 && i + 1 < n) {
            float v = brow + sl2 * (float)(64 * ATT_SEQ(i + 1) + 63 - qpos) - mref;
            v = __builtin_fmaxf(v, __shfl_xor(v, 1)); v = __builtin_fmaxf(v, __shfl_xor(v, 2)); v = __builtin_fmaxf(v, __shfl_xor(v, 4)); v = __builtin_fmaxf(v, __shfl_xor(v, 8)); v = __builtin_fmaxf(v, __shfl_xor(v, 16));
            if (lane == 0) stopv[(i & 1) * 8 + wid] = v; }
        slot = (slot == 2) ? 0 : slot + 1;
    }
#undef ATT_SEQ
    { auto rr = __builtin_amdgcn_permlane32_swap(__float_as_uint(l_reg), __float_as_uint(l_reg), false, false); l_reg = __uint_as_float(rr[0]) + __uint_as_float(rr[1]); }
    if (hi == 0) wsf[32 + r32] = l_reg;
    float rli[16];
#pragma unroll
    for (int r = 0; r < 16; ++r) rli[r] = 1.0f / wsf[32 + crow(r, hi)];
    { __attribute__((address_space(3))) bf16_t* stg = (__attribute__((address_space(3))) bf16_t*)(shm + LDS_OST) + wid * 4096;
#pragma unroll
      for (int r = 0; r < 16; ++r) { const int orow = crow(r, hi);
#pragma unroll
          for (int d0 = 0; d0 < 4; ++d0) { const float v = o[d0][r] * rli[r]; stg[orow * 128 + d0 * 32 + r32] = (bf16_t)(cvtpk(v, v) & 0xffffu); } }
      asm volatile("s_waitcnt lgkmcnt(0)" ::: "memory");
      bf16_t* Ow = O + (size_t)(q0 + wid * 32) * PITCH + h * 128;
#pragma unroll
      for (int it = 0; it < 8; ++it) { const int row = it * 4 + (lane >> 4), ch = lane & 15;
          const u32x4 v = *(const __attribute__((address_space(3))) u32x4*)(stg + row * 128 + ch * 8);
          *(u32x4*)(Ow + (size_t)row * PITCH + ch * 8) = v; } }
    asm volatile("s_waitcnt vmcnt(0) lgkmcnt(0)\n\ts_barrier" ::: "memory");
#undef ATT_DMA
}
#undef ATT_SBAR
#undef ATT_WAIT_BAR
}

constexpr int NWAVES = 8;
constexpr int N_LAUNCHES = MK_N_LAUNCHES;
constexpr int N_PHASES = 13;
constexpr int SEQ = 16384, DM = 4096, DIN = 18432, DRNN = 2048, DFF = 11008, NUP = 2 * DFF  ;
constexpr float EPS = 1e-6f;
constexpr float QSCALE = 0.125f * 1.4426950408889634f;
constexpr float LOG2E = 1.4426950408889634f;
constexpr size_t MiB = 1u << 20;
constexpr size_t WS_CTL = 0, CTL_ZERO_BYTES = 64 * 1024;
constexpr size_t WS_MOD = 1 * MiB;
constexpr size_t WS_RGW = 2 * MiB;
constexpr size_t WS_CA = 4 * MiB, WS_CB = 6 * MiB, WS_HC = 8 * MiB;
constexpr size_t WS_PART = 10 * MiB;
constexpr size_t WS_RSTD = 14 * MiB, WS_BIAS2 = 14 * MiB + 512 * 1024;
constexpr size_t WS_WIN = 16 * MiB;
constexpr size_t WS_WPA = 160 * MiB, WS_WPR = 176 * MiB;
constexpr size_t WS_WOUT = 192 * MiB;
constexpr size_t WS_WUP = 224 * MiB;
constexpr size_t WS_WDN = 396 * MiB;
constexpr size_t WS_H = 482 * MiB;
constexpr size_t WS_Q = 610 * MiB, WS_K = 674 * MiB, WS_V = 738 * MiB;
constexpr size_t WS_RX = 802 * MiB, WS_RG = 866 * MiB;
constexpr size_t WS_GA = 930 * MiB, WS_GB = 1058 * MiB;
constexpr size_t WS_O1 = 1186 * MiB, WS_O2 = 1250 * MiB;
constexpr size_t WS_H8 = 1186 * MiB, WS_W8 = 1250 * MiB;
constexpr int NPROJ8 = 10240;
constexpr float W8SCALE = 128.0f, WPA8SCALE = 64.0f;
constexpr size_t WS_MIX = 1314 * MiB;
constexpr size_t WS_GT = 1314 * MiB, WS_GH = 1320 * MiB, WS_UH = 1326 * MiB;
constexpr size_t WS_ACT = 610 * MiB;
constexpr size_t WS_BPART = 1442 * MiB;
constexpr size_t WS_END = 1448 * MiB;
static_assert(WS_UH + (size_t)64 * 2 * DFF * 4 <= WS_BPART && WS_BPART + (size_t)64 * NUP * 4 <= WS_END && WS_ACT + (size_t)SEQ * DFF * 2 <= WS_GT, "d_ws map");
constexpr int CW_BAR = 4096;
constexpr int CW_ATTQ = 8192;
constexpr int CW_QKMAX = 8320;
constexpr int RING_OFF = 0, BND_OFF = 131072;
constexpr int LDSCTL_OFF = 143360, MISC_OFF = LDSCTL_OFF + 320;
constexpr int LDS_BYTES = 147456;
static_assert(att::LDS_END <= LDSCTL_OFF && MISC_OFF + 128 <= LDS_BYTES, "LDS map");
#define GAS __attribute__((address_space(1)))
#define LAS __attribute__((address_space(3)))
typedef unsigned short bf16;
typedef unsigned v4u __attribute__((ext_vector_type(4)));
typedef float f32x4 __attribute__((ext_vector_type(4)));
typedef short bf16x8 __attribute__((ext_vector_type(8)));
typedef GAS unsigned gu32;
typedef GAS unsigned long long gu64;
#define RLX_AGENT __ATOMIC_RELAXED, __HIP_MEMORY_SCOPE_AGENT
#define LDS_WAIT() asm volatile("s_waitcnt lgkmcnt(0)" ::: "memory")
#define VM_WAIT() asm volatile("s_waitcnt vmcnt(0)" ::: "memory")
__device__ __forceinline__ unsigned long long rt() { return __builtin_amdgcn_s_memrealtime(); }
__device__ __forceinline__ unsigned f2bf(float f) { unsigned u = __builtin_bit_cast(unsigned, f); return (u + 0x7fffu + ((u >> 16) & 1u)) >> 16; }
__device__ __forceinline__ unsigned pk2(float lo, float hi) { return f2bf(lo) | (f2bf(hi) << 16); }

#define XB_TMO      128
#define XB_XCNT(j)  (256  + 64 * (j))
#define XB_XSUB(j)  (1280 + 64 * (j))
#define XB_XGEN(j)  (2304 + 64 * (j))
#define XB_TOP      3328
#define XB_TOPGEN   3392
#define XCD_BAR_WORDS 3456
#define XB_SPIN_CAP (1u << 18)

__device__ __forceinline__ unsigned xb_ld(unsigned* p)              { return __hip_atomic_load(p, __ATOMIC_RELAXED, __HIP_MEMORY_SCOPE_AGENT); }
__device__ __forceinline__ unsigned xb_add(unsigned* p, unsigned v) { return __hip_atomic_fetch_add(p, v, __ATOMIC_RELAXED, __HIP_MEMORY_SCOPE_AGENT); }
__device__ __forceinline__ unsigned xb_xcc_id() { return (unsigned)__builtin_amdgcn_s_getreg((3 << 11) | 20) & 0xFu; }
#define XB_SPIN(cond, bar) do { unsigned _sp = 0; while (cond) { __builtin_amdgcn_s_sleep(1); \
    if ((++_sp & 255u) == 0u) { if (xb_ld(&(bar)[XB_TMO])) break; if (_sp > XB_SPIN_CAP) { atomicAdd(&(bar)[XB_TMO], 1u); break; } } } } while (0)

struct XcdBarrier {
    unsigned* bar; unsigned x;
    volatile LAS unsigned* st;
};

__device__ __forceinline__ XcdBarrier xcd_barrier_post(unsigned* bar, volatile LAS unsigned* st) {
    XcdBarrier b; b.bar = bar; b.x = xb_xcc_id(); b.st = st;
    if (threadIdx.x == 0) (void)xb_add(&bar[XB_XCNT(b.x)], 1u);
    return b;
}
__device__ __forceinline__ void xcd_barrier_complete(unsigned* bar, unsigned x, unsigned& nloc, unsigned& nx) {
    const unsigned G = gridDim.x * gridDim.y * gridDim.z;
    unsigned sum, cnt, mine, sp = 0u;
    for (;;) {
        sum = 0u; cnt = 0u; mine = 0u;
#pragma unroll
        for (unsigned j = 0; j < 16; ++j) { const unsigned c = xb_ld(&bar[XB_XCNT(j)]); sum += c; cnt += (c > 0u) ? 1u : 0u; mine = (j == x) ? c : mine; }
        if (sum == G) break;
        __builtin_amdgcn_s_sleep(1);
        if ((++sp & 255u) == 0u) { if (xb_ld(&bar[XB_TMO])) break; if (sp > XB_SPIN_CAP) { atomicAdd(&bar[XB_TMO], 1u); break; } }
    }
    nloc = mine > 0u ? mine : 1u; nx = cnt > 0u ? cnt : 1u;
}

__device__ __forceinline__ void xcd_barrier(const XcdBarrier& b) {
    asm volatile("s_waitcnt vmcnt(0)" ::: "memory");
    __syncthreads();
    if (threadIdx.x == 0) {
        unsigned* bar = b.bar;
        __builtin_amdgcn_s_waitcnt(0);
        unsigned nloc = b.st[0], nx = b.st[1];
        if (nloc == 0u) { xcd_barrier_complete(bar, b.x, nloc, nx); b.st[0] = nloc; b.st[1] = nx; }
        const unsigned old = xb_add(&bar[XB_XSUB(b.x)], 1u);
        const unsigned gen = old / nloc;
        if (old + 1u == (gen + 1u) * nloc) {
            __builtin_amdgcn_fence(__ATOMIC_RELEASE, "agent");
            asm volatile("s_waitcnt vmcnt(0)" ::: "memory");
            const unsigned og = xb_add(&bar[XB_TOP], 1u);
            const unsigned tg = og / nx;
            if (og + 1u == (tg + 1u) * nx) xb_add(&bar[XB_TOPGEN], 1u);
            else XB_SPIN(xb_ld(&bar[XB_TOPGEN]) == tg, bar);
            __builtin_amdgcn_fence(__ATOMIC_ACQUIRE, "agent");
            xb_add(&bar[XB_XGEN(b.x)], 1u);
            asm volatile("s_waitcnt vmcnt(0)" ::: "memory");
        } else {
            XB_SPIN(xb_ld(&bar[XB_XGEN(b.x)]) == gen, bar);
            __builtin_amdgcn_fence(__ATOMIC_ACQUIRE, "agent");
            asm volatile("s_waitcnt vmcnt(0)" ::: "memory");
        }
    }
    __syncthreads();
}
struct Frame {
    LAS unsigned char* lds;
    volatile LAS unsigned* MISC;
    gu32* ctl;
    int tid, lane, wave;
    int vcu, G;
};
__device__ __forceinline__ float wave_sum(float v) {
#pragma unroll
    for (int o = 1; o < 64; o <<= 1) v += __shfl_xor(v, o);
    return v;
}
__device__ __forceinline__ unsigned pkbf(float lo, float hi) { unsigned r; asm("v_cvt_pk_bf16_f32 %0, %1, %2" : "=v"(r) : "v"(lo), "v"(hi)); return r; }
__device__ __forceinline__ float bflo(unsigned w) { return __uint_as_float(w << 16); }
__device__ __forceinline__ float bfhi(unsigned w) { return __uint_as_float(w & 0xffff0000u); }
__device__ __forceinline__ float sigmoidf_(float v) { return __builtin_amdgcn_rcpf(1.0f + __builtin_amdgcn_exp2f(-LOG2E * v)); }
__device__ __forceinline__ float gelu_tanhf_(float v) { const float u = v * (0.7978845608028654f + 0.035677408136300125f * v * v);
    return v * __builtin_amdgcn_rcpf(1.0f + __builtin_amdgcn_exp2f(-2.8853900817779268f * u)); }

__device__ __forceinline__ void transpose_item(const float* W, int K, int N, bf16* WT, int k0, int n0, int rowbase, LAS float* scr, int lane) {
#pragma unroll 8
    for (int i = 0; i < 32; ++i) { const int kk = 2 * i + (lane >> 5); scr[kk * 33 + (lane & 31)] = __builtin_nontemporal_load(&W[(size_t)(k0 + kk) * N + n0 + (lane & 31)]);     }
    LDS_WAIT(); asm volatile("" ::: "memory");
    const int c = lane & 7;
#pragma unroll
    for (int j = 0; j < 4; ++j) { const int n = (lane >> 3) + 8 * j; const LAS float* s = scr + (8 * c) * 33 + n;
        v4u o; o.x = pkbf(s[0 * 33], s[1 * 33]); o.y = pkbf(s[2 * 33], s[3 * 33]); o.z = pkbf(s[4 * 33], s[5 * 33]); o.w = pkbf(s[6 * 33], s[7 * 33]);
        *(GAS v4u*)(WT + (size_t)(rowbase + n) * K + k0 + 8 * c) = o; }
    LDS_WAIT(); asm volatile("" ::: "memory");
}
__device__ __forceinline__ unsigned pk4_fp8(float a, float b, float c, float d);
__device__ __forceinline__ void transpose_item_fp8(const float* W, int K, int N, unsigned char* W8, int k0, int n0, int rowbase, LAS float* scr, int lane, float sc) {
#pragma unroll 8
    for (int i = 0; i < 32; ++i) { const int kk = 2 * i + (lane >> 5); scr[kk * 33 + (lane & 31)] = __builtin_nontemporal_load(&W[(size_t)(k0 + kk) * N + n0 + (lane & 31)]) * sc; }
    LDS_WAIT(); asm volatile("" ::: "memory");
    const int c = lane & 7;
#pragma unroll
    for (int j = 0; j < 4; ++j) { const int n = (lane >> 3) + 8 * j; const LAS float* s = scr + (8 * c) * 33 + n;
        const unsigned long long o = (unsigned long long)pk4_fp8(s[0 * 33], s[1 * 33], s[2 * 33], s[3 * 33]) | ((unsigned long long)pk4_fp8(s[4 * 33], s[5 * 33], s[6 * 33], s[7 * 33]) << 32);
        *(GAS unsigned long long*)(W8 + (size_t)(rowbase + n) * K + k0 + 8 * c) = o; }
    LDS_WAIT(); asm volatile("" ::: "memory");
}
__device__ __forceinline__ void transpose_matrix_item(const float* W, int K, int N, bf16* WT, int item, int mode, LAS float* scr, int lane) {
    const int nblk = N / 32, kb = item / nblk, nb = item % nblk, n0 = 32 * nb;
    int rowbase = n0;
    if (mode == 1) { rowbase = (n0 < DFF) ? (n0 / 128) * 256 + (n0 % 128) : ((n0 - DFF) / 128) * 256 + 128 + ((n0 - DFF) % 128); }
    transpose_item(W, K, N, WT, 64 * kb, n0, rowbase, scr, lane);
}

__device__ __forceinline__ void transpose_up_item(const float* W, bf16* WT, int item, const LAS float* a2, const LAS float* sh2, float* BPART, LAS float* scr, int lane) {
    constexpr int K = DM, N = NUP; constexpr int nblk = N / 32; const int kb = item / nblk, nb = item % nblk, n0 = 32 * nb, k0 = 64 * kb;
    const int rowbase = (n0 < DFF) ? (n0 / 128) * 256 + (n0 % 128) : ((n0 - DFF) / 128) * 256 + 128 + ((n0 - DFF) % 128);
    float bsum = 0.f;
#pragma unroll 8
    for (int i = 0; i < 32; ++i) { const int kk = 2 * i + (lane >> 5); const float w = __builtin_nontemporal_load(&W[(size_t)(k0 + kk) * N + n0 + (lane & 31)]); bsum += sh2[k0 + kk] * w; scr[kk * 33 + (lane & 31)] = w * a2[k0 + kk]; }
    bsum += __shfl_xor(bsum, 32);
    if (lane < 32) BPART[(size_t)kb * N + n0 + lane] = bsum;
    LDS_WAIT(); asm volatile("" ::: "memory");
    const int c = lane & 7;
#pragma unroll
    for (int j = 0; j < 4; ++j) { const int n = (lane >> 3) + 8 * j; const LAS float* s = scr + (8 * c) * 33 + n;
        v4u o; o.x = pkbf(s[0 * 33], s[1 * 33]); o.y = pkbf(s[2 * 33], s[3 * 33]); o.z = pkbf(s[4 * 33], s[5 * 33]); o.w = pkbf(s[6 * 33], s[7 * 33]);
        *(GAS v4u*)(WT + (size_t)(rowbase + n) * K + k0 + 8 * c) = o; }
    LDS_WAIT(); asm volatile("" ::: "memory");
}

__device__ __forceinline__ void conv64_plain(const float* W, int K, int N, bf16* WT, int item, LAS float* scr, int lane) {
    const int nblk = N / 64, kb = item / nblk, nb = item % nblk, n0 = 64 * nb, k0 = 64 * kb;
    const int lr = lane >> 4, lc = (lane & 15) * 4;
    f32x4 v[16];
#pragma unroll
    for (int i = 0; i < 16; ++i) v[i] = __builtin_nontemporal_load((const GAS f32x4*)(W + (size_t)(k0 + 4 * i + lr) * N + n0 + lc));
#pragma unroll
    for (int i = 0; i < 16; ++i) { LAS float* p = scr + (4 * i + lr) * 65 + lc; p[0] = v[i].x; p[1] = v[i].y; p[2] = v[i].z; p[3] = v[i].w; }
    LDS_WAIT(); asm volatile("" ::: "memory");
    const int c = lane & 7;
#pragma unroll
    for (int j = 0; j < 8; ++j) { const int n = (lane >> 3) + 8 * j; const LAS float* s = scr + (8 * c) * 65 + n;
        v4u o; o.x = pkbf(s[0 * 65], s[1 * 65]); o.y = pkbf(s[2 * 65], s[3 * 65]); o.z = pkbf(s[4 * 65], s[5 * 65]); o.w = pkbf(s[6 * 65], s[7 * 65]);
        *(GAS v4u*)(WT + (size_t)(n0 + n) * K + k0 + 8 * c) = o; }
    LDS_WAIT(); asm volatile("" ::: "memory");
}

__device__ __forceinline__ unsigned pk4_fp8(float a, float b, float c, float d) { int w = __builtin_amdgcn_cvt_pk_fp8_f32(a, b, 0, false); w = __builtin_amdgcn_cvt_pk_fp8_f32(c, d, w, true); return (unsigned)w; }
__device__ __forceinline__ void norm_row_to_bf16(const float* xrow, bf16* orow, const LAS float* avec, const LAS float* bvec, int lane, unsigned* o4row = nullptr) {
    asm volatile("" ::: "memory");
    const GAS f32x4* xr = (const GAS f32x4*)xrow + lane;
    f32x4 v[16]; float s = 0.f;
#pragma unroll
    for (int j = 0; j < 16; ++j) { v[j] = __builtin_nontemporal_load(&xr[64 * j]); s += (v[j].x * v[j].x + v[j].y * v[j].y) + (v[j].z * v[j].z + v[j].w * v[j].w); }
    const float rstd = 1.0f / sqrtf(wave_sum(s) * (1.f / DM) + EPS);
    GAS unsigned long long* o8 = (GAS unsigned long long*)orow + lane;
#pragma unroll
    for (int j = 0; j < 16; ++j) { const f32x4 a = *(const LAS f32x4*)(avec + 256 * j + 4 * lane), b = *(const LAS f32x4*)(bvec + 256 * j + 4 * lane);
        const f32x4 y = v[j] * rstd * a + b;
        o8[64 * j] = (unsigned long long)pkbf(y.x, y.y) | ((unsigned long long)pkbf(y.z, y.w) << 32);
        if (o4row) ((GAS unsigned*)o4row)[64 * j + lane] = pk4_fp8(y.x, y.y, y.z, y.w);
        if ((j & 3) == 3) __builtin_amdgcn_sched_barrier(0); }
}
namespace rgl {
constexpr int T = 64;
constexpr int L_XRF = 0, L_AF = 32768, L_BF = 65536, L_XRB = 98304, L_SA = 115712, L_SB = 117760, L_END = 119808;
typedef short bf16x8 __attribute__((ext_vector_type(8)));
struct Ptrs { const bf16* RX; const bf16* RGg; const float* conv_w; const float* conv_b; const bf16* Wt; const float* b_a; const float* b_x; const float* lam; float* CA; float* CB; const float* HC; bf16* YREC; };
struct RxBuf { v4u x[2][4]; };
__device__ __forceinline__ void load_rx(const Ptrs& P, int n, int ch, int tid, RxBuf& B) {
#pragma unroll
    for (int jj = 0; jj < 2; ++jj) { const int it = tid + 512 * jj, r = it >> 4, g = it & 15, t = ch * T + r, col = n * 128 + 8 * g;
#pragma unroll
        for (int j = 0; j < 4; ++j) { const int ts = t - 3 + j; B.x[jj][j] = (ts >= 0) ? *(const GAS v4u*)(P.RX + (size_t)ts * DRNN + col) : (v4u){0u, 0u, 0u, 0u}; } }
}
template <int PASS> __device__ __forceinline__ void unit(const Ptrs& P, int n, int ch, LAS unsigned char* lds, int tid, const bf16x8 (&bw)[2][4], float bias_a, float bias_x, float sp,
                                                         RxBuf& RXB_, const f32x4 (&cwv)[4][2], const f32x4 (&cbv)[2], int un) {
    asm volatile("" : "+v"(tid));
    const int lane = tid & 63, wid = tid >> 6, cbase = n * 128, t0 = ch * T;
    LAS float* XRF = (LAS float*)(lds + L_XRF); LAS float* AF = (LAS float*)(lds + L_AF); LAS float* BF = (LAS float*)(lds + L_BF);
    LAS float* SA = (LAS float*)(lds + L_SA); LAS float* SB = (LAS float*)(lds + L_SB);
#pragma unroll
    for (int jj = 0; jj < 2; ++jj) { const int it = tid + 512 * jj, r = it >> 4, g = it & 15;
        float xr[8];
        xr[0] = cbv[0].x; xr[1] = cbv[0].y; xr[2] = cbv[0].z; xr[3] = cbv[0].w; xr[4] = cbv[1].x; xr[5] = cbv[1].y; xr[6] = cbv[1].z; xr[7] = cbv[1].w;
#pragma unroll
        for (int j = 0; j < 4; ++j) { const v4u x = RXB_.x[jj][j]; const f32x4 w0 = cwv[j][0], w1 = cwv[j][1];
            xr[0] += w0.x * bflo(x.x); xr[1] += w0.y * bfhi(x.x); xr[2] += w0.z * bflo(x.y); xr[3] += w0.w * bfhi(x.y);
            xr[4] += w1.x * bflo(x.z); xr[5] += w1.y * bfhi(x.z); xr[6] += w1.z * bflo(x.w); xr[7] += w1.w * bfhi(x.w); }
        *(LAS f32x4*)(XRF + r * 128 + 8 * g) = (f32x4){xr[0], xr[1], xr[2], xr[3]}; *(LAS f32x4*)(XRF + r * 128 + 8 * g + 4) = (f32x4){xr[4], xr[5], xr[6], xr[7]};
        v4u pk; pk.x = pkbf(xr[0], xr[1]); pk.y = pkbf(xr[2], xr[3]); pk.z = pkbf(xr[4], xr[5]); pk.w = pkbf(xr[6], xr[7]);
        *(LAS v4u*)(lds + L_XRB + r * 272 + 16 * g) = pk; }
    if (un >= 0) load_rx(P, un & 15, un >> 4, tid, RXB_);
    __syncthreads();
    { const int fi = lane & 15, kq = lane >> 4;
#pragma unroll
      for (int rt = 0; rt < 4; ++rt) { f32x4 da = (f32x4){0.f, 0.f, 0.f, 0.f}, dx = da;
#pragma unroll
          for (int s = 0; s < 4; ++s) { const bf16x8 af = *(const LAS bf16x8*)(lds + L_XRB + (16 * rt + fi) * 272 + (32 * s + 8 * kq) * 2);
              da = __builtin_amdgcn_mfma_f32_16x16x32_bf16(af, bw[0][s], da, 0, 0, 0);
              dx = __builtin_amdgcn_mfma_f32_16x16x32_bf16(af, bw[1][s], dx, 0, 0, 0); }
          const int e = 16 * wid + fi;
#pragma unroll
          for (int q = 0; q < 4; ++q) { const int t = 16 * rt + 4 * kq + q;
              const float r = sigmoidf_(da[q] + bias_a), ig = sigmoidf_(dx[q] + bias_x);
              const float z = -16.0f * r * sp;
              const float a = __builtin_amdgcn_exp2f(z * (0.5f * LOG2E));
              const float om = (z > -0.03f) ? -z * (1.0f + z * (0.5f + z * (0.16666667f + z * 0.041666668f))) : 1.0f - a * a;
              const float bxv = __builtin_amdgcn_sqrtf(om) * ig * XRF[t * 128 + e];
              AF[t * 128 + e] = a; BF[t * 128 + e] = bxv; }
          __builtin_amdgcn_sched_barrier(0); } }
    __syncthreads();
    const int e = tid & 127, sub = tid >> 7;
    { float A = 1.f, B = 0.f;
#pragma unroll
      for (int q = 0; q < 16; ++q) { const int t = 16 * sub + q; const float a = AF[t * 128 + e], b = BF[t * 128 + e]; B = a * B + b; A = A * a; }
      SA[sub * 128 + e] = A; SB[sub * 128 + e] = B; }
    __syncthreads();
    if (PASS == 1) {
        if (tid < 128) { float A = 1.f, B = 0.f;
#pragma unroll
            for (int s = 0; s < 4; ++s) { const float a = SA[s * 128 + e], b = SB[s * 128 + e]; B = a * B + b; A = A * a; }
            P.CA[(size_t)ch * DRNN + cbase + e] = A; P.CB[(size_t)ch * DRNN + cbase + e] = B; }
    } else {
        float hst = P.HC[(size_t)ch * DRNN + cbase + e];
        for (int s = 0; s < sub; ++s) hst = SA[s * 128 + e] * hst + SB[s * 128 + e];
#pragma unroll
        for (int q = 0; q < 16; ++q) { const int t = 16 * sub + q; hst = AF[t * 128 + e] * hst + BF[t * 128 + e]; AF[t * 128 + e] = hst; }
        __syncthreads();
#pragma unroll
        for (int jj = 0; jj < 2; ++jj) { const int it = tid + 512 * jj, r = it >> 4, g = it & 15, t = t0 + r, col = cbase + 8 * g;
            const v4u gg = *(const GAS v4u*)(P.RGg + (size_t)t * DRNN + col);
            const f32x4 h0 = *(const LAS f32x4*)(AF + r * 128 + 8 * g), h1 = *(const LAS f32x4*)(AF + r * 128 + 8 * g + 4);
            v4u pk; pk.x = pkbf(h0.x * bflo(gg.x), h0.y * bfhi(gg.x)); pk.y = pkbf(h0.z * bflo(gg.y), h0.w * bfhi(gg.y));
            pk.z = pkbf(h1.x * bflo(gg.z), h1.y * bfhi(gg.z)); pk.w = pkbf(h1.z * bflo(gg.w), h1.w * bfhi(gg.w));
            *(GAS v4u*)(P.YREC + (size_t)t * DRNN + col) = pk; }
    }
    __syncthreads();
}
template <int PASS> __device__ __forceinline__ void phase(const Ptrs& P, LAS unsigned char* lds, int tid, int G) {
    const int lane = tid & 63, wid = tid >> 6, fi = lane & 15, kq = lane >> 4;
    int ncur = -1; bf16x8 bw[2][4]; float bias_a = 0.f, bias_x = 0.f, sp = 0.f; f32x4 cwv[4][2], cbv[2];
#pragma unroll
    for (int g = 0; g < 2; ++g)
#pragma unroll
        for (int s = 0; s < 4; ++s) bw[g][s] = (bf16x8){0, 0, 0, 0, 0, 0, 0, 0};
#pragma unroll
    for (int j = 0; j < 4; ++j) { cwv[j][0] = (f32x4){0.f, 0.f, 0.f, 0.f}; cwv[j][1] = cwv[j][0]; }
    cbv[0] = (f32x4){0.f, 0.f, 0.f, 0.f}; cbv[1] = cbv[0];
    const int NU = 16 * (SEQ / T);
    RxBuf cur;
    if ((int)blockIdx.x < NU) load_rx(P, blockIdx.x & 15, blockIdx.x >> 4, tid, cur);
#pragma unroll 1
    for (int u = blockIdx.x; u < NU; u += G) {
        const int n = u & 15, ch = u >> 4;
        if (n != ncur) { ncur = n; const int e = 16 * wid + fi;
#pragma unroll
            for (int g = 0; g < 2; ++g)
#pragma unroll
                for (int s = 0; s < 4; ++s) bw[g][s] = *(const GAS bf16x8*)(P.Wt + ((size_t)(g * 16 + n) * 128 + e) * 128 + 32 * s + 8 * kq);
            bias_a = P.b_a[n * 128 + e]; bias_x = P.b_x[n * 128 + e]; sp = log1pf(__expf(-P.lam[n * 128 + e]));
            const int col = n * 128 + 8 * (tid & 15);
#pragma unroll
            for (int j = 0; j < 4; ++j) { cwv[j][0] = *(const GAS f32x4*)(P.conv_w + j * DRNN + col); cwv[j][1] = *(const GAS f32x4*)(P.conv_w + j * DRNN + col + 4); }
            cbv[0] = *(const GAS f32x4*)(P.conv_b + col); cbv[1] = *(const GAS f32x4*)(P.conv_b + col + 4); }
        unit<PASS>(P, n, ch, lds, tid, bw, bias_a, bias_x, sp, cur, cwv, cbv, (u + G < NU) ? u + G : -1);
    }
}
}

#ifndef PROBE_DUP
#define PROBE_DUP 0
#endif
#define PROBE_REP(k) ((((PROBE_DUP) >> (k)) & 1) + 1)
struct Args { const float* in[27]; float* out; unsigned char* ws; int ph_lo, ph_hi; };
__global__ void __launch_bounds__(NWAVES * 64, 2) mk_fwd(Args args) {
    extern __shared__ __attribute__((aligned(16))) unsigned char lds[];
    Frame F;
    F.lds = (LAS unsigned char*)lds;
    F.MISC = (volatile LAS unsigned*)(F.lds + MISC_OFF);
    F.tid = ftid(); F.lane = F.tid & 63; F.wave = __builtin_amdgcn_readfirstlane(F.tid >> 6);
    F.G = gridDim.x; { const int bx = blockIdx.x; F.vcu = (F.G % 8 == 0) ? (bx % 8) * (F.G / 8) + bx / 8 : bx; }
    unsigned char* ws = args.ws;
    F.ctl = (gu32*)(ws + WS_CTL);
    for (int u = F.tid; u < (LDS_BYTES - LDSCTL_OFF) / 4; u += NWAVES * 64) ((LAS unsigned*)(F.lds + LDSCTL_OFF))[u] = 0u;
    __syncthreads();
    XcdBarrier bar; bar.bar = (unsigned*)(F.ctl + CW_BAR); bar.x = 0; bar.st = nullptr;
    if (N_LAUNCHES == 1) bar = xcd_barrier_post((unsigned*)(F.ctl + CW_BAR), F.MISC + 8);
#define GRID_BAR() do { if (N_LAUNCHES == 1) xcd_barrier(bar); } while (0)
    const int lo = args.ph_lo, hi = args.ph_hi;
#define IN(k) (lo <= (k) && (k) < hi)
#define BOTH(k) (IN(k) && IN((k) + 1))
    const float* x = args.in[0]; const float* cvec = args.in[1]; const float* w_ada = args.in[2]; const float* b_ada = args.in[3]; const float* norm1_w = args.in[4];
    const float* w_in = args.in[5]; const float* lq1 = args.in[6]; const float* lk1 = args.in[7]; const float* lq2 = args.in[8]; const float* lk2 = args.in[9];
    const float* subln_w = args.in[10]; const float* conv_w = args.in[11]; const float* conv_b = args.in[12]; const float* w_rg_a = args.in[13]; const float* b_rg_a = args.in[14];
    const float* w_rg_x = args.in[15]; const float* b_rg_x = args.in[16]; const float* lru_lambda = args.in[17]; const float* w_pa = args.in[18]; const float* w_pr = args.in[19];
    const float* w_out = args.in[20]; const float* norm2_w = args.in[21]; const float* w_up = args.in[22]; const float* fconv_w = args.in[23]; const float* fconv_b = args.in[24];
    const float* w_dn = args.in[25]; const float* normf_w = args.in[26];
    float* out = args.out;
    float* MOD = (float*)(ws + WS_MOD);
    bf16* RGW = (bf16*)(ws + WS_RGW); float* CA = (float*)(ws + WS_CA); float* CB = (float*)(ws + WS_CB); float* HC = (float*)(ws + WS_HC);
    bf16* WIN = (bf16*)(ws + WS_WIN); bf16* WPA = (bf16*)(ws + WS_WPA); bf16* WPR = (bf16*)(ws + WS_WPR); bf16* WOUT = (bf16*)(ws + WS_WOUT); bf16* WUP = (bf16*)(ws + WS_WUP); bf16* WDN = (bf16*)(ws + WS_WDN);
    bf16* HB = (bf16*)(ws + WS_H); bf16* QB_ = (bf16*)(ws + WS_Q); bf16* KB = (bf16*)(ws + WS_K); bf16* VB = (bf16*)(ws + WS_V); bf16* RXB = (bf16*)(ws + WS_RX); bf16* RGB = (bf16*)(ws + WS_RG);
    bf16* GAB = (bf16*)(ws + WS_GA); bf16* GBB = (bf16*)(ws + WS_GB); bf16* O1 = (bf16*)(ws + WS_O1); bf16* O2 = (bf16*)(ws + WS_O2); bf16* MIX = (bf16*)(ws + WS_MIX);
    bf16* ACT = (bf16*)(ws + WS_ACT); float* GT = (float*)(ws + WS_GT); float* GH = (float*)(ws + WS_GH); float* UH = (float*)(ws + WS_UH);
    bf16* YATT = QB_; bf16* YREC = KB; bf16* M1 = HB; bf16* X1B = HB;
    unsigned char* H8 = ws + WS_H8; unsigned char* W8 = ws + WS_W8;
    float* PART = (float*)(ws + WS_PART); float* RSTD = (float*)(ws + WS_RSTD); float* BIAS2 = (float*)(ws + WS_BIAS2); float* BPART = (float*)(ws + WS_BPART);
    const int gw = F.vcu * NWAVES + F.wave, NGW = F.G * NWAVES;

#ifndef NO_P0
    if (IN(0)) { F.tid = ftid(); F.lane = F.tid & 63;
      for (int rep = 0; rep < PROBE_REP(0); ++rep) {
        { LAS float* sc_l = (LAS float*)(F.lds);
          LAS float* red = (LAS float*)(F.lds + 16384);
          for (int i = F.tid; i < DM; i += NWAVES * 64) { const float cv = cvec[i]; sc_l[i] = cv * sigmoidf_(cv); }
          __syncthreads();
          for (int cb = blockIdx.x; cb < (6 * DM) / 96; cb += F.G) {
              const int rgp = F.tid >> 5, cl = F.tid & 31;
              f32x4 a = (f32x4){0.f, 0.f, 0.f, 0.f};
              if (cl < 24) { const float* wp = w_ada + (size_t)rgp * (6 * DM) + 96 * cb + 4 * cl;
#pragma unroll 8
                  for (int k = 0; k < DM / 16; ++k) { const f32x4 w = __builtin_nontemporal_load((const GAS f32x4*)(wp + (size_t)k * 16 * (6 * DM))); a += w * sc_l[rgp + 16 * k]; }
                  *(LAS f32x4*)(red + rgp * 96 + 4 * cl) = a; }
              __syncthreads();
              if (F.tid < 96) { float s = 0.f;
#pragma unroll
                  for (int g = 0; g < 16; ++g) s += red[g * 96 + F.tid];
                  MOD[96 * cb + F.tid] = s + b_ada[96 * cb + F.tid]; }
              __syncthreads(); } }
        { LAS float* scr = (LAS float*)(F.lds + RING_OFF + F.wave * 16384);
          constexpr int I_IN = (DM / 64) * (DIN / 32), I_PA = (2048 / 64) * (DM / 32), I_OUT = (DM / 64) * (DM / 32), I_DN = (DFF / 64) * (DM / 32), I_RG = 16 * 2 * 4;
          constexpr int NITEMS = I_IN + 2 * I_PA + I_OUT + 2 * I_RG;
          for (int it = gw; it < NITEMS; it += NGW) {
              int r = it;
              if (r < I_IN) { const int nb = r % (DIN / 32), kb = r / (DIN / 32);
                  const int n0 = 32 * nb, r8 = (n0 < 6144) ? n0 : ((n0 >= 10240 && n0 < 14336) ? n0 - 10240 + 6144 : -1);
                  if (r8 >= 0) transpose_item_fp8(w_in, DM, DIN, W8, 64 * kb, n0, r8, scr, F.lane, W8SCALE);
                  else transpose_matrix_item(w_in, DM, DIN, WIN, r, 0, scr, F.lane);
                  continue; } r -= I_IN;
              if (r < I_PA) { const int nb = r % (DM / 32), kb = r / (DM / 32); transpose_item_fp8(w_pa, 2048, DM, (unsigned char*)WPA, 64 * kb, 32 * nb, 32 * nb, scr, F.lane, WPA8SCALE); continue; } r -= I_PA;
              if (r < I_PA) { transpose_matrix_item(w_pr, 2048, DM, WPR, r, 0, scr, F.lane); continue; } r -= I_PA;
              if (r < I_OUT) { transpose_matrix_item(w_out, DM, DM, WOUT, r, 0, scr, F.lane); continue; } r -= I_OUT;
              if (r < I_RG) { const int nb = r >> 3; transpose_matrix_item(w_rg_a + (size_t)nb * 16384, 128, 128, RGW + (size_t)nb * 16384, r & 7, 0, scr, F.lane); continue; } r -= I_RG;
              { const int nb = r >> 3; transpose_matrix_item(w_rg_x + (size_t)nb * 16384, 128, 128, RGW + (size_t)(16 + nb) * 16384, r & 7, 0, scr, F.lane); }
          } }
        if (PROBE_REP(0) > 1) __syncthreads();
      }
        if (BOTH(0)) GRID_BAR();
    }
#endif
#ifndef NO_P1
    if (IN(1)) { F.tid = ftid(); F.lane = F.tid & 63;
        LAS float* av = (LAS float*)(F.lds); LAS float* bv = (LAS float*)(F.lds + 16384); LAS float* a2 = (LAS float*)(F.lds + 32768); LAS float* s2 = (LAS float*)(F.lds + 49152);
        for (int i = F.tid; i < DM; i += NWAVES * 64) { av[i] = norm1_w[i] * (1.0f + MOD[DM + i]); bv[i] = MOD[i]; a2[i] = norm2_w[i] * (1.0f + MOD[4 * DM + i]); s2[i] = MOD[3 * DM + i]; }
        __syncthreads();
        for (int rep = 0; rep < PROBE_REP(1); ++rep) {
#pragma unroll 1
        for (int m = gw; m < SEQ; m += NGW) norm_row_to_bf16(x + (size_t)m * DM, HB + (size_t)m * DM, av, bv, F.lane, (unsigned*)(H8 + (size_t)m * DM));
        { LAS float* scr = (LAS float*)(F.lds + 65536 + F.wave * 8448);
          constexpr int I_UP = (DM / 64) * (NUP / 32);
#pragma unroll 1
          for (int it = gw; it < I_UP; it += NGW) transpose_up_item(w_up, WUP, it, a2, s2, BPART, scr, F.lane); }
        }
        if (BOTH(1)) GRID_BAR();
    }
#endif
#ifndef NO_P2
    if (IN(2)) { F.tid = ftid(); F.lane = F.tid & 63;
        { pg8::Gemm g{HB, WIN, SEQ, DIN - NPROJ8, DM, DM}; pg8::ProjOrder16 S; S.init(SEQ, DIN - NPROJ8, F.G, (int)blockIdx.x);
          pg8::EpiProj E{QB_, KB, VB, RXB, RGB, GAB, GBB, QSCALE, 1.0f};
          pg8::gemm_phase<pg8::EpiProj, pg8::ProjOrder16, true, true>(F.lds + RING_OFF, g, S, E); }
        VM_WAIT(); __syncthreads();
        { pg8::Gemm g{(const pg8::bf16_t*)H8, (const pg8::bf16_t*)W8, SEQ, NPROJ8, DM, DM}; pg8::StaticOrder S; S.init(SEQ, NPROJ8, F.G, (int)blockIdx.x);
          pg8::EpiProjF8 E2{pg8::EpiProj{QB_, KB, VB, RXB, RGB, GAB, GBB, QSCALE, 1.0f / W8SCALE}};
          pg8::gemm_phase<pg8::EpiProjF8, pg8::StaticOrder, true, true, true>(F.lds + RING_OFF, g, S, E2); }
        if (BOTH(2)) GRID_BAR();
    }
#endif
    const rgl::Ptrs RP{RXB, RGB, conv_w, conv_b, RGW, b_rg_a, b_rg_x, lru_lambda, CA, CB, HC, YREC};
#ifndef NO_P3
    if (IN(3)) { F.tid = ftid(); F.lane = F.tid & 63;
        for (int rep = 0; rep < PROBE_REP(3); ++rep) {
        rgl::phase<1>(RP, F.lds, F.tid, F.G);
        { float qm[4] = {0.f, 0.f, 0.f, 0.f};
#pragma unroll 1
          for (int m = gw; m < SEQ; m += NGW) {
#pragma unroll
              for (int j = 0; j < 4; ++j) { const size_t off = (size_t)m * 2048 + 512 * j + 8 * F.lane;
                  const v4u a = *(const GAS v4u*)(QB_ + off);
                  float sa = (bflo(a.x) * bflo(a.x) + bfhi(a.x) * bfhi(a.x)) + (bflo(a.y) * bflo(a.y) + bfhi(a.y) * bfhi(a.y)) + (bflo(a.z) * bflo(a.z) + bfhi(a.z) * bfhi(a.z)) + (bflo(a.w) * bflo(a.w) + bfhi(a.w) * bfhi(a.w));
                  sa += __shfl_xor(sa, 1); sa += __shfl_xor(sa, 2); sa += __shfl_xor(sa, 4);
                  qm[j] = fmaxf(qm[j], sa); } }
          if ((F.lane & 7) == 0) {
#pragma unroll
              for (int j = 0; j < 4; ++j) __hip_atomic_fetch_max(F.ctl + CW_QKMAX + 8 * j + (F.lane >> 3), __float_as_uint(qm[j]), RLX_AGENT); }
#pragma unroll 1
          for (int it = gw; it < 32 * 256; it += NGW) { const bf16* kp = KB + (size_t)it * 4096 + F.lane * 8; float sb = 0.f;
#pragma unroll
              for (int ch = 0; ch < 8; ++ch) { const v4u b = *(const GAS v4u*)(kp + ch * 512);
                  sb += (bflo(b.x) * bflo(b.x) + bfhi(b.x) * bfhi(b.x)) + (bflo(b.y) * bflo(b.y) + bfhi(b.y) * bfhi(b.y)) + (bflo(b.z) * bflo(b.z) + bfhi(b.z) * bfhi(b.z)) + (bflo(b.w) * bflo(b.w) + bfhi(b.w) * bfhi(b.w)); }
#pragma unroll
              for (int o = 1; o < 64; o <<= 1) sb = fmaxf(sb, __shfl_xor(sb, o));
              if (F.lane == 0) __hip_atomic_fetch_max(F.ctl + CW_QKMAX + 32 + (it >> 8), __float_as_uint(sb), RLX_AGENT); } }
        }
        if (BOTH(3)) GRID_BAR();
    }
#endif
#ifndef NO_P4
    if (IN(4)) { F.tid = ftid(); F.lane = F.tid & 63;
        if (blockIdx.x < 4) { const int e = blockIdx.x * 512 + F.tid; float hst = 0.f;
            for (int c0 = 0; c0 < SEQ / rgl::T; c0 += 8) { float a[8], b[8];
#pragma unroll
                for (int j = 0; j < 8; ++j) { a[j] = CA[(size_t)(c0 + j) * DRNN + e]; b[j] = CB[(size_t)(c0 + j) * DRNN + e]; }
#pragma unroll
                for (int j = 0; j < 8; ++j) { HC[(size_t)(c0 + j) * DRNN + e] = hst; hst = a[j] * hst + b[j]; } }
            VM_WAIT(); __syncthreads(); }
        for (int rep = 0; rep < PROBE_REP(4); ++rep)
        for (;;) {
            if (F.tid == 0) F.MISC[16] = __hip_atomic_fetch_add(F.ctl + CW_ATTQ + 64 * rep, 1u, RLX_AGENT);
            __syncthreads();
            const int idx = (int)F.MISC[16];
            __syncthreads();
            if (idx >= 2048) break;
            const int h = 15 - (idx >> 7), qb = 63 - ((idx >> 1) & 63), c = idx & 1;
            const float sl2 = exp2f(-0.5f * (float)(h + 1)) * LOG2E;
            const float qm = __uint_as_float(__hip_atomic_load(F.ctl + CW_QKMAX + 2 * h + c, RLX_AGENT)), km = __uint_as_float(__hip_atomic_load(F.ctl + CW_QKMAX + 32 + 2 * h + c, RLX_AGENT));
            const float Bq = sqrtf(qm * km) * 1.001f + 0.01f;
            const float dmaxf = (2.0f * Bq + 44.0f) / sl2;
            int t_start = 0;
            if (dmaxf < 20000.0f) { const int lim = qb * 256 - (int)ceilf(dmaxf) - 63; t_start = (lim >= 0) ? (lim >> 6) + 1 : 0; if (t_start > 4 * qb) t_start = 4 * qb; }
            att::attn_unit(h, c, qb, QB_, KB, VB, c ? O2 : O1, (att::lds_ptr)(F.lds + RING_OFF), sl2, t_start, sqrtf(km));
        }
        if (BOTH(4)) GRID_BAR();
    }
#endif
#ifndef NO_P5
    if (IN(5)) { F.tid = ftid(); F.lane = F.tid & 63;
        for (int rep = 0; rep < PROBE_REP(5); ++rep) {
        rgl::phase<2>(RP, F.lds, F.tid, F.G);
        float lam;
        { const float p1 = (F.lane < 64) ? lq1[F.lane] * lk1[F.lane] : 0.f, p2 = lq2[F.lane] * lk2[F.lane];
          lam = __expf(wave_sum(p1)) - __expf(wave_sum(p2)) + 0.2f; }
        float sw[8];
#pragma unroll
        for (int j = 0; j < 8; ++j) sw[j] = subln_w[8 * (F.lane & 15) + j] * 0.8f;
#pragma unroll 1
        for (int m = gw; m < SEQ; m += NGW) {
#pragma unroll
            for (int j = 0; j < 4; ++j) { const size_t off = (size_t)m * 2048 + 512 * j + 8 * F.lane;
                const v4u a = *(const GAS v4u*)(O1 + off), b = *(const GAS v4u*)(O2 + off);
                float d[8]; d[0] = bflo(a.x) - lam * bflo(b.x); d[1] = bfhi(a.x) - lam * bfhi(b.x); d[2] = bflo(a.y) - lam * bflo(b.y); d[3] = bfhi(a.y) - lam * bfhi(b.y);
                d[4] = bflo(a.z) - lam * bflo(b.z); d[5] = bfhi(a.z) - lam * bfhi(b.z); d[6] = bflo(a.w) - lam * bflo(b.w); d[7] = bfhi(a.w) - lam * bfhi(b.w);
                float ss = 0.f;
#pragma unroll
                for (int q = 0; q < 8; ++q) ss += d[q] * d[q];
                ss += __shfl_xor(ss, 1); ss += __shfl_xor(ss, 2); ss += __shfl_xor(ss, 4); ss += __shfl_xor(ss, 8);
                const float rstd = 1.0f / sqrtf(ss * (1.f / 128.f) + EPS);
                v4u o; o.x = pkbf(d[0] * rstd * sw[0], d[1] * rstd * sw[1]); o.y = pkbf(d[2] * rstd * sw[2], d[3] * rstd * sw[3]);
                o.z = pkbf(d[4] * rstd * sw[4], d[5] * rstd * sw[5]); o.w = pkbf(d[6] * rstd * sw[6], d[7] * rstd * sw[7]);
                (void)o;
                *(GAS unsigned long long*)((unsigned char*)YATT + off) = (unsigned long long)pk4_fp8(d[0] * rstd * sw[0], d[1] * rstd * sw[1], d[2] * rstd * sw[2], d[3] * rstd * sw[3])
                    | ((unsigned long long)pk4_fp8(d[4] * rstd * sw[4], d[5] * rstd * sw[5], d[6] * rstd * sw[6], d[7] * rstd * sw[7]) << 32); } }
        }
        if (BOTH(5)) GRID_BAR();
    }
#endif
#ifndef NO_P6
    if (IN(6)) { F.tid = ftid(); F.lane = F.tid & 63;
        { pg8::Gemm g{YATT, WPA, SEQ, DM, 2048, 2048}; pg8::StaticOrder S; S.init(SEQ, DM, F.G, (int)blockIdx.x);
          pg8::EpiGate<false> E{GAB, nullptr, M1, 1.0f / WPA8SCALE};
          pg8::gemm_phase<pg8::EpiGate<false>, pg8::StaticOrder, true, true, true>(F.lds + RING_OFF, g, S, E); }
        VM_WAIT(); __syncthreads();
        { pg8::Gemm g{YREC, WPR, SEQ, DM, 2048, 2048}; pg8::StaticOrder S; S.init(SEQ, DM, F.G, (int)blockIdx.x);
          pg8::EpiGate<true> E{GBB, M1, MIX, 1.0f};
          pg8::gemm_phase<pg8::EpiGate<true>, pg8::StaticOrder, true, true>(F.lds + RING_OFF, g, S, E); }
        if (BOTH(6)) GRID_BAR();
    }
#endif
#ifndef NO_P7
    if (IN(7)) { F.tid = ftid(); F.lane = F.tid & 63;
        pg8::Gemm g{MIX, WOUT, SEQ, DM, DM, DM}; pg8::StaticOrder S; S.init(SEQ, DM, F.G, (int)blockIdx.x);
        pg8::EpiRes1 E{x, MOD + 2 * DM, X1B, PART};
        for (int rep = 0; rep < PROBE_REP(7); ++rep) pg8::gemm_phase<pg8::EpiRes1, pg8::StaticOrder, true, true>(F.lds + RING_OFF, g, S, E);
        if (BOTH(7)) GRID_BAR();
    }
#endif
#ifndef NO_P8
    if (IN(8)) { F.tid = ftid(); F.lane = F.tid & 63;
        const int gt = blockIdx.x * (NWAVES * 64) + F.tid, GT_ = F.G * NWAVES * 64;
        for (int row = gt; row < SEQ; row += GT_) { const GAS f32x4* p = (const GAS f32x4*)(PART + (size_t)row * 64); float s = 0.f;
#pragma unroll
            for (int j = 0; j < 16; ++j) { const f32x4 v = p[j]; s += (v.x + v.y) + (v.z + v.w); }
            RSTD[row] = 1.0f / sqrtf(s * (1.f / DM) + EPS); }
        for (int n = gt; n < NUP; n += GT_) { float s = 0.f;
#pragma unroll 8
            for (int kb = 0; kb < DM / 64; ++kb) s += BPART[(size_t)kb * NUP + n];
            BIAS2[n] = s; }
        if (BOTH(8)) GRID_BAR();
    }
#endif
#ifndef NO_P9
    if (IN(9)) { F.tid = ftid(); F.lane = F.tid & 63;
        { F.tid = ftid(); F.lane = F.tid & 63;
          if (F.G == 256 && ((int)blockIdx.x & 7) >= 4) { const int wi = ((((int)blockIdx.x >> 3) * 4) + (((int)blockIdx.x & 7) - 4)) * NWAVES + F.wave;
              LAS float* scr = (LAS float*)(F.lds + RING_OFF + F.wave * 16640);
              constexpr int I_DN64 = (DFF / 64) * (DM / 64);
#pragma unroll 1
              for (int it = wi; it < I_DN64; it += 128 * NWAVES) conv64_plain(w_dn, DFF, DM, WDN, it, scr, F.lane); }
          else if (F.G != 256) { const int wi = (int)blockIdx.x * NWAVES + F.wave; LAS float* scr = (LAS float*)(F.lds + RING_OFF + F.wave * 16640); constexpr int I_DN64 = (DFF / 64) * (DM / 64);
#pragma unroll 1
              for (int it = wi; it < I_DN64; it += F.G * NWAVES) conv64_plain(w_dn, DFF, DM, WDN, it, scr, F.lane); } }
        __syncthreads();
        F.tid = ftid(); F.lane = F.tid & 63;
        pg8::Gemm g{X1B, WUP, SEQ, NUP, DM, DM}; pg8::HalfXcdOrder S; S.init(SEQ, NUP, F.G, (int)blockIdx.x);
        pg8::EpiFfn E{ACT, fconv_w, fconv_b, GT, GH, UH, (LAS float*)(F.lds + BND_OFF), DFF, RSTD, BIAS2, (LAS float*)(F.lds + BND_OFF + 4096)};
        for (int rep = 0; rep < PROBE_REP(9); ++rep) pg8::gemm_phase<pg8::EpiFfn, pg8::HalfXcdOrder, true, true>(F.lds + RING_OFF, g, S, E);
        if (BOTH(9)) GRID_BAR();
    }
#endif
#ifndef NO_P10
    if (IN(10)) { F.tid = ftid(); F.lane = F.tid & 63;
        for (int it = blockIdx.x * (NWAVES * 64) + F.tid; it < 64 * DFF; it += F.G * NWAVES * 64) {
            const int pm = it / DFF, cc = it % DFF;
            const float w0 = fconv_w[cc], w1 = fconv_w[DFF + cc], w2 = fconv_w[2 * DFF + cc], bb = fconv_b[cc];
            const float gm2 = pm ? GT[((size_t)(pm - 1) * 2 + 0) * DFF + cc] : 0.f, gm1 = pm ? GT[((size_t)(pm - 1) * 2 + 1) * DFF + cc] : 0.f;
            const float g0 = GH[((size_t)pm * 2 + 0) * DFF + cc], g1 = GH[((size_t)pm * 2 + 1) * DFF + cc];
            const float u0 = UH[((size_t)pm * 2 + 0) * DFF + cc], u1 = UH[((size_t)pm * 2 + 1) * DFF + cc];
            const float y0 = gelu_tanhf_(bb + w0 * gm2 + w1 * gm1 + w2 * g0) * u0, y1 = gelu_tanhf_(bb + w0 * gm1 + w1 * g0 + w2 * g1) * u1;
            ACT[(size_t)(256 * pm) * DFF + cc] = (bf16)(pkbf(y0, y0) & 0xffffu); ACT[(size_t)(256 * pm + 1) * DFF + cc] = (bf16)(pkbf(y1, y1) & 0xffffu);
        }
        if (BOTH(10)) GRID_BAR();
    }
#endif
#ifndef NO_P11
    if (IN(11)) { F.tid = ftid(); F.lane = F.tid & 63;
        pg8::Gemm g{ACT, WDN, SEQ, DM, DFF, DFF}; pg8::StaticOrder S; S.init(SEQ, DM, F.G, (int)blockIdx.x);
        pg8::EpiRes2 E{X1B, MOD + 5 * DM};
        pg8::gemm_phase<pg8::EpiRes2, pg8::StaticOrder, true, true>(F.lds + RING_OFF, g, S, E);
        if (BOTH(11)) GRID_BAR();
    }
#endif
#ifndef NO_P12
    if (IN(12)) { F.tid = ftid(); F.lane = F.tid & 63;
#pragma unroll 1
        for (int m = gw; m < SEQ; m += NGW) {
            const GAS v4u* xr = (const GAS v4u*)(X1B + (size_t)m * DM) + F.lane;
            v4u v[8]; float s = 0.f;
#pragma unroll
            for (int j = 0; j < 8; ++j) { v[j] = xr[64 * j];
                s += (bflo(v[j].x) * bflo(v[j].x) + bfhi(v[j].x) * bfhi(v[j].x)) + (bflo(v[j].y) * bflo(v[j].y) + bfhi(v[j].y) * bfhi(v[j].y))
                   + (bflo(v[j].z) * bflo(v[j].z) + bfhi(v[j].z) * bfhi(v[j].z)) + (bflo(v[j].w) * bflo(v[j].w) + bfhi(v[j].w) * bfhi(v[j].w)); }
            const float rstd = 1.0f / sqrtf(wave_sum(s) * (1.f / DM) + EPS);
            GAS f32x4* orow = (GAS f32x4*)(out + (size_t)m * DM);
#pragma unroll
            for (int j = 0; j < 8; ++j) { const int c0 = 512 * j + 8 * F.lane;
                const f32x4 w0 = *(const GAS f32x4*)(normf_w + c0), w1 = *(const GAS f32x4*)(normf_w + c0 + 4);
                orow[c0 / 4] = (f32x4){bflo(v[j].x) * rstd * w0.x, bfhi(v[j].x) * rstd * w0.y, bflo(v[j].y) * rstd * w0.z, bfhi(v[j].y) * rstd * w0.w};
                orow[c0 / 4 + 1] = (f32x4){bflo(v[j].z) * rstd * w1.x, bfhi(v[j].z) * rstd * w1.y, bflo(v[j].w) * rstd * w1.z, bfhi(v[j].w) * rstd * w1.w}; }
        }
    }
#endif
#undef IN
#undef BOTH
#undef GRID_BAR
}

extern "C" void kernel_launch(void* const* d_in, const int* in_sizes, int n_in, void* d_out, int out_size, void* d_ws, size_t ws_size, hipStream_t stream) {
    static int grid = 0;
    if (grid == 0) {
        if (n_in != 27 || out_size != SEQ * DM || ws_size < WS_END) { fprintf(stderr, "kernel_launch: unexpected problem (n_in %d, out %d, ws %zu); nothing launched\n", n_in, out_size, ws_size); grid = -1; return; }
        int dev = 0, cus = 0, per_cu = 0;
        if (hipGetDevice(&dev) != hipSuccess || hipDeviceGetAttribute(&cus, hipDeviceAttributeMultiprocessorCount, dev) != hipSuccess) { grid = -1; return; }
        if (hipFuncSetAttribute((const void*)mk_fwd, hipFuncAttributeMaxDynamicSharedMemorySize, LDS_BYTES) != hipSuccess) { fprintf(stderr, "kernel_launch: hipFuncSetAttribute failed\n"); grid = -1; return; }
        if (hipOccupancyMaxActiveBlocksPerMultiprocessor(&per_cu, (const void*)mk_fwd, NWAVES * 64, LDS_BYTES) != hipSuccess || per_cu < 1)
            fprintf(stderr, "kernel_launch: note: occupancy query reports %d workgroups per CU\n", per_cu);
        (void)hipGetLastError();
        grid = cus;
    }
    if (grid < 0) return;
    if (hipMemsetAsync((char*)d_ws + WS_CTL, 0, CTL_ZERO_BYTES, stream) != hipSuccess) return;
    Args a{};
    for (int i = 0; i < 27; ++i) a.in[i] = (const float*)d_in[i];
    a.out = (float*)d_out; a.ws = (unsigned char*)d_ws;
    for (int li = 0; li < N_LAUNCHES; ++li) {
        a.ph_lo = (N_LAUNCHES == 1) ? 0 : li; a.ph_hi = (N_LAUNCHES == 1) ? N_PHASES : li + 1;
        hipLaunchKernelGGL(mk_fwd, dim3(grid), dim3(NWAVES * 64), LDS_BYTES, stream, a);
        const hipError_t le = hipPeekAtLastError();
        if (le != hipSuccess) { fprintf(stderr, "kernel_launch: launch %d failed: %s\n", li, hipGetErrorName(le)); break; }
    }
}
```
